# Optimizing an MI355X kernel written in HIP

```python
import jax, jax.numpy as jnp
from jax import lax
import numpy as np

D_MODEL = 1024
BATCH = 8
SEQ = 4096
DEPTH = 2

CHUNK = 64
Q_BLOCK = 128
HEAD_DIM = 64
SB_HEADS = 4
MLA_HEADS = 8
MLA_Q_RANK = 256
MLA_KV_RANK = 128
MLA_NOPE = 64
MLA_ROPE = 32
MLA_V = 64
ROPE_THETA = 10000.0
CK_HEADS = 4
CK_LEFT_CHUNKS = 8
REL_CLIP = 128

D_SB = SB_HEADS * HEAD_DIM
D_MLA = MLA_HEADS * MLA_V
D_CK = CK_HEADS * HEAD_DIM
D_MIX = D_SB + D_MLA + D_CK
IN_SIZES = (D_SB, D_SB, D_SB, MLA_Q_RANK, MLA_KV_RANK, MLA_ROPE, D_CK, D_CK, D_CK)
IN_COLS = sum(IN_SIZES)
IN_SPLITS = tuple(int(v) for v in np.cumsum(IN_SIZES)[:-1])
GROUP_SPLITS = (D_SB, D_SB + D_MLA)

D_FF = 2816
N_EXPERTS = 8
TOP_K = 2
N_DENSE = (DEPTH + 1) // 2
N_MOE = DEPTH // 2
EPS = 1e-6
NEG = -1e30

kernel_name = "hybrid_streaming_sb_mla_chunkattn_moe"


def _rms_norm(x, g):
    xf = x.astype(jnp.float32)
    y = xf * lax.rsqrt(jnp.mean(xf * xf, axis=-1, keepdims=True) + EPS)
    return (y * g.astype(jnp.float32)).astype(x.dtype)


def _rope(x, cos, sin):
    half = x.shape[-1] // 2
    x1, x2 = x[..., :half], x[..., half:]
    return jnp.concatenate([x1 * cos - x2 * sin, x2 * cos + x1 * sin], axis=-1)


def _stick_breaking(q, k, v):
    S, Dh = q.shape[1], q.shape[-1]
    scale = Dh ** -0.5
    outs = []
    for i in range(S // Q_BLOCK):
        q0, q1 = i * Q_BLOCK, (i + 1) * Q_BLOCK
        z = jnp.einsum('bqhd,bkhd->bhqk', q[:, q0:q1], k[:, :q1]).astype(jnp.float32) * scale
        tq = q0 + jnp.arange(Q_BLOCK)
        tk = jnp.arange(q1)
        strict = tk[None, :] < tq[:, None]
        log_1mb = jnp.where(strict, jax.nn.log_sigmoid(-z), 0.0)
        tail = lax.cumsum(log_1mb, axis=3, reverse=True) - log_1mb
        w = jnp.where(strict, jnp.exp(jax.nn.log_sigmoid(z) + tail), 0.0)
        outs.append(jnp.einsum('bhqk,bkhd->bqhd', w.astype(v.dtype), v[:, :q1]))
    return jnp.concatenate(outs, axis=1)


def _chunk_causal_attention(q, k, v, scale):
    S = q.shape[1]
    outs = []
    for i in range(S // Q_BLOCK):
        q0, q1 = i * Q_BLOCK, (i + 1) * Q_BLOCK
        s = jnp.einsum('bqhd,bkhd->bhqk', q[:, q0:q1], k[:, :q1]).astype(jnp.float32) * scale
        tq = q0 + jnp.arange(Q_BLOCK)
        tk = jnp.arange(q1)
        allowed = (tk[None, :] // CHUNK) <= (tq[:, None] // CHUNK)
        p = jax.nn.softmax(jnp.where(allowed, s, NEG), axis=-1)
        outs.append(jnp.einsum('bhqk,bkhd->bqhd', p.astype(v.dtype), v[:, :q1]))
    return jnp.concatenate(outs, axis=1)


def _chunked_band_attention(q, k, v, rel_bias):
    B, S, H, Dh = q.shape
    NC = S // CHUNK
    W = CK_LEFT_CHUNKS + 1
    qc = q.reshape(B, NC, CHUNK, H, Dh)
    pad = ((0, 0), (CK_LEFT_CHUNKS * CHUNK, 0), (0, 0), (0, 0))
    kp = jnp.pad(k, pad).reshape(B, NC + CK_LEFT_CHUNKS, CHUNK, H, Dh)
    vp = jnp.pad(v, pad).reshape(B, NC + CK_LEFT_CHUNKS, CHUNK, H, Dh)
    band = jnp.arange(NC)[:, None] + jnp.arange(W)[None, :]
    kb = kp[:, band].reshape(B, NC, W * CHUNK, H, Dh)
    vb = vp[:, band].reshape(B, NC, W * CHUNK, H, Dh)
    s = jnp.einsum('bnqhd,bnkhd->bnhqk', qc, kb).astype(jnp.float32) * (Dh ** -0.5)
    q_pos = jnp.arange(CHUNK) + CK_LEFT_CHUNKS * CHUNK
    k_pos = jnp.arange(W * CHUNK)
    rel = jnp.clip(q_pos[:, None] - k_pos[None, :], -REL_CLIP, REL_CLIP) + REL_CLIP
    bias = rel_bias.astype(jnp.float32)[:, rel]
    key_chunk = jnp.arange(NC)[:, None] + (k_pos // CHUNK)[None, :] - CK_LEFT_CHUNKS
    valid = (key_chunk >= 0)[None, :, None, None, :]
    p = jax.nn.softmax(jnp.where(valid, s + bias[None, None], NEG), axis=-1)
    o = jnp.einsum('bnhqk,bnkhd->bnqhd', p.astype(v.dtype), vb)
    return o.reshape(B, S, H, Dh)


def _mixer(h, cos, sin, w_in, mla_q_norm, w_q_up, mla_kv_norm, w_kv_up, mla_q_qknorm,
           mla_k_qknorm, ck_q_qknorm, ck_k_qknorm, ck_rel_bias, group_out_norm, w_out):
    B, S, _ = h.shape
    proj = h @ w_in
    sb_q, sb_k, sb_v, cq, ckv, k_pe, ck_q, ck_k, ck_v = jnp.split(proj, IN_SPLITS, axis=-1)

    hd = lambda t, n: t.reshape(B, S, n, -1)
    o_sb = _stick_breaking(hd(sb_q, SB_HEADS), hd(sb_k, SB_HEADS), hd(sb_v, SB_HEADS))

    q = (_rms_norm(cq, mla_q_norm) @ w_q_up).reshape(B, S, MLA_HEADS, MLA_NOPE + MLA_ROPE)
    q = jnp.concatenate([q[..., :MLA_NOPE], _rope(q[..., MLA_NOPE:], cos, sin)], axis=-1)
    kv = (_rms_norm(ckv, mla_kv_norm) @ w_kv_up).reshape(B, S, MLA_HEADS, MLA_NOPE + MLA_V)
    k_pe = _rope(k_pe[:, :, None, :], cos, sin)
    k = jnp.concatenate([kv[..., :MLA_NOPE],
                         jnp.broadcast_to(k_pe, (B, S, MLA_HEADS, MLA_ROPE))], axis=-1)
    q = _rms_norm(q, mla_q_qknorm)
    k = _rms_norm(k, mla_k_qknorm)
    o_mla = _chunk_causal_attention(q, k, kv[..., MLA_NOPE:], (MLA_NOPE + MLA_ROPE) ** -0.5)

    o_ck = _chunked_band_attention(_rms_norm(hd(ck_q, CK_HEADS), ck_q_qknorm),
                                   _rms_norm(hd(ck_k, CK_HEADS), ck_k_qknorm),
                                   hd(ck_v, CK_HEADS), ck_rel_bias)

    g_sb, g_mla, g_ck = jnp.split(group_out_norm, GROUP_SPLITS)
    merged = jnp.concatenate([_rms_norm(o_sb.reshape(B, S, D_SB), g_sb),
                              _rms_norm(o_mla.reshape(B, S, D_MLA), g_mla),
                              _rms_norm(o_ck.reshape(B, S, D_CK), g_ck)], axis=-1)
    return merged @ w_out


def _swiglu(h, w_gate, w_up, w_down):
    return (jax.nn.silu(h @ w_gate) * (h @ w_up)) @ w_down


def _moe(h, w_router, w_gate, w_up, w_down):
    logits = (h @ w_router).astype(jnp.float32)
    top_val, top_idx = lax.top_k(logits, TOP_K)
    top_w = jax.nn.softmax(top_val, axis=-1)
    gates = jnp.sum(jax.nn.one_hot(top_idx, N_EXPERTS, dtype=jnp.float32) * top_w[..., None], axis=-2)
    gates = gates.astype(h.dtype)
    out = jnp.zeros_like(h)
    for e in range(N_EXPERTS):
        out = out + gates[..., e:e + 1] * _swiglu(h, w_gate[e], w_up[e], w_down[e])
    return out


def setup_inputs(seed: int = 0) -> dict:
    key = jax.random.key(seed)
    ks = iter(jax.random.split(key, 32))
    f32 = jnp.float32

    def w(shape, fan_in, mult=1.0):
        return jax.random.normal(next(ks), shape, f32) * (mult * fan_in ** -0.5)

    def gain(shape):
        return 1.0 + 0.1 * jax.random.normal(next(ks), shape, f32)

    x = jax.random.normal(next(ks), (BATCH, SEQ, D_MODEL), f32)
    c = jax.random.normal(next(ks), (BATCH, D_MODEL), f32)
    offsets = jax.random.randint(next(ks), (BATCH, 1), 0, 4096, dtype=jnp.int32)
    positions = (offsets + jnp.arange(SEQ, dtype=jnp.int32)[None, :]).astype(jnp.int32)
    return {
        "x": x,
        "c": c,
        "positions": positions,
        "ada_w": w((DEPTH, D_MODEL, 6 * D_MODEL), D_MODEL, 0.5),
        "ada_b": 0.02 * jax.random.normal(next(ks), (DEPTH, 6 * D_MODEL), f32),
        "norm_mix": gain((DEPTH, D_MODEL)),
        "norm_ffn": gain((DEPTH, D_MODEL)),
        "w_in": w((DEPTH, D_MODEL, IN_COLS), D_MODEL),
        "mla_q_norm": gain((DEPTH, MLA_Q_RANK)),
        "w_q_up": w((DEPTH, MLA_Q_RANK, MLA_HEADS * (MLA_NOPE + MLA_ROPE)), MLA_Q_RANK),
        "mla_kv_norm": gain((DEPTH, MLA_KV_RANK)),
        "w_kv_up": w((DEPTH, MLA_KV_RANK, MLA_HEADS * (MLA_NOPE + MLA_V)), MLA_KV_RANK),
        "mla_q_qknorm": gain((DEPTH, MLA_NOPE + MLA_ROPE)),
        "mla_k_qknorm": gain((DEPTH, MLA_NOPE + MLA_ROPE)),
        "ck_q_qknorm": gain((DEPTH, HEAD_DIM)),
        "ck_k_qknorm": gain((DEPTH, HEAD_DIM)),
        "ck_rel_bias": 0.5 * jax.random.normal(next(ks), (DEPTH, CK_HEADS, 2 * REL_CLIP + 1), f32),
        "group_out_norm": gain((DEPTH, D_MIX)),
        "w_out": w((DEPTH, D_MIX, D_MODEL), D_MIX),
        "ffn_w_gate": w((N_DENSE, D_MODEL, D_FF), D_MODEL),
        "ffn_w_up": w((N_DENSE, D_MODEL, D_FF), D_MODEL),
        "ffn_w_down": w((N_DENSE, D_FF, D_MODEL), D_FF),
        "moe_router": w((N_MOE, D_MODEL, N_EXPERTS), D_MODEL),
        "moe_w_gate": w((N_MOE, N_EXPERTS, D_MODEL, D_FF), D_MODEL),
        "moe_w_up": w((N_MOE, N_EXPERTS, D_MODEL, D_FF), D_MODEL),
        "moe_w_down": w((N_MOE, N_EXPERTS, D_FF, D_MODEL), D_FF),
    }


def reference(x, c, positions, ada_w, ada_b, norm_mix, norm_ffn, w_in, mla_q_norm, w_q_up,
              mla_kv_norm, w_kv_up, mla_q_qknorm, mla_k_qknorm, ck_q_qknorm, ck_k_qknorm,
              ck_rel_bias, group_out_norm, w_out, ffn_w_gate, ffn_w_up, ffn_w_down,
              moe_router, moe_w_gate, moe_w_up, moe_w_down):
    inv_freq = ROPE_THETA ** (-jnp.arange(0, MLA_ROPE, 2, dtype=jnp.float32) / MLA_ROPE)
    ang = positions.astype(jnp.float32)[..., None] * inv_freq
    cos = jnp.cos(ang)[:, :, None, :].astype(x.dtype)
    sin = jnp.sin(ang)[:, :, None, :].astype(x.dtype)
    c_act = jax.nn.silu(c)
    for layer in range(DEPTH):
        mod = c_act @ ada_w[layer] + ada_b[layer]
        sh1, sc1, g1, sh2, sc2, g2 = [m[:, None, :] for m in jnp.split(mod, 6, axis=-1)]
        h = _rms_norm(x, norm_mix[layer]) * (1.0 + sc1) + sh1
        x = x + g1 * _mixer(h, cos, sin, w_in[layer], mla_q_norm[layer], w_q_up[layer],
                            mla_kv_norm[layer], w_kv_up[layer], mla_q_qknorm[layer],
                            mla_k_qknorm[layer], ck_q_qknorm[layer], ck_k_qknorm[layer],
                            ck_rel_bias[layer], group_out_norm[layer], w_out[layer])
        h = _rms_norm(x, norm_ffn[layer]) * (1.0 + sc2) + sh2
        i = layer // 2
        if layer % 2 == 0:
            y = _swiglu(h, ffn_w_gate[i], ffn_w_up[i], ffn_w_down[i])
        else:
            y = _moe(h, moe_router[i], moe_w_gate[i], moe_w_up[i], moe_w_down[i])
        x = x + g2 * y
    return x
```

```cpp
#include <hip/hip_runtime.h>
#include <stdint.h>
#include <stdio.h>

#ifndef REP_MASK
#define REP_MASK 0u
#endif
#ifndef ONE_LAUNCH
#define ONE_LAUNCH 1
#endif

#define DEVI __device__ __forceinline__
#define LAS __attribute__((address_space(3)))
typedef unsigned short bf16_t;
typedef short bf16x8 __attribute__((ext_vector_type(8)));
typedef float f32x4 __attribute__((ext_vector_type(4)));

constexpr int NB = 8, SEQ = 4096, DM = 1024, MTOK = NB * SEQ;
constexpr int INC = 1952;
constexpr int PROJ_LD = 2048;
constexpr int DFF = 2816, NEXP = 8;
constexpr int QLD = 768;
constexpr int KVLD = 1280;
constexpr float EPS = 1e-6f;
constexpr int PC_SBQ = 0, PC_SBK = 256, PC_SBV = 512, PC_CQ = 768, PC_CKQ = 1024, PC_CKK = 1280, PC_CKV = 1536, PC_LAT = 1792, PC_KPE = 1920;
constexpr int MOE_TILES = 136;
constexpr int MOE_ROWS = MOE_TILES * 256;

constexpr size_t MiB = 1u << 20;
constexpr size_t WS_CTL = 0, CTL_BYTES = 64 * 1024;
constexpr size_t WS_MOD = 1 * MiB;
constexpr size_t WS_COS = 2 * MiB, WS_SIN = 4 * MiB;
constexpr size_t WS_TOKE = 6 * MiB;
constexpr size_t WS_TOKW = 6 * MiB + 256 * 1024;
constexpr size_t WS_CNT = 6 * MiB + 512 * 1024;
constexpr size_t WS_PERM = 6 * MiB + 640 * 1024;
constexpr size_t WS_PERMW = 7 * MiB;
constexpr size_t WS_TEXP = 7 * MiB + 512 * 1024;
constexpr size_t WS_WIN = 8 * MiB;
constexpr size_t WS_WQ = 16 * MiB;
constexpr size_t WS_WKV = 17 * MiB;
constexpr size_t WS_WOUT = 19 * MiB;
constexpr size_t WS_FGU = 23 * MiB;
constexpr size_t WS_FD = 34 * MiB;
constexpr size_t WS_MGU = 40 * MiB;
constexpr size_t WS_MD = 128 * MiB;
constexpr size_t WS_H = 172 * MiB;
constexpr size_t WS_PROJ = 236 * MiB;
constexpr size_t WS_Q = 364 * MiB;
constexpr size_t WS_KV = 412 * MiB;
constexpr size_t WS_HID = 236 * MiB;
constexpr size_t WS_SSH = 492 * MiB;
constexpr size_t WS_RAT = 494 * MiB;
constexpr size_t WS_ALPHA = 494 * MiB + 512 * 1024;
constexpr size_t WS_XS2 = 440 * MiB;
constexpr size_t WS_PART = 172 * MiB;
constexpr size_t WS_END = 504 * MiB;
static_assert(WS_HID + (size_t)MOE_ROWS * DFF * 2 <= WS_END, "hid fits");
static_assert(WS_KV + (size_t)MTOK * KVLD * 2 <= WS_END, "kv fits");

DEVI float bf2f(bf16_t v) { return __builtin_bit_cast(float, (unsigned)v << 16); }
DEVI bf16_t f2bf(float f) { unsigned u = __builtin_bit_cast(unsigned, f); return (bf16_t)((u + 0x7fffu + ((u >> 16) & 1u)) >> 16); }
DEVI unsigned pk2(float lo, float hi) { return (unsigned)f2bf(lo) | ((unsigned)f2bf(hi) << 16); }
DEVI float lo16(unsigned u) { return __builtin_bit_cast(float, u << 16); }
DEVI float hi16(unsigned u) { return __builtin_bit_cast(float, u & 0xffff0000u); }
DEVI float wave_sum(float v) {
#pragma unroll
    for (int o = 32; o; o >>= 1) v += __shfl_xor(v, o, 64);
    return v;
}
DEVI float sum16(float v) {
#pragma unroll
    for (int o = 8; o; o >>= 1) v += __shfl_xor(v, o, 64);
    return v;
}
template <int N> DEVI void load_bf16_row(const bf16_t* p, float (&out)[N]) {
#pragma unroll
    for (int i = 0; i < N / 8; ++i) {
        const uint4 v = *(const uint4*)(p + 8 * i);
        out[8 * i + 0] = lo16(v.x); out[8 * i + 1] = hi16(v.x); out[8 * i + 2] = lo16(v.y); out[8 * i + 3] = hi16(v.y);
        out[8 * i + 4] = lo16(v.z); out[8 * i + 5] = hi16(v.z); out[8 * i + 6] = lo16(v.w); out[8 * i + 7] = hi16(v.w);
    }
}
template <int N> DEVI void store_bf16_row(bf16_t* p, const float (&v)[N]) {
#pragma unroll
    for (int i = 0; i < N / 8; ++i) {
        uint4 o; o.x = pk2(v[8 * i], v[8 * i + 1]); o.y = pk2(v[8 * i + 2], v[8 * i + 3]); o.z = pk2(v[8 * i + 4], v[8 * i + 5]); o.w = pk2(v[8 * i + 6], v[8 * i + 7]);
        *(uint4*)(p + 8 * i) = o;
    }
}

template <int N> DEVI float dot_bf16(const bf16_t* p, const float (&q)[N]) {
    float z0 = 0.f, z1 = 0.f;
#pragma unroll
    for (int i = 0; i < N / 8; ++i) {
        const uint4 v = *(const uint4*)(p + 8 * i);
        z0 += q[8 * i + 0] * lo16(v.x); z1 += q[8 * i + 1] * hi16(v.x); z0 += q[8 * i + 2] * lo16(v.y); z1 += q[8 * i + 3] * hi16(v.y);
        z0 += q[8 * i + 4] * lo16(v.z); z1 += q[8 * i + 5] * hi16(v.z); z0 += q[8 * i + 6] * lo16(v.w); z1 += q[8 * i + 7] * hi16(v.w);
    }
    return z0 + z1;
}
template <int N> DEVI void axpy_bf16(float (&acc)[N], float corr, float w, const bf16_t* p) {
#pragma unroll
    for (int i = 0; i < N / 8; ++i) {
        const uint4 v = *(const uint4*)(p + 8 * i);
        acc[8 * i + 0] = acc[8 * i + 0] * corr + w * lo16(v.x); acc[8 * i + 1] = acc[8 * i + 1] * corr + w * hi16(v.x);
        acc[8 * i + 2] = acc[8 * i + 2] * corr + w * lo16(v.y); acc[8 * i + 3] = acc[8 * i + 3] * corr + w * hi16(v.y);
        acc[8 * i + 4] = acc[8 * i + 4] * corr + w * lo16(v.z); acc[8 * i + 5] = acc[8 * i + 5] * corr + w * hi16(v.z);
        acc[8 * i + 6] = acc[8 * i + 6] * corr + w * lo16(v.w); acc[8 * i + 7] = acc[8 * i + 7] * corr + w * hi16(v.w);
    }
}

template <int N> DEVI float dot_bf16_pk(const bf16_t* p, const unsigned (&q)[N / 2]) {
    float z0 = 0.f, z1 = 0.f;
#pragma unroll
    for (int i = 0; i < N / 8; ++i) {
        const uint4 v = *(const uint4*)(p + 8 * i);
        z0 += lo16(q[4 * i + 0]) * lo16(v.x); z1 += hi16(q[4 * i + 0]) * hi16(v.x); z0 += lo16(q[4 * i + 1]) * lo16(v.y); z1 += hi16(q[4 * i + 1]) * hi16(v.y);
        z0 += lo16(q[4 * i + 2]) * lo16(v.z); z1 += hi16(q[4 * i + 2]) * hi16(v.z); z0 += lo16(q[4 * i + 3]) * lo16(v.w); z1 += hi16(q[4 * i + 3]) * hi16(v.w);
    }
    return z0 + z1;
}

#define XB_TMO      128
#define XB_XCNT(j)  (256  + 64 * (j))
#define XB_XSUB(j)  (1280 + 64 * (j))
#define XB_XGEN(j)  (2304 + 64 * (j))
#define XB_TOP      3328
#define XB_TOPGEN   3392
#define XCD_BAR_WORDS 3456
#define XB_SPIN_CAP (1u << 24)
DEVI unsigned xb_ld(unsigned* p)              { return __hip_atomic_load(p, __ATOMIC_RELAXED, __HIP_MEMORY_SCOPE_AGENT); }
DEVI unsigned xb_add(unsigned* p, unsigned v) { return __hip_atomic_fetch_add(p, v, __ATOMIC_RELAXED, __HIP_MEMORY_SCOPE_AGENT); }
DEVI unsigned xb_xcc_id() { return (unsigned)__builtin_amdgcn_s_getreg((3 << 11) | 20) & 0xFu; }
#define XB_SPIN(cond, bar) do { unsigned _sp = 0; while (cond) { __builtin_amdgcn_s_sleep(1); \
    if ((++_sp & 255u) == 0u) { if (xb_ld(&(bar)[XB_TMO])) break; if (_sp > XB_SPIN_CAP) { atomicAdd(&(bar)[XB_TMO], 1u); break; } } } } while (0)
struct XcdBarrier { unsigned* bar; unsigned x; volatile LAS unsigned* st; };
DEVI XcdBarrier xcd_barrier_post(unsigned* bar, volatile LAS unsigned* st) {
    XcdBarrier b; b.bar = bar; b.x = xb_xcc_id(); b.st = st;
    if (threadIdx.x == 0) (void)xb_add(&bar[XB_XCNT(b.x)], 1u);
    return b;
}
DEVI void xcd_barrier_complete(unsigned* bar, unsigned x, unsigned& nloc, unsigned& nx) {
    const unsigned G = gridDim.x * gridDim.y * gridDim.z;
    unsigned sum, cnt, mine, sp = 0u;
    for (;;) {
        sum = 0u; cnt = 0u; mine = 0u;
#pragma unroll
        for (unsigned j = 0; j < 16; ++j) { const unsigned c = xb_ld(&bar[XB_XCNT(j)]); sum += c; cnt += (c > 0u) ? 1u : 0u; mine = (j == x) ? c : mine; }
        if (sum == G) break;
        __builtin_amdgcn_s_sleep(1);
        if ((++sp & 255u) == 0u) { if (xb_ld(&bar[XB_TMO])) break; if (sp > XB_SPIN_CAP) { atomicAdd(&bar[XB_TMO], 1u); break; } }
    }
    nloc = mine > 0u ? mine : 1u; nx = cnt > 0u ? cnt : 1u;
}
DEVI void xcd_barrier(const XcdBarrier& b) {
    asm volatile("s_waitcnt vmcnt(0)" ::: "memory");
    __syncthreads();
    if (threadIdx.x == 0) {
        unsigned* bar = b.bar;
        __builtin_amdgcn_s_waitcnt(0);
        unsigned nloc = b.st[0], nx = b.st[1];
        if (nloc == 0u) { xcd_barrier_complete(bar, b.x, nloc, nx); b.st[0] = nloc; b.st[1] = nx; }
        const unsigned old = xb_add(&bar[XB_XSUB(b.x)], 1u);
        const unsigned gen = old / nloc;
        if (old + 1u == (gen + 1u) * nloc) {
            __builtin_amdgcn_fence(__ATOMIC_RELEASE, "agent");
            asm volatile("s_waitcnt vmcnt(0)" ::: "memory");
            const unsigned og = xb_add(&bar[XB_TOP], 1u);
            const unsigned tg = og / nx;
            if (og + 1u == (tg + 1u) * nx) xb_add(&bar[XB_TOPGEN], 1u);
            else XB_SPIN(xb_ld(&bar[XB_TOPGEN]) == tg, bar);
            __builtin_amdgcn_fence(__ATOMIC_ACQUIRE, "agent");
            xb_add(&bar[XB_XGEN(b.x)], 1u);
            asm volatile("s_waitcnt vmcnt(0)" ::: "memory");
        } else {
            XB_SPIN(xb_ld(&bar[XB_XGEN(b.x)]) == gen, bar);
            __builtin_amdgcn_fence(__ATOMIC_ACQUIRE, "agent");
            asm volatile("s_waitcnt vmcnt(0)" ::: "memory");
        }
    }
    __syncthreads();
}

struct Params {
    const float* in[26];
    float* out;
    unsigned char* ws;
};
enum { I_X = 0, I_C, I_POS, I_ADAW, I_ADAB, I_NMIX, I_NFFN, I_WIN, I_QNORM, I_WQUP, I_KVNORM, I_WKVUP, I_QQK, I_KQK, I_CKQN, I_CKKN, I_RELB, I_GON, I_WOUT,
       I_FG, I_FU, I_FD, I_ROUTER, I_MG, I_MU, I_MD };

struct Ctx {
    int bid, nblk, tid, lane, wid;
    float* sm;
    LAS unsigned char* ring;
};

enum { MAP_ID = 0, MAP_WIN, MAP_KV, MAP_GU };
template <int MAP>
DEVI void conv_job(const Ctx& c, const float* src, const float* src2, int src_ld, int Ksrc, const float* gain, bf16_t* dst, int Kdst, int nrows) {
    const int nrb = nrows / 32, nkb = Kdst / 64, total = nrb * nkb;
    float* tile = c.sm;
    for (int it = c.bid; it < total; it += c.nblk) {
        const int rb = it / nkb, kb = it % nkb, k0 = kb * 64;
        const float* s = src; int col = rb * 32;
        if (MAP == MAP_WIN) { const int r = rb * 32; col = r < 1024 ? r : r < 1792 ? 1184 + (r - 1024) : r < 1920 ? 1024 + (r - 1792) : r < 1952 ? 1152 : -1; }
        if (MAP == MAP_KV) { const int r = rb * 32, h = r / 160, o = r % 160; col = o < 64 ? 128 * h + o : o < 96 ? -1 : 128 * h + 64 + (o - 96); }
        if (MAP == MAP_GU) { const int t = rb >> 3, sb = rb & 7; s = (sb >> 2) ? src2 : src; col = 128 * t + 32 * (sb & 3); }
        for (int e = c.tid; e < 2048; e += 512) {
            const int kk = e >> 5, j = e & 31, k = k0 + kk;
            float v = 0.f;
            if (col >= 0 && k < Ksrc) { v = s[(size_t)k * src_ld + col + j]; if (gain) v *= gain[k]; }
            tile[kk * 33 + j] = v;
        }
        __syncthreads();
        for (int e = c.tid; e < 1024; e += 512) {
            const int j = e >> 5, kp = e & 31;
            *(unsigned*)(dst + (size_t)(rb * 32 + j) * Kdst + k0 + 2 * kp) = pk2(tile[(2 * kp) * 33 + j], tile[(2 * kp + 1) * 33 + j]);
        }
        __syncthreads();
    }
}


enum { MAP_Q = 4 };
template <int MAP>
DEVI void conv_job2(const Ctx& c, const float* __restrict__ src, const float* __restrict__ src2, int src_ld, int Ksrc, const float* __restrict__ gain, bf16_t* __restrict__ dst, int Kdst, int nrows) {
    const int nrb = nrows / 64, nkb = Kdst / 64, total = nrb * nkb;
    for (int it = c.bid * 8 + c.wid; it < total; it += c.nblk * 8) {
        const int kb = it / nrb, rb = it % nrb, n = rb * 64 + c.lane, k0 = kb * 64;
        const float* sp = src; int col = n;
        if (MAP == MAP_WIN) col = n < 1024 ? n : n < 1792 ? 1184 + (n - 1024) : n < 1920 ? 1024 + (n - 1792) : n < 1952 ? 1152 + (n - 1920) : -1;
        if (MAP == MAP_KV) { const int h = n / 160, o = n % 160; col = o < 64 ? 128 * h + o : o < 96 ? -1 : 128 * h + 64 + (o - 96); }
        if (MAP == MAP_GU) { const int t = n >> 8, r = n & 255; sp = (r >> 7) ? src2 : src; col = 128 * t + (r & 127); }
        if (MAP == MAP_Q) { const int h = n / 96, pos = n % 96; col = 96 * h + (pos < 64 ? pos : 64 + ((pos - 64) >> 1) + 16 * ((pos - 64) & 1)); }
        const bool live = (col >= 0);
        sp += live ? col : 0;
        bf16_t* dp = dst + (size_t)n * Kdst + k0;
        float v[64];
        if (live) {
#pragma unroll
            for (int j = 0; j < 64; ++j) v[j] = (k0 + j < Ksrc) ? __builtin_nontemporal_load(sp + (size_t)(k0 + j) * src_ld) : 0.f;
            if (gain) {
#pragma unroll
                for (int j = 0; j < 64; ++j) v[j] *= (k0 + j < Ksrc) ? gain[k0 + j] : 0.f;
            }
        } else {
#pragma unroll
            for (int j = 0; j < 64; ++j) v[j] = 0.f;
        }
#pragma unroll
        for (int k8 = 0; k8 < 8; ++k8) {
            uint4 o; o.x = pk2(v[8 * k8], v[8 * k8 + 1]); o.y = pk2(v[8 * k8 + 2], v[8 * k8 + 3]); o.z = pk2(v[8 * k8 + 4], v[8 * k8 + 5]); o.w = pk2(v[8 * k8 + 6], v[8 * k8 + 7]);
            *(uint4*)(dp + k8 * 8) = o;
        }
    }
}

template <int MAP>
DEVI void conv_job3(const Ctx& c, const float* __restrict__ src, const float* __restrict__ src2, int src_ld, int Ksrc, const float* __restrict__ gain, bf16_t* __restrict__ dst, int Kdst, int nrows) {
    const int nrb = nrows / 256, nkb = Kdst / 16, total = nrb * nkb;
    for (int it = c.bid * 8 + c.wid; it < total; it += c.nblk * 8) {
        const int kb = it % nkb, rb = it / nkb, n = rb * 256 + 4 * c.lane, k0 = kb * 16;
        const float* sp = src; int col = n;
        if (MAP == MAP_WIN) col = n < 1024 ? n : n < 1792 ? 1184 + (n - 1024) : n < 1920 ? 1024 + (n - 1792) : n < 1952 ? 1152 + (n - 1920) : -1;
        if (MAP == MAP_KV) { const int h = n / 160, o = n % 160; col = o < 64 ? 128 * h + o : o < 96 ? -1 : 128 * h + 64 + (o - 96); }
        if (MAP == MAP_GU) { const int t = n >> 8, r = n & 255; sp = (r >> 7) ? src2 : src; col = 128 * t + (r & 127); }
        const bool live = (col >= 0) && (k0 < Ksrc);
        f32x4 v[16];
        if (live) {
            sp += col;
#pragma unroll
            for (int j = 0; j < 16; ++j) v[j] = __builtin_nontemporal_load((const f32x4*)(sp + (size_t)(k0 + j) * src_ld));
            if (gain) {
#pragma unroll
                for (int j = 0; j < 16; ++j) v[j] *= gain[k0 + j];
            }
        } else {
#pragma unroll
            for (int j = 0; j < 16; ++j) v[j] = (f32x4){0.f, 0.f, 0.f, 0.f};
        }
#pragma unroll
        for (int i = 0; i < 4; ++i) {
            uint4 o0, o1;
            o0.x = pk2(v[0][i], v[1][i]); o0.y = pk2(v[2][i], v[3][i]); o0.z = pk2(v[4][i], v[5][i]); o0.w = pk2(v[6][i], v[7][i]);
            o1.x = pk2(v[8][i], v[9][i]); o1.y = pk2(v[10][i], v[11][i]); o1.z = pk2(v[12][i], v[13][i]); o1.w = pk2(v[14][i], v[15][i]);
            bf16_t* dp = dst + (size_t)(n + i) * Kdst + k0;
            *(uint4*)dp = o0; *(uint4*)(dp + 8) = o1;
        }
    }
}

template <int MAP>
DEVI void conv_rowblock(const Ctx& c, const float* __restrict__ src, const float* __restrict__ src2, int src_ld, int Ksrc, const float* __restrict__ gain, bf16_t* __restrict__ dst, int Kdst, int rb) {
    const int nkb = Kdst / 16;
    for (int kb = c.wid; kb < nkb; kb += 8) {
        const int n = rb * 256 + 4 * c.lane, k0 = kb * 16;
        const float* sp = src; int col = n;
        if (MAP == MAP_WIN) col = n < 1024 ? n : n < 1792 ? 1184 + (n - 1024) : n < 1920 ? 1024 + (n - 1792) : n < 1952 ? 1152 + (n - 1920) : -1;
        if (MAP == MAP_KV) { const int h = n / 160, o = n % 160; col = o < 64 ? 128 * h + o : o < 96 ? -1 : 128 * h + 64 + (o - 96); }
        if (MAP == MAP_GU) { const int t = n >> 8, r = n & 255; sp = (r >> 7) ? src2 : src; col = 128 * t + (r & 127); }
        const bool live = (col >= 0) && (k0 < Ksrc);
        f32x4 v[16];
        if (live) {
            sp += col;
#pragma unroll
            for (int j = 0; j < 16; ++j) v[j] = __builtin_nontemporal_load((const f32x4*)(sp + (size_t)(k0 + j) * src_ld));
            if (gain) {
#pragma unroll
                for (int j = 0; j < 16; ++j) v[j] *= gain[k0 + j];
            }
        } else {
#pragma unroll
            for (int j = 0; j < 16; ++j) v[j] = (f32x4){0.f, 0.f, 0.f, 0.f};
        }
#pragma unroll
        for (int i = 0; i < 4; ++i) {
            uint4 o0, o1;
            o0.x = pk2(v[0][i], v[1][i]); o0.y = pk2(v[2][i], v[3][i]); o0.z = pk2(v[4][i], v[5][i]); o0.w = pk2(v[6][i], v[7][i]);
            o1.x = pk2(v[8][i], v[9][i]); o1.y = pk2(v[10][i], v[11][i]); o1.z = pk2(v[12][i], v[13][i]); o1.w = pk2(v[14][i], v[15][i]);
            bf16_t* dp = dst + (size_t)(n + i) * Kdst + k0;
            *(uint4*)dp = o0; *(uint4*)(dp + 8) = o1;
        }
    }
}

#ifndef MOE_CONV_IN_ATT
#define MOE_CONV_IN_ATT 1
#endif
#ifndef PRO_SKIP
#define PRO_SKIP 0
#endif
DEVI void phase_prologue(const Ctx& c, const Params& p, int repi = 0) {
    unsigned char* ws = p.ws;
    const int skip = repi ? PRO_SKIP : 0;
    if (!(skip & 1))
    {
        LAS float* sc = (LAS float*)c.ring;
        float* part = c.sm;
        float* mod = (float*)(ws + WS_MOD);
        for (int e = c.tid; e < 8 * 1024; e += 512) { const float v = p.in[I_C][e]; sc[e] = v / (1.f + __expf(-v)); }
        __syncthreads();
        const int col_l = c.tid % 48, ks = c.tid / 48;
        for (int it = c.bid; it < 256; it += c.nblk) {
            const int gcol = it * 48 + col_l, l = gcol / 6144, col = gcol % 6144;
            if (ks < 8) {
                const float* w = p.in[I_ADAW] + (size_t)l * 1024 * 6144 + (size_t)(ks * 128) * 6144 + col;
                float acc[8];
#pragma unroll
                for (int b = 0; b < 8; ++b) acc[b] = 0.f;
#pragma unroll 1
                for (int k0 = 0; k0 < 128; k0 += 32) {
                    float wv[32];
#pragma unroll
                    for (int j = 0; j < 32; ++j) wv[j] = __builtin_nontemporal_load(w + (size_t)(k0 + j) * 6144);
#pragma unroll
                    for (int j = 0; j < 32; ++j)
#pragma unroll
                        for (int b = 0; b < 8; ++b) acc[b] += sc[b * 1024 + ks * 128 + k0 + j] * wv[j];
                }
#pragma unroll
                for (int b = 0; b < 8; ++b) part[(ks * 8 + b) * 48 + col_l] = acc[b];
            }
            __syncthreads();
            if (c.tid < 384) { const int b = c.tid / 48, cl = c.tid % 48;
              const int gc = it * 48 + cl, l2 = gc / 6144, c2 = gc % 6144;
              float a = 0.f;
#pragma unroll
              for (int k2 = 0; k2 < 8; ++k2) a += part[(k2 * 8 + b) * 48 + cl];
              mod[(l2 * 8 + b) * 6144 + c2] = a + p.in[I_ADAB][l2 * 6144 + c2]; }
            __syncthreads();
        }
        __syncthreads();
    }
    if (!(skip & 2)) {
        float* cs = (float*)(ws + WS_COS); float* sn = (float*)(ws + WS_SIN);
        const int* pos = (const int*)p.in[I_POS];
        for (int e = c.bid * 512 + c.tid; e < MTOK * 16; e += c.nblk * 512) {
            const int m = e >> 4, i = e & 15;
            const float inv_freq = powf(10000.0f, -(float)(2 * i) / 32.0f);
            const float ang = (float)pos[m] * inv_freq;
            cs[e] = cosf(ang); sn[e] = sinf(ang);
        }
    }
    if (!(skip & 8)) for (int l = 0; l < 2; ++l) {
        conv_job3<MAP_WIN>(c, p.in[I_WIN] + (size_t)l * 1024 * INC, nullptr, INC, 1024, nullptr, (bf16_t*)(ws + WS_WIN) + (size_t)l * 2048 * 1024, 1024, 2048);
        conv_job2<MAP_Q>(c, p.in[I_WQUP] + (size_t)l * 256 * 768, nullptr, 768, 256, p.in[I_QNORM] + l * 256, (bf16_t*)(ws + WS_WQ) + (size_t)l * 768 * 256, 256, 768);
        conv_job3<MAP_KV>(c, p.in[I_WKVUP] + (size_t)l * 128 * 1024, nullptr, 1024, 128, p.in[I_KVNORM] + l * 128, (bf16_t*)(ws + WS_WKV) + (size_t)l * 1280 * 256, 256, 1280);
        conv_job3<MAP_ID>(c, p.in[I_WOUT] + (size_t)l * 1024 * 1024, nullptr, 1024, 1024, p.in[I_GON] + l * 1024, (bf16_t*)(ws + WS_WOUT) + (size_t)l * 1024 * 1024, 1024, 1024);
    }
    if (!(skip & 8)) conv_job3<MAP_GU>(c, p.in[I_FG], p.in[I_FU], DFF, 1024, nullptr, (bf16_t*)(ws + WS_FGU), 1024, 5632);
    if (!(skip & 8)) conv_job3<MAP_ID>(c, p.in[I_FD], nullptr, 1024, DFF, nullptr, (bf16_t*)(ws + WS_FD), DFF, 1024);
    if (!(skip & 4) && !MOE_CONV_IN_ATT) for (int e = 0; e < NEXP; ++e) {
        conv_job3<MAP_GU>(c, p.in[I_MG] + (size_t)e * 1024 * DFF, p.in[I_MU] + (size_t)e * 1024 * DFF, DFF, 1024, nullptr, (bf16_t*)(ws + WS_MGU) + (size_t)e * 5632 * 1024, 1024, 5632);
        conv_job3<MAP_ID>(c, p.in[I_MD] + (size_t)e * DFF * 1024, nullptr, 1024, DFF, nullptr, (bf16_t*)(ws + WS_MD) + (size_t)e * 1024 * DFF, DFF, 1024);
    }
}

template <bool BF> DEVI f32x4 pg8_ld4(const void* base, size_t idx) {
    if constexpr (BF) { const uint2 v = *(const uint2*)((const bf16_t*)base + idx); return (f32x4){lo16(v.x), hi16(v.x), lo16(v.y), hi16(v.y)}; }
    else return *(const f32x4*)((const float*)base + idx);
}
DEVI float reduce8(const float (&lg)[8], int lane) {
    float t[4], u[2], v;
    const bool b5 = lane & 32, b4 = lane & 16, b3 = lane & 8;
#pragma unroll
    for (int e = 0; e < 4; ++e) { const float keep = b5 ? lg[e + 4] : lg[e], send = b5 ? lg[e] : lg[e + 4]; t[e] = keep + __shfl_xor(send, 32, 64); }
#pragma unroll
    for (int e = 0; e < 2; ++e) { const float keep = b4 ? t[e + 2] : t[e], send = b4 ? t[e] : t[e + 2]; u[e] = keep + __shfl_xor(send, 16, 64); }
    { const float keep = b3 ? u[1] : u[0], send = b3 ? u[0] : u[1]; v = keep + __shfl_xor(send, 8, 64); }
    v += __shfl_xor(v, 4, 64); v += __shfl_xor(v, 2, 64); v += __shfl_xor(v, 1, 64);
    return v;
}
template <bool ROUTER, bool XBF>
DEVI void phase_norm(const Ctx& c, const Params& p, const void* __restrict__ x, const float* __restrict__ gain, const float* __restrict__ sh, const float* __restrict__ sc  ) {
    bf16_t* __restrict__ h = (bf16_t*)(p.ws + WS_H);
    int* sm_e = (int*)c.sm;
    constexpr int NR = 2;
    LAS f32x4* wl = (LAS f32x4*)c.ring;
    if (ROUTER) {
        for (int e4 = c.tid; e4 < 2048; e4 += 512) {
            const int col = e4 >> 1, half = e4 & 1, ln = (col >> 2) & 63, i = col >> 8, j = col & 3;
            wl[((i * 4 + j) * 2 + half) * 64 + ln] = *(const f32x4*)(p.in[I_ROUTER] + (size_t)col * 8 + 4 * half);
        }
        __syncthreads();
    }
#pragma unroll 1
    for (int ch = c.bid; ch < MTOK / 128; ch += c.nblk) {
#pragma unroll 1
        for (int rr = 0; rr < 16; rr += NR) {
            if (ROUTER) asm volatile("" ::: "memory");
            const int rloc = c.wid * 16 + rr, row = ch * 128 + rloc, b = row / SEQ;
            f32x4 v[NR][4]; float ss[NR];
#pragma unroll
            for (int q = 0; q < NR; ++q)
#pragma unroll
                for (int i = 0; i < 4; ++i) v[q][i] = pg8_ld4<XBF>(x, (size_t)(row + q) * DM + 4 * (c.lane + 64 * i));
#pragma unroll
            for (int q = 0; q < NR; ++q) { float a = 0.f;
#pragma unroll
                for (int i = 0; i < 4; ++i) a += v[q][i][0] * v[q][i][0] + v[q][i][1] * v[q][i][1] + v[q][i][2] * v[q][i][2] + v[q][i][3] * v[q][i][3];
                ss[q] = a; }
            float rstdv[NR];
#pragma unroll
            for (int q = 0; q < NR; ++q) rstdv[q] = rsqrtf(wave_sum(ss[q]) * (1.f / DM) + EPS);
            float lg[NR][8];
#pragma unroll
            for (int q = 0; q < NR; ++q)
#pragma unroll
                for (int e = 0; e < 8; ++e) lg[q][e] = 0.f;
#pragma unroll
            for (int i = 0; i < 4; ++i) {
                const int col = 4 * (c.lane + 64 * i);
                const f32x4 g = *(const f32x4*)(gain + col), s1 = *(const f32x4*)(sc + b * 6144 + col), s0 = *(const f32x4*)(sh + b * 6144 + col);
                f32x4 o[NR];
#pragma unroll
                for (int q = 0; q < NR; ++q) {
#pragma unroll
                    for (int j = 0; j < 4; ++j) o[q][j] = v[q][i][j] * rstdv[q] * g[j] * (1.f + s1[j]) + s0[j];
                    uint2 pk; pk.x = pk2(o[q][0], o[q][1]); pk.y = pk2(o[q][2], o[q][3]);
                    *(uint2*)(h + (size_t)(row + q) * DM + col) = pk;
                }
                if (ROUTER) {
                    asm volatile("" ::: "memory");
#pragma unroll
                    for (int j = 0; j < 4; ++j) {
                        const f32x4 w0 = wl[((i * 4 + j) * 2) * 64 + c.lane], w1 = wl[((i * 4 + j) * 2 + 1) * 64 + c.lane];
#pragma unroll
                        for (int q = 0; q < NR; ++q) {
                            lg[q][0] += o[q][j] * w0[0]; lg[q][1] += o[q][j] * w0[1]; lg[q][2] += o[q][j] * w0[2]; lg[q][3] += o[q][j] * w0[3];
                            lg[q][4] += o[q][j] * w1[0]; lg[q][5] += o[q][j] * w1[1]; lg[q][6] += o[q][j] * w1[2]; lg[q][7] += o[q][j] * w1[3];
                        }
                    }
                }
            }
            if (ROUTER) {
#pragma unroll
                for (int q = 0; q < NR; ++q) {
                    const float mine = reduce8(lg[q], c.lane);
                    float l8[8];
#pragma unroll
                    for (int e = 0; e < 8; ++e) l8[e] = __builtin_bit_cast(float, __builtin_amdgcn_readlane(__builtin_bit_cast(int, mine), 8 * e));
                    int e0 = 0; float v0 = l8[0];
#pragma unroll
                    for (int e = 1; e < 8; ++e) if (l8[e] > v0) { v0 = l8[e]; e0 = e; }
                    int e1 = -1; float v1 = -3.0e38f;
#pragma unroll
                    for (int e = 0; e < 8; ++e) if (e != e0 && l8[e] > v1) { v1 = l8[e]; e1 = e; }
                    const float t = __expf(v1 - v0), w0 = 1.f / (1.f + t), w1 = t / (1.f + t);
                    if (c.lane == 0) {
                        int* te = (int*)(p.ws + WS_TOKE); float* tw = (float*)(p.ws + WS_TOKW);
                        te[(row + q) * 2] = e0; te[(row + q) * 2 + 1] = e1; tw[(row + q) * 2] = w0; tw[(row + q) * 2 + 1] = w1;
                        sm_e[rloc + q] = e0; sm_e[128 + rloc + q] = e1;
                    }
                }
            }
        }
        if (ROUTER) {
            __syncthreads();
            if (c.tid < 16) { const int s = c.tid >> 3, e = c.tid & 7; int n = 0; for (int i = 0; i < 128; ++i) n += (sm_e[s * 128 + i] == e); ((int*)(p.ws + WS_CNT))[ch * 16 + c.tid] = n; }
            __syncthreads();
        }
    }
}

struct GemmDesc {
    const bf16_t* A; int lda; const bf16_t* Bt; int ldb; int M, N, K;
    const int* rowidx;
    const int* tile_expert;
    size_t expert_stride;
    const int* ntiles;
};
template <bool DUAL, class Epi>
DEVI void gemm_simple(const Ctx& c, const GemmDesc& g, const Epi& epi) {
    const int fr = c.lane & 15, fq = c.lane >> 4;
    const int Mrows = g.ntiles ? (*g.ntiles) * 256 : g.M;
    const int ntn = DUAL ? (g.N / 256) * 4 : g.N / 64, ntm = Mrows / 32;
    const long total = (long)ntm * ntn;
    for (long u = (long)c.bid * 8 + c.wid; u < total; u += (long)c.nblk * 8) {
        const int mt = (int)(u / ntn), nt = (int)(u % ntn), row0 = mt * 32;
        const bf16_t* Bt = g.Bt;
        if (g.tile_expert) Bt += (size_t)g.tile_expert[row0 >> 8] * g.expert_stride;
        int colb[4];
        if (DUAL) { const int t = nt >> 2, s = nt & 3; colb[0] = 256 * t + 32 * s; colb[1] = colb[0] + 16; colb[2] = colb[0] + 128; colb[3] = colb[2] + 16; }
        else {
#pragma unroll
            for (int i = 0; i < 4; ++i) colb[i] = nt * 64 + 16 * i;
        }
        int r0 = row0 + fr, r1 = row0 + 16 + fr;
        if (g.rowidx) { r0 = g.rowidx[r0]; r1 = g.rowidx[r1]; r0 = r0 < 0 ? 0 : r0; r1 = r1 < 0 ? 0 : r1; }
        const bf16_t* a0 = g.A + (size_t)r0 * g.lda + fq * 8; const bf16_t* a1 = g.A + (size_t)r1 * g.lda + fq * 8;
        const bf16_t* b0 = Bt + (size_t)(colb[0] + fr) * g.ldb + fq * 8; const bf16_t* b1 = Bt + (size_t)(colb[1] + fr) * g.ldb + fq * 8;
        const bf16_t* b2 = Bt + (size_t)(colb[2] + fr) * g.ldb + fq * 8; const bf16_t* b3 = Bt + (size_t)(colb[3] + fr) * g.ldb + fq * 8;
        f32x4 acc[2][4];
#pragma unroll
        for (int m = 0; m < 2; ++m)
#pragma unroll
            for (int i = 0; i < 4; ++i) acc[m][i] = (f32x4){0.f, 0.f, 0.f, 0.f};
        for (int k = 0; k < g.K; k += 32) {
            const bf16x8 af0 = *(const bf16x8*)(a0 + k), af1 = *(const bf16x8*)(a1 + k);
            const bf16x8 bf0 = *(const bf16x8*)(b0 + k), bf1 = *(const bf16x8*)(b1 + k), bf2 = *(const bf16x8*)(b2 + k), bf3 = *(const bf16x8*)(b3 + k);
            acc[0][0] = __builtin_amdgcn_mfma_f32_16x16x32_bf16(af0, bf0, acc[0][0], 0, 0, 0);
            acc[0][1] = __builtin_amdgcn_mfma_f32_16x16x32_bf16(af0, bf1, acc[0][1], 0, 0, 0);
            acc[0][2] = __builtin_amdgcn_mfma_f32_16x16x32_bf16(af0, bf2, acc[0][2], 0, 0, 0);
            acc[0][3] = __builtin_amdgcn_mfma_f32_16x16x32_bf16(af0, bf3, acc[0][3], 0, 0, 0);
            acc[1][0] = __builtin_amdgcn_mfma_f32_16x16x32_bf16(af1, bf0, acc[1][0], 0, 0, 0);
            acc[1][1] = __builtin_amdgcn_mfma_f32_16x16x32_bf16(af1, bf1, acc[1][1], 0, 0, 0);
            acc[1][2] = __builtin_amdgcn_mfma_f32_16x16x32_bf16(af1, bf2, acc[1][2], 0, 0, 0);
            acc[1][3] = __builtin_amdgcn_mfma_f32_16x16x32_bf16(af1, bf3, acc[1][3], 0, 0, 0);
        }
#pragma unroll
        for (int m = 0; m < 2; ++m)
#pragma unroll
            for (int r = 0; r < 4; ++r) {
                const int row = row0 + 16 * m + 4 * fq + r;
                if (DUAL) {
                    const int t = nt >> 2, s = nt & 3, j0 = 128 * t + 32 * s + fr;
                    epi(row, j0, acc[m][0][r], acc[m][2][r]);
                    epi(row, j0 + 16, acc[m][1][r], acc[m][3][r]);
                } else {
#pragma unroll
                    for (int i = 0; i < 4; ++i) epi(row, colb[i] + fr, acc[m][i][r], 0.f);
                }
            }
    }
}

struct EpiStoreBf16 { bf16_t* O; int ldo; DEVI void operator()(int row, int col, float v, float) const { O[(size_t)row * ldo + col] = f2bf(v); } };
struct EpiResid {
    const float* xin; float* out; const float* gate;
    DEVI void operator()(int row, int col, float v, float) const { const int b = row / SEQ; out[(size_t)row * DM + col] = xin[(size_t)row * DM + col] + gate[b * 6144 + col] * v; }
};
struct EpiSwiglu { bf16_t* H; DEVI void operator()(int row, int j, float g, float u) const { H[(size_t)row * DFF + j] = f2bf(g / (1.f + __expf(-g)) * u); } };
struct EpiMoeDown {
    float* out; const float* gate; const int* perm; const float* permw;
    DEVI void operator()(int pos, int col, float v, float) const {
        const int tok = perm[pos]; if (tok < 0) return;
        const int b = tok / SEQ; out[(size_t)tok * DM + col] += gate[b * 6144 + col] * permw[pos] * v;
    }
};


namespace pg8 {
typedef unsigned u32x4 __attribute__((ext_vector_type(4)));
constexpr int BM = 256, BK = 64, HALF = 128, HTB = HALF * BK * 2, STAGE_BYTES = 8 * HTB, NXCD = 8, WGM = 8;
__host__ __device__ __forceinline__ int lds_byte(int r, int c) { const int st = (r >> 4) * 2 + (c >> 5), rr = r & 15, cc = c & 31, ob = rr * 64 + cc * 2; return st * 1024 + (ob ^ (((ob >> 9) & 1) << 5)); }
__host__ __device__ __forceinline__ void stage_rc(int b, int& R, int& C) { const int st = b / 1024, sb = b % 1024, swz = sb ^ (((sb >> 9) & 1) << 5); R = (st >> 1) * 16 + swz / 64; C = (st & 1) * 32 + (swz % 64) / 2; }
__host__ __device__ __forceinline__ int perm32(int rho) { const int n = rho >> 4, i = rho & 15; return 8 * (i >> 2) + 4 * n + (i & 3); }
struct Unit { int pm, pn, ks; };
struct StaticOrder {
    int nM, nN, nwg, G, c;
    __device__ void init(int nM_, int nN_, int G_, int c_) { nM = nM_; nN = nN_; nwg = nM * nN; G = G_; c = c_; }
    __device__ bool next(int i, Unit& u) const { return unit_of((long)i * G + c, u); }
    __device__ bool unit_of(long L, Unit& u) const {
        if (L >= nwg) return false;
        int wgid = (int)L; { const int q = nwg / NXCD, r = nwg % NXCD, xcd = wgid % NXCD, off = wgid / NXCD; wgid = (xcd < r ? xcd * (q + 1) : r * (q + 1) + (xcd - r) * q) + off; }
        const int nig = WGM * nN, gid = wgid / nig, fm = gid * WGM, gsz = (nM - fm) < WGM ? (nM - fm) : WGM;
        u.pm = fm + ((wgid % nig) % gsz); u.pn = (wgid % nig) / gsz; u.ks = 0; return true;
    }
};
DEVI unsigned cvt_pk_bf16(float lo, float hi) { unsigned r; asm volatile("v_cvt_pk_bf16_f32 %0, %1, %2" : "=v"(r) : "v"(lo), "v"(hi)); return r; }

struct NoRowScale { static constexpr bool ON = false; DEVI void load(int, int, int, int, float (&)[8]) const {} };
struct GroupRowScale {
    static constexpr bool ON = true; const float* rat;
    DEVI void load(int pm, int wr, int fr, int sel, float (&f)[8]) const {
#pragma unroll
        for (int ai = 0; ai < 2; ++ai)
#pragma unroll
            for (int m = 0; m < 4; ++m) f[ai * 4 + m] = rat[(unsigned)((pm * BM + ai * HALF + wr * 64 + m * 16 + fr) * 4 + sel)];
    }
};
template <class Epi, class Prob, bool GATHER = false, bool ALIGN_EPI = true, class RS = NoRowScale>
DEVI void gemm_phase(LAS unsigned char* lds, const Prob& P, const Epi& E, int tid_in, const RS& rs = RS()) {
    const int tid = tid_in, wid = __builtin_amdgcn_readfirstlane(tid >> 6), lane = tid & 63, wr = wid >> 2, wc = wid & 3, fr = lane & 15, fq = lane >> 4;
    int nt = P.nt_of_first();
    int RA[2], CA[2];
    unsigned voffA[2], voffB[2];
#pragma unroll
    for (int i = 0; i < 2; ++i) { int R, C; stage_rc(tid * 16 + i * 8192, R, C); const int Rb = Epi::PERM ? ((R & ~31) + perm32(R & 31)) : R;
        RA[i] = R; CA[i] = C; voffA[i] = (unsigned)(R * P.lda + C) * 2u; voffB[i] = (unsigned)(Rb * P.ldb + C) * 2u; }
    const size_t kstep = (size_t)(BK * 2);
    const size_t hstepA = (size_t)HALF * P.lda * 2, hstepB = (size_t)HALF * P.ldb * 2;
    const unsigned ldsw = (unsigned)wid * 1024u;
    const int aoff = lds_byte(wr * 64 + fr, fq * 8), boff = lds_byte(wc * 32 + fr, fq * 8);
#define PG8_SA(b, h) (((b) * 2 + (h)) * HTB)
#define PG8_SB(b, h) ((4 + (b) * 2 + (h)) * HTB)
#define PG8_STAGE(bufoff, gbase, voff) do { _Pragma("unroll") for (int _i = 0; _i < 2; ++_i) \
        __builtin_amdgcn_global_load_lds((const unsigned*)((const char*)(gbase) + (voff)[_i]), (LAS unsigned*)(lds + (bufoff) + ldsw + _i * 8192), 16, 0, 0); } while (0)
#define PG8_LDA(dst, b, h) do { _Pragma("unroll") for (int m = 0; m < 4; ++m) _Pragma("unroll") for (int k = 0; k < 2; ++k) dst[m][k] = *(const LAS bf16x8*)(lds + PG8_SA(b, h) + aoff + m * 2048 + k * 1024); } while (0)
#define PG8_LDB(dst, b, h) do { _Pragma("unroll") for (int n = 0; n < 2; ++n) _Pragma("unroll") for (int k = 0; k < 2; ++k) dst[n][k] = *(const LAS bf16x8*)(lds + PG8_SB(b, h) + boff + n * 2048 + k * 1024); } while (0)
#define PG8_MMA(ai, bj, At, Bt) do { __builtin_amdgcn_s_setprio(1); _Pragma("unroll") for (int m = 0; m < 4; ++m) _Pragma("unroll") for (int n = 0; n < 2; ++n) _Pragma("unroll") for (int k = 0; k < 2; ++k) \
        acc[ai][bj][m][n] = __builtin_amdgcn_mfma_f32_16x16x32_bf16(Bt[n][k], At[m][k], acc[ai][bj][m][n], 0, 0, 0); __builtin_amdgcn_s_setprio(0); } while (0)
#define PG8_WAIT_V(n) asm volatile("s_waitcnt vmcnt(" #n ")" ::: "memory")
#define PG8_WAIT_L(n) asm volatile("s_waitcnt lgkmcnt(" #n ")" ::: "memory")
#define PG8_BAR __builtin_amdgcn_s_barrier()
#define PG8_SCHED __builtin_amdgcn_sched_barrier(0)
#define PG8_STAGE_A(bufoff, ptr, h, vG) do { if constexpr (GATHER) PG8_STAGE(bufoff, ptr, vG[h]); else PG8_STAGE(bufoff, (ptr) + (h) * hstepA, voffA); } while (0)
    Unit cur, nxt; int ui = 0;
    if (!P.next(0, cur)) return;
    f32x4 acc[2][2][4][2];
#pragma unroll
    for (int a = 0; a < 2; ++a)
#pragma unroll
        for (int b = 0; b < 2; ++b)
#pragma unroll
            for (int m = 0; m < 4; ++m)
#pragma unroll
                for (int n = 0; n < 2; ++n) acc[a][b][m][n] = (f32x4){0.f, 0.f, 0.f, 0.f};
    bf16x8 At[4][2], B0[2][2], B1[2][2];
    unsigned vAc[2][2] = {{0u, 0u}, {0u, 0u}}, vAn[2][2] = {{0u, 0u}, {0u, 0u}};
#define PG8_RSCALE(arr) do { _Pragma("unroll") for (int a_ = 0; a_ < 2; ++a_) _Pragma("unroll") for (int m_ = 0; m_ < 4; ++m_) _Pragma("unroll") for (int b_ = 0; b_ < 2; ++b_) _Pragma("unroll") for (int n_ = 0; n_ < 2; ++n_) acc[a_][b_][m_][n_] *= arr[a_ * 4 + m_]; } while (0)
    const char* cA; const char* cB = P.b_tile(cur);
    if constexpr (GATHER) { cA = P.a_base();
#pragma unroll
        for (int h = 0; h < 2; ++h)
#pragma unroll
            for (int i = 0; i < 2; ++i) vAc[h][i] = P.a_rowoff(0, h * HALF + RA[i]) + (unsigned)CA[i] * 2u;
    } else { cA = P.a_tile(cur); }
    PG8_STAGE(PG8_SB(0, 0), cB, voffB); PG8_STAGE(PG8_SB(0, 1), cB + hstepB, voffB); PG8_STAGE_A(PG8_SA(0, 0), cA, 0, vAc); PG8_STAGE_A(PG8_SA(0, 1), cA, 1, vAc);
    if (wr == 1) PG8_BAR;
    PG8_WAIT_V(2); PG8_BAR;
    PG8_STAGE(PG8_SB(1, 0), cB + kstep, voffB); PG8_STAGE_A(PG8_SA(1, 0), cA + kstep, 0, vAc); PG8_STAGE(PG8_SB(1, 1), cB + hstepB + kstep, voffB);
    PG8_WAIT_V(6); PG8_BAR;
    for (;;) {
        const bool has_next = P.next(ui + 1, nxt);
        nt = P.nt_of(cur);
        const char* nA; const char* nB = has_next ? P.b_tile(nxt) : cB;
        if constexpr (GATHER) { nA = cA;
#pragma unroll
            for (int h = 0; h < 2; ++h)
#pragma unroll
                for (int i = 0; i < 2; ++i) vAn[h][i] = has_next ? P.a_rowoff(ui + 1, h * HALF + RA[i]) + (unsigned)CA[i] * 2u : vAc[h][i];
        } else { nA = has_next ? P.a_tile(nxt) : cA; }
        for (int t = 0; t < nt; t += 2) {
            const bool last = (t == nt - 2);
            if constexpr (RS::ON) { if (t == 4 || t == 12) { float rsf[8]; rs.load(cur.pm, wr, fr, t == 4 ? 0 : 1, rsf); PG8_RSCALE(rsf); } }
            const char* a1 = cA + (size_t)(t + 1) * kstep;
            const char* a2 = last ? nA : cA + (size_t)(t + 2) * kstep; const char* b2 = last ? nB : cB + (size_t)(t + 2) * kstep;
            const char* a3 = a2 + kstep; const char* b3 = b2 + kstep;
            unsigned vA2[2][2];
#pragma unroll
            for (int h = 0; h < 2; ++h)
#pragma unroll
                for (int i = 0; i < 2; ++i) vA2[h][i] = (GATHER && last) ? vAn[h][i] : vAc[h][i];
            PG8_LDB(B0, 0, 0); PG8_LDB(B1, 0, 1); PG8_SCHED; PG8_LDA(At, 0, 0); PG8_STAGE_A(PG8_SA(1, 1), a1, 1, vAc);
            PG8_WAIT_V(8); PG8_WAIT_L(0); PG8_BAR; PG8_MMA(0, 0, At, B0); PG8_MMA(0, 1, At, B1); PG8_BAR; PG8_SCHED;
            PG8_LDA(At, 0, 1); PG8_STAGE(PG8_SB(0, 0), b2, voffB); PG8_STAGE(PG8_SB(0, 1), b2 + hstepB, voffB); PG8_STAGE_A(PG8_SA(0, 0), a2, 0, vA2);
            PG8_WAIT_V(8); PG8_WAIT_L(0); PG8_BAR; PG8_MMA(1, 0, At, B0); PG8_MMA(1, 1, At, B1); PG8_BAR; PG8_SCHED;
            PG8_LDB(B0, 1, 0); PG8_LDB(B1, 1, 1); PG8_SCHED; PG8_LDA(At, 1, 0); PG8_STAGE_A(PG8_SA(0, 1), a2, 1, vA2);
            PG8_WAIT_V(8); PG8_WAIT_L(0); PG8_BAR; PG8_MMA(0, 0, At, B0); PG8_MMA(0, 1, At, B1); PG8_BAR; PG8_SCHED;
            PG8_LDA(At, 1, 1); PG8_STAGE(PG8_SB(1, 0), b3, voffB); PG8_STAGE(PG8_SB(1, 1), b3 + hstepB, voffB); PG8_STAGE_A(PG8_SA(1, 0), a3, 0, vA2);
            PG8_WAIT_V(8); PG8_WAIT_L(0); PG8_BAR; PG8_MMA(1, 0, At, B0); PG8_MMA(1, 1, At, B1); PG8_BAR; PG8_SCHED;
        }
        if constexpr (ALIGN_EPI) { if (wr == 0) PG8_BAR; }
        if constexpr (RS::ON) { float rsf[8]; rs.load(cur.pm, wr, fr, 2, rsf); PG8_RSCALE(rsf); }
        E(acc, cur, wr, wc, fr, fq);
        if (!has_next) break;
#pragma unroll
        for (int a = 0; a < 2; ++a)
#pragma unroll
            for (int b = 0; b < 2; ++b)
#pragma unroll
                for (int m = 0; m < 4; ++m)
#pragma unroll
                    for (int n = 0; n < 2; ++n) acc[a][b][m][n] = (f32x4){0.f, 0.f, 0.f, 0.f};
        cur = nxt; cA = nA; cB = nB; ++ui;
        if constexpr (GATHER) {
#pragma unroll
            for (int h = 0; h < 2; ++h)
#pragma unroll
                for (int i = 0; i < 2; ++i) vAc[h][i] = vAn[h][i];
        }
        if constexpr (ALIGN_EPI) { if (wr == 1) PG8_BAR; }
    }
    PG8_WAIT_V(0);
    if constexpr (!ALIGN_EPI) { if (wr == 0) PG8_BAR; }
    PG8_BAR;
#undef PG8_SA
#undef PG8_RSCALE
#undef PG8_SB
#undef PG8_STAGE
#undef PG8_STAGE_A
#undef PG8_LDA
#undef PG8_LDB
#undef PG8_MMA
#undef PG8_WAIT_V
#undef PG8_WAIT_L
#undef PG8_BAR
#undef PG8_SCHED
}

typedef f32x4 Acc[2][2][4][2];
struct EpiStoreT {
    static constexpr bool PERM = true;
    bf16_t* O; int ldc; bf16_t* O2; int ldc2; int split_pn;
    DEVI void operator()(const Acc& acc, const Unit& u, int wr, int wc, int fr, int fq) const {
        const int row0 = u.pm * BM + wr * 64 + fr;
        bf16_t* base = O; int ld = ldc, pn = u.pn;
        if (pn >= split_pn) { base = O2; ld = ldc2; pn -= split_pn; }
        const int col0 = pn * BM + wc * 32 + 8 * fq;
#pragma unroll
        for (int ai = 0; ai < 2; ++ai)
#pragma unroll
            for (int m = 0; m < 4; ++m) { bf16_t* rowp = base + (size_t)(row0 + ai * HALF + m * 16) * ld + col0;
#pragma unroll
                for (int bj = 0; bj < 2; ++bj) { const f32x4 v0 = acc[ai][bj][m][0], v1 = acc[ai][bj][m][1];
                    u32x4 w; w.x = cvt_pk_bf16(v0[0], v0[1]); w.y = cvt_pk_bf16(v0[2], v0[3]); w.z = cvt_pk_bf16(v1[0], v1[1]); w.w = cvt_pk_bf16(v1[2], v1[3]);
                    *(u32x4*)(rowp + bj * HALF) = w; } }
    }
};
struct F8 { f32x4 lo, hi; };
template <bool BF> DEVI F8 ld8(const void* base, size_t idx) {
    F8 r;
    if constexpr (BF) { const u32x4 v = *(const u32x4*)((const bf16_t*)base + idx); r.lo = (f32x4){lo16(v.x), hi16(v.x), lo16(v.y), hi16(v.y)}; r.hi = (f32x4){lo16(v.z), hi16(v.z), lo16(v.w), hi16(v.w)}; }
    else { r.lo = *(const f32x4*)((const float*)base + idx); r.hi = *(const f32x4*)((const float*)base + idx + 4); }
    return r;
}
template <bool BF> DEVI void st8(void* base, size_t idx, const f32x4& lo, const f32x4& hi) {
    if constexpr (BF) { u32x4 o; o.x = cvt_pk_bf16(lo[0], lo[1]); o.y = cvt_pk_bf16(lo[2], lo[3]); o.z = cvt_pk_bf16(hi[0], hi[1]); o.w = cvt_pk_bf16(hi[2], hi[3]); *(u32x4*)((bf16_t*)base + idx) = o; }
    else { *(f32x4*)((float*)base + idx) = lo; *(f32x4*)((float*)base + idx + 4) = hi; }
}
template <bool XBF, bool OBF>
struct EpiResidT {
    static constexpr bool PERM = true;
    const void* xin; void* out; const float* gate;
    DEVI void operator()(const Acc& acc, const Unit& u, int wr, int wc, int fr, int fq) const {
        const int row0 = u.pm * BM + wr * 64 + fr, col0 = u.pn * BM + wc * 32 + 8 * fq, b = (u.pm * BM) / SEQ;
        const float* gp = gate + b * 6144 + col0;
#pragma unroll
        for (int bj = 0; bj < 2; ++bj) {
            const f32x4 g0 = *(const f32x4*)(gp + bj * HALF), g1 = *(const f32x4*)(gp + bj * HALF + 4);
            constexpr int RB = XBF ? 4 : 2;
#pragma unroll
            for (int ai = 0; ai < 2; ++ai)
#pragma unroll
                for (int m0 = 0; m0 < 4; m0 += RB) {
                    F8 xv[RB];
#pragma unroll
                    for (int m = 0; m < RB; ++m) xv[m] = ld8<XBF>(xin, (size_t)(row0 + ai * HALF + (m0 + m) * 16) * DM + col0 + bj * HALF);
                    asm volatile("" ::: "memory");
#pragma unroll
                    for (int m = 0; m < RB; ++m) st8<OBF>(out, (size_t)(row0 + ai * HALF + (m0 + m) * 16) * DM + col0 + bj * HALF, xv[m].lo + g0 * acc[ai][bj][m0 + m][0], xv[m].hi + g1 * acc[ai][bj][m0 + m][1]);
                    asm volatile("" ::: "memory");
                }
        }
    }
};
struct EpiSwigluT {
    static constexpr bool PERM = true;
    bf16_t* H; int pm_wrap = 1 << 30, pm_shift = 0;
    DEVI void operator()(const Acc& acc, const Unit& u, int wr, int wc, int fr, int fq) const {
        const int row0 = (u.pm >= pm_wrap ? u.pm + pm_shift : u.pm) * BM + wr * 64 + fr, j0 = u.pn * HALF + wc * 32 + 8 * fq;
#pragma unroll
        for (int ai = 0; ai < 2; ++ai)
#pragma unroll
            for (int m = 0; m < 4; ++m) {
                float hv[8];
#pragma unroll
                for (int n = 0; n < 2; ++n)
#pragma unroll
                    for (int i = 0; i < 4; ++i) { const float g = acc[ai][0][m][n][i], up = acc[ai][1][m][n][i]; hv[4 * n + i] = g * __builtin_amdgcn_rcpf(1.f + __expf(-g)) * up; }
                u32x4 w; w.x = cvt_pk_bf16(hv[0], hv[1]); w.y = cvt_pk_bf16(hv[2], hv[3]); w.z = cvt_pk_bf16(hv[4], hv[5]); w.w = cvt_pk_bf16(hv[6], hv[7]);
                *(u32x4*)(H + (size_t)(row0 + ai * HALF + m * 16) * DFF + j0) = w;
            }
    }
};
template <bool OBF>
struct EpiMoeDownT {
    static constexpr bool PERM = true;
    const void* xin; void* out; const float* gate; const int* perm; const float* permw;
    DEVI void operator()(const Acc& acc, const Unit& u, int wr, int wc, int fr, int fq) const {
        const int pos0 = u.pm * BM + wr * 64 + fr, col0 = u.pn * BM + wc * 32 + 8 * fq;
        int tk[8]; float wv[8];
#pragma unroll
        for (int r = 0; r < 8; ++r) { const int pos = pos0 + (r >> 2) * HALF + (r & 3) * 16; tk[r] = perm[pos]; wv[r] = permw[pos]; }
#pragma unroll
        for (int r = 0; r < 8; ++r) {
            const int tok = tk[r];
            if (tok >= 0) { const float w = wv[r]; const float* gp = gate + (tok / SEQ) * 6144 + col0; const size_t ro = (size_t)tok * DM + col0;
                F8 xv[2]; f32x4 gv[2][2];
#pragma unroll
                for (int bj = 0; bj < 2; ++bj) { xv[bj] = ld8<true>(xin, ro + bj * HALF); gv[bj][0] = *(const f32x4*)(gp + bj * HALF); gv[bj][1] = *(const f32x4*)(gp + bj * HALF + 4); }
                asm volatile("" ::: "memory");
#pragma unroll
                for (int bj = 0; bj < 2; ++bj) st8<OBF>(out, ro + bj * HALF, xv[bj].lo + gv[bj][0] * w * acc[r >> 2][bj][r & 3][0], xv[bj].hi + gv[bj][1] * w * acc[r >> 2][bj][r & 3][1]);
            }
        }
    }
};

struct ProbPlain {
    static constexpr bool dummy = false;
    const bf16_t* A; const bf16_t* Bt; int lda, ldb, K; StaticOrder S;
    DEVI int nt_of(const Unit&) const { return K / BK; }
    DEVI int nt_of_first() const { return K / BK; }
    DEVI bool next(int i, Unit& u) const { return S.next(i, u); }
    DEVI const char* a_tile(const Unit& u) const { return (const char*)(A + (size_t)u.pm * BM * lda); }
    DEVI const char* b_tile(const Unit& u) const { return (const char*)(Bt + (size_t)u.pn * BM * ldb); }
    DEVI const char* a_base() const { return (const char*)A; }
    DEVI unsigned a_rowoff(int, int) const { return 0u; }
};
struct ProbUp {
    const bf16_t* A1; const bf16_t* A2; const bf16_t* B1; const bf16_t* B2; int lda, ldb, K; StaticOrder S;
    DEVI int nt_of(const Unit& u) const { return u.pn < 3 ? 4 : 2; }
    DEVI int nt_of_first() const { return 4; }
    DEVI bool next(int i, Unit& u) const { return S.next(i, u); }
    DEVI const char* a_tile(const Unit& u) const { return (const char*)((u.pn < 3 ? A1 : A2) + (size_t)u.pm * BM * lda); }
    DEVI const char* b_tile(const Unit& u) const { return (const char*)(u.pn < 3 ? B1 + (size_t)u.pn * BM * ldb : B2 + (size_t)(u.pn - 3) * BM * ldb); }
    DEVI const char* a_base() const { return (const char*)A1; }
    DEVI unsigned a_rowoff(int, int) const { return 0u; }
};
struct SkipOrder {
    StaticOrder base; int nskip, R, m, pmx0;
    DEVI bool next(int i, Unit& u) const {
        const int c = base.c, G = base.G, Gs = G - nskip; const bool lo = c >= Gs; const int round = i + (lo ? R : 0);
        const long L = (round < R) ? (long)round * Gs + c : (long)R * Gs + (long)(round - R) * G + c;
        if (base.unit_of(L, u)) return true;
        const int rounds = (base.nwg + G - 1) / G, x = c - (base.nwg - (rounds - 1) * G);
        if (i != rounds - 1 || x < 0 || x >= 22 * m) return false;
        u.pm = pmx0 + x % m; u.pn = x / m; u.ks = 0; return true;
    }
};
struct OneUnit { int pm, pn; DEVI bool next(int i, Unit& u) const { if (i != 0) return false; u.pm = pm; u.pn = pn; u.ks = 0; return true; } };
template <class Ord>
struct ProbMoeT {
    const bf16_t* A; const bf16_t* Bt; int lda, ldb, K; Ord S; const int* texp; size_t estride; const LAS unsigned* tab; int pm_off;
    DEVI int nt_of(const Unit&) const { return K / BK; }
    DEVI int nt_of_first() const { return K / BK; }
    DEVI bool next(int i, Unit& u) const { if (!S.next(i, u)) return false; u.pm += pm_off; return true; }
    DEVI const char* a_tile(const Unit& u) const { return (const char*)(A + (size_t)u.pm * BM * lda); }
    DEVI const char* b_tile(const Unit& u) const { return (const char*)(Bt + (size_t)texp[u.pm] * estride + (size_t)u.pn * BM * ldb); }
    DEVI const char* a_base() const { return (const char*)A; }
    DEVI unsigned a_rowoff(int ui, int r) const { return tab[ui * 256 + r]; }
};

struct ProbSplitK4 {
    const bf16_t* A; const bf16_t* Bt; int lda, ldb, K; const int* texp; size_t estride; int nsub, G, c;
    DEVI int nt_of(const Unit& u) const { return u.ks < 2 ? 12 : 10; }
    DEVI int nt_of_first() const { return 12; }
    DEVI static int k0_of(int ks) { return 64 * (ks < 2 ? 12 * ks : 24 + 10 * (ks - 2)); }
    DEVI bool next(int i, Unit& u) const { const long L = (long)i * G + c; if (L >= nsub) return false; const int l = (int)L; u.ks = l & 3; u.pn = (l >> 2) & 3; u.pm = l >> 4; return true; }
    DEVI const char* a_tile(const Unit& u) const { return (const char*)(A + (size_t)u.pm * BM * lda + k0_of(u.ks)); }
    DEVI const char* b_tile(const Unit& u) const { return (const char*)(Bt + (size_t)texp[u.pm] * estride + (size_t)u.pn * BM * ldb + k0_of(u.ks)); }
    DEVI const char* a_base() const { return (const char*)A; }
    DEVI unsigned a_rowoff(int, int) const { return 0u; }
};
struct EpiPartialT {
    static constexpr bool PERM = true;
    float* part; int rows;
    DEVI void operator()(const Acc& acc, const Unit& u, int wr, int wc, int fr, int fq) const {
        const int pos0 = u.pm * BM + wr * 64 + fr, col0 = u.pn * BM + wc * 32 + 8 * fq;
        float* base = part + (size_t)u.ks * rows * DM;
#pragma unroll
        for (int ai = 0; ai < 2; ++ai)
#pragma unroll
            for (int m = 0; m < 4; ++m)
#pragma unroll
                for (int bj = 0; bj < 2; ++bj) st8<false>(base, (size_t)(pos0 + ai * HALF + m * 16) * DM + col0 + bj * HALF, acc[ai][bj][m][0], acc[ai][bj][m][1]);
    }
};
}


namespace att {
#define ATT_WRITE_SS (!(PF & 16))
typedef float f32x16 __attribute__((ext_vector_type(16)));
typedef short s16x4 __attribute__((ext_vector_type(4)));
constexpr int LK0 = 0, LK1 = 13312, LV0 = 26624, LV1 = 34816, LBIAS = 43008, LFLAG = 44544, LUNIT = 44672  ;
constexpr float L2E = 1.4426950408889634f;
enum { T_MLA = 0, T_SB = 1, T_CK = 2 };

template <int DK> struct TileRegs { pg8::u32x4 k0, k1, v; };
template <int DK> DEVI void tile_load(TileRegs<DK>& r, const bf16_t* Kg, int pitchK, const bf16_t* Vg, int pitchV, int key0, int tid) {
    constexpr int CPR = DK / 8;
    { const int row = tid / CPR, cc = tid % CPR; r.k0 = *(const pg8::u32x4*)(Kg + (size_t)(key0 + row) * pitchK + cc * 8); }
    if (DK == 96 && tid < 256) { const int ch = tid + 512, row = ch / CPR, cc = ch % CPR; r.k1 = *(const pg8::u32x4*)(Kg + (size_t)(key0 + row) * pitchK + cc * 8); }
    { const int row = tid >> 3, cc = tid & 7; r.v = *(const pg8::u32x4*)(Vg + (size_t)(key0 + row) * pitchV + cc * 8); }
}
template <int DK> DEVI void tile_store(const TileRegs<DK>& r, LAS unsigned char* kb, LAS unsigned char* vb, int tid) {
    constexpr int CPR = DK / 8, PITCH = DK * 2 + 16;
    { const int row = tid / CPR, cc = tid % CPR; *(LAS pg8::u32x4*)(kb + row * PITCH + cc * 16) = r.k0; }
    if (DK == 96 && tid < 256) { const int ch = tid + 512, row = ch / CPR, cc = ch % CPR; *(LAS pg8::u32x4*)(kb + row * PITCH + cc * 16) = r.k1; }
    { const int row = tid >> 3, cc = tid & 7; *(LAS pg8::u32x4*)(vb + (cc >> 2) * 4096 + row * 64 + (cc & 3) * 16) = r.v; }
}
template <int DK> DEVI void loadK(TileRegs<DK>& r, const bf16_t* Kg, int pitchK, int key0, int tid) {
    constexpr int CPR = DK / 8;
    { const int row = tid / CPR, cc = tid % CPR; r.k0 = *(const pg8::u32x4*)(Kg + (size_t)(key0 + row) * pitchK + cc * 8); }
    if (DK == 96 && tid < 256) { const int ch = tid + 512, row = ch / CPR, cc = ch % CPR; r.k1 = *(const pg8::u32x4*)(Kg + (size_t)(key0 + row) * pitchK + cc * 8); }
}
template <int DK> DEVI void loadV(TileRegs<DK>& r, const bf16_t* Vg, int pitchV, int key0, int tid) {
    const int row = tid >> 3, cc = tid & 7; r.v = *(const pg8::u32x4*)(Vg + (size_t)(key0 + row) * pitchV + cc * 8);
}
template <int DK> DEVI void storeK(const TileRegs<DK>& r, LAS unsigned char* kb, int tid) {
    constexpr int CPR = DK / 8, PITCH = DK * 2 + 16;
    { const int row = tid / CPR, cc = tid % CPR; *(LAS pg8::u32x4*)(kb + row * PITCH + cc * 16) = r.k0; }
    if (DK == 96 && tid < 256) { const int ch = tid + 512, row = ch / CPR, cc = ch % CPR; *(LAS pg8::u32x4*)(kb + row * PITCH + cc * 16) = r.k1; }
}
template <int DK> DEVI void storeV(const TileRegs<DK>& r, LAS unsigned char* vb, int tid) {
    const int row = tid >> 3, cc = tid & 7; *(LAS pg8::u32x4*)(vb + (cc >> 2) * 4096 + row * 64 + (cc & 3) * 16) = r.v;
}
DEVI void xswap32(unsigned& a, unsigned& b) { asm volatile("s_nop 1\n\tv_permlane32_swap_b32 %0, %1" : "+v"(a), "+v"(b)); }
DEVI float xhalf_max(float v) { unsigned a = __builtin_bit_cast(unsigned, v), b = a; xswap32(a, b); return fmaxf(__builtin_bit_cast(float, a), __builtin_bit_cast(float, b)); }
DEVI float xhalf_sum(float v) { unsigned a = __builtin_bit_cast(unsigned, v), b = a; xswap32(a, b); return __builtin_bit_cast(float, a) + __builtin_bit_cast(float, b); }
template <int DK> DEVI void qk_tile(f32x16& s0, f32x16& s1, const LAS unsigned char* kb, const bf16x8 (&qf)[DK / 16], int r32, int h) {
    constexpr int PITCH = DK * 2 + 16, NS = DK / 16;
    const LAS unsigned char* k0 = kb + r32 * PITCH + h * 16;
    bf16x8 a0[NS], a1[NS];
#pragma unroll
    for (int st = 0; st < NS; ++st) { a0[st] = *(const LAS bf16x8*)(k0 + st * 32); a1[st] = *(const LAS bf16x8*)(k0 + 32 * PITCH + st * 32); }
#pragma unroll
    for (int i = 0; i < 16; ++i) { s0[i] = 0.f; s1[i] = 0.f; }
    __builtin_amdgcn_sched_barrier(0);
#pragma unroll
    for (int st = 0; st < NS; ++st) {
        s0 = __builtin_amdgcn_mfma_f32_32x32x16_bf16(a0[st], qf[st], s0, 0, 0, 0);
        s1 = __builtin_amdgcn_mfma_f32_32x32x16_bf16(a1[st], qf[st], s1, 0, 0, 0);
    }
    __builtin_amdgcn_sched_barrier(0);
}
DEVI s16x4 vtr(const LAS unsigned char* p) { return __builtin_bit_cast(s16x4, __builtin_amdgcn_ds_read_tr16_b64_v4i16((LAS s16x4*)p)); }
DEVI void pv_tile(f32x16 (&o)[2], const LAS unsigned char* vlane, const bf16x8 (&pf)[4]) {
#pragma unroll
    for (int db = 0; db < 2; ++db) {
        s16x4 lo[4], hi[4];
#pragma unroll
        for (int ks = 0; ks < 4; ++ks) { lo[ks] = vtr(vlane + db * 4096 + ks * 1024); hi[ks] = vtr(vlane + db * 4096 + ks * 1024 + 512); }
        __builtin_amdgcn_sched_barrier(0);
#pragma unroll
        for (int ks = 0; ks < 4; ++ks) {
            const bf16x8 a = (bf16x8){lo[ks][0], lo[ks][1], lo[ks][2], lo[ks][3], hi[ks][0], hi[ks][1], hi[ks][2], hi[ks][3]};
            o[db] = __builtin_amdgcn_mfma_f32_32x32x16_bf16(a, pf[ks], o[db], 0, 0, 0);
        }
        __builtin_amdgcn_sched_barrier(0);
    }
}

template <int DK> DEVI void seg1_fused(f32x16& s0, f32x16& s1, f32x16 (&o)[2], const LAS unsigned char* kb, const LAS unsigned char* vlane, const bf16x8 (&qf)[DK / 16], const bf16x8 (&pf)[4], int r32, int h) {
    constexpr int PITCH = DK * 2 + 16, NS = DK / 16, NH = NS / 2;
    const LAS unsigned char* k0 = kb + r32 * PITCH + h * 16;
    s16x4 lo0[4], hi0[4], lo1[4], hi1[4];
    bf16x8 ka0[NH], ka1[NH], kb0[NH], kb1[NH];
#pragma unroll
    for (int ks = 0; ks < 4; ++ks) { lo0[ks] = vtr(vlane + ks * 1024); hi0[ks] = vtr(vlane + ks * 1024 + 512); }
#pragma unroll
    for (int st = 0; st < NH; ++st) { ka0[st] = *(const LAS bf16x8*)(k0 + st * 32); ka1[st] = *(const LAS bf16x8*)(k0 + 32 * PITCH + st * 32); }
#pragma unroll
    for (int i = 0; i < 16; ++i) { s0[i] = 0.f; s1[i] = 0.f; }
    __builtin_amdgcn_sched_barrier(0);
#pragma unroll
    for (int ks = 0; ks < 4; ++ks) {
        const bf16x8 a = (bf16x8){lo0[ks][0], lo0[ks][1], lo0[ks][2], lo0[ks][3], hi0[ks][0], hi0[ks][1], hi0[ks][2], hi0[ks][3]};
        o[0] = __builtin_amdgcn_mfma_f32_32x32x16_bf16(a, pf[ks], o[0], 0, 0, 0);
    }
#pragma unroll
    for (int ks = 0; ks < 4; ++ks) { lo1[ks] = vtr(vlane + 4096 + ks * 1024); hi1[ks] = vtr(vlane + 4096 + ks * 1024 + 512); }
    __builtin_amdgcn_sched_barrier(0);
#pragma unroll
    for (int st = 0; st < NH; ++st) {
        s0 = __builtin_amdgcn_mfma_f32_32x32x16_bf16(ka0[st], qf[st], s0, 0, 0, 0);
        s1 = __builtin_amdgcn_mfma_f32_32x32x16_bf16(ka1[st], qf[st], s1, 0, 0, 0);
    }
#pragma unroll
    for (int st = 0; st < NH; ++st) { kb0[st] = *(const LAS bf16x8*)(k0 + (NH + st) * 32); kb1[st] = *(const LAS bf16x8*)(k0 + 32 * PITCH + (NH + st) * 32); }
    __builtin_amdgcn_sched_barrier(0);
#pragma unroll
    for (int ks = 0; ks < 4; ++ks) {
        const bf16x8 a = (bf16x8){lo1[ks][0], lo1[ks][1], lo1[ks][2], lo1[ks][3], hi1[ks][0], hi1[ks][1], hi1[ks][2], hi1[ks][3]};
        o[1] = __builtin_amdgcn_mfma_f32_32x32x16_bf16(a, pf[ks], o[1], 0, 0, 0);
    }
    __builtin_amdgcn_sched_barrier(0);
#pragma unroll
    for (int st = 0; st < NH; ++st) {
        s0 = __builtin_amdgcn_mfma_f32_32x32x16_bf16(kb0[st], qf[NH + st], s0, 0, 0, 0);
        s1 = __builtin_amdgcn_mfma_f32_32x32x16_bf16(kb1[st], qf[NH + st], s1, 0, 0, 0);
    }
    __builtin_amdgcn_sched_barrier(0);
}
DEVI void pack_p(bf16x8 (&pf)[4], const f32x16& s0, const f32x16& s1) {
#pragma unroll
    for (int st = 0; st < 2; ++st) {
        unsigned a[4], b[4];
#pragma unroll
        for (int i = 0; i < 4; ++i) { a[i] = pg8::cvt_pk_bf16(s0[8 * st + 2 * i], s0[8 * st + 2 * i + 1]); b[i] = pg8::cvt_pk_bf16(s1[8 * st + 2 * i], s1[8 * st + 2 * i + 1]); }
        pf[st] = __builtin_bit_cast(bf16x8, (pg8::u32x4){a[0], a[1], a[2], a[3]});
        pf[2 + st] = __builtin_bit_cast(bf16x8, (pg8::u32x4){b[0], b[1], b[2], b[3]});
    }
}
typedef float f32x2 __attribute__((ext_vector_type(2)));
DEVI void softmax_tile(f32x16& s0, f32x16& s1, float& m_run, float& l_run, f32x16 (&o)[2], bf16x8 (&pf)[4]) {
    float mx = fmaxf(s0[0], s1[0]);
#pragma unroll
    for (int i = 1; i < 16; ++i) mx = fmaxf(fmaxf(mx, s0[i]), s1[i]);
    mx = xhalf_max(mx);
    const float mn = fmaxf(m_run, mx);
    const f32x2 mn2 = (f32x2){mn, mn};
    f32x2 sum2 = (f32x2){0.f, 0.f};
#pragma unroll
    for (int i = 0; i < 16; i += 2) {
        f32x2 a = (f32x2){s0[i], s0[i + 1]} - mn2, b = (f32x2){s1[i], s1[i + 1]} - mn2;
        a.x = __builtin_amdgcn_exp2f(a.x); a.y = __builtin_amdgcn_exp2f(a.y); b.x = __builtin_amdgcn_exp2f(b.x); b.y = __builtin_amdgcn_exp2f(b.y);
        s0[i] = a.x; s0[i + 1] = a.y; s1[i] = b.x; s1[i + 1] = b.y;
        sum2 += a + b;
    }
    if (__any(mn != m_run)) {
        const float corr = __builtin_amdgcn_exp2f(m_run - mn);
        const f32x2 c2 = (f32x2){corr, corr};
        l_run *= corr;
#pragma unroll
        for (int i = 0; i < 16; i += 2) {
            f32x2 a = (f32x2){o[0][i], o[0][i + 1]} * c2, b = (f32x2){o[1][i], o[1][i + 1]} * c2;
            o[0][i] = a.x; o[0][i + 1] = a.y; o[1][i] = b.x; o[1][i + 1] = b.y;
        }
        m_run = mn;
    }
    l_run += sum2.x + sum2.y;
    pack_p(pf, s0, s1);
}
template <bool MASKED>
DEVI void sb_tile(f32x16& s0, f32x16& s1, float& carry, bf16x8 (&pf)[4], int h, int t_rel  ) {
    constexpr float ZS = 0.125f * 1.4426950408889634f;
    f32x16 L0, L1;
    float G[2][4], Gp[2][4];
#pragma unroll
    for (int x = 0; x < 2; ++x)
#pragma unroll
        for (int g = 0; g < 4; ++g) {
            float gs = 0.f;
#pragma unroll
            for (int i = 0; i < 4; ++i) {
                const int rr = 4 * g + i;
                const float z = (x ? s1[rr] : s0[rr]) * ZS;
                const float e = __builtin_amdgcn_exp2f(-fabsf(z));
                const float sp = fmaxf(z, 0.f) + __builtin_amdgcn_logf(1.f + e);
                float L = -sp, ls = z - sp;
                if (MASKED) { const bool valid = (32 * x + 8 * g + 4 * h + i) < t_rel; L = valid ? L : 0.f; ls = valid ? ls : -1.0e30f; }
                gs += L;
                if (x) { s1[rr] = ls; L1[rr] = L; } else { s0[rr] = ls; L0[rr] = L; }
            }
            G[x][g] = gs;
        }
#pragma unroll
    for (int x = 0; x < 2; ++x)
#pragma unroll
        for (int g = 0; g < 4; ++g) Gp[x][g] = xhalf_sum(G[x][g]) - G[x][g];
    float T[2][4]; float run = 0.f;
#pragma unroll
    for (int x = 1; x >= 0; --x)
#pragma unroll
        for (int g = 3; g >= 0; --g) { T[x][g] = run; run += G[x][g] + Gp[x][g]; }
#pragma unroll
    for (int x = 0; x < 2; ++x)
#pragma unroll
        for (int g = 0; g < 4; ++g) {
            float tl = carry + T[x][g] + (h == 0 ? Gp[x][g] : 0.f);
#pragma unroll
            for (int i = 3; i >= 0; --i) {
                const int rr = 4 * g + i;
                if (x) { const float w = __builtin_amdgcn_exp2f(s1[rr] + tl); tl += L1[rr]; s1[rr] = w; }
                else   { const float w = __builtin_amdgcn_exp2f(s0[rr] + tl); tl += L0[rr]; s0[rr] = w; }
            }
        }
    carry += run;
    pack_p(pf, s0, s1);
}


DEVI void unpack8(const bf16x8& f, float* q) {
#pragma unroll
    for (int j = 0; j < 8; ++j) q[j] = __builtin_bit_cast(float, (unsigned)(unsigned short)f[j] << 16);
}
DEVI bf16x8 pack8(const float* q, float sc) {
    pg8::u32x4 w; w.x = pg8::cvt_pk_bf16(q[0] * sc, q[1] * sc); w.y = pg8::cvt_pk_bf16(q[2] * sc, q[3] * sc); w.z = pg8::cvt_pk_bf16(q[4] * sc, q[5] * sc); w.w = pg8::cvt_pk_bf16(q[6] * sc, q[7] * sc);
    return __builtin_bit_cast(bf16x8, w);
}
DEVI void qprep_mla(bf16x8 (&qf)[6], const Params& p, size_t grow, int h) {
    float q[48];
#pragma unroll
    for (int st = 0; st < 6; ++st) unpack8(qf[st], q + 8 * st);
    const float* cs = (const float*)(p.ws + WS_COS) + grow * 16; const float* sn = (const float*)(p.ws + WS_SIN) + grow * 16;
    const f32x4 c0 = *(const f32x4*)(cs + 4 * h), c1 = *(const f32x4*)(cs + 8 + 4 * h), s0 = *(const f32x4*)(sn + 4 * h), s1 = *(const f32x4*)(sn + 8 + 4 * h);
    float ss = 0.f;
#pragma unroll
    for (int i = 0; i < 48; ++i) ss += q[i] * q[i];
    ss = xhalf_sum(ss);
#pragma unroll
    for (int m = 0; m < 4; ++m) {
        { const float a = q[32 + 2 * m], b = q[33 + 2 * m]; q[32 + 2 * m] = a * c0[m] - b * s0[m]; q[33 + 2 * m] = b * c0[m] + a * s0[m]; }
        { const float a = q[40 + 2 * m], b = q[41 + 2 * m]; q[40 + 2 * m] = a * c1[m] - b * s1[m]; q[41 + 2 * m] = b * c1[m] + a * s1[m]; }
    }
    const float alpha = ((const float*)(p.ws + WS_ALPHA))[grow];
    const float rq = rsqrtf(alpha * alpha * ss * (1.f / 96.f) + EPS) * alpha * (0.10206207261596577f * L2E);
#pragma unroll
    for (int st = 0; st < 6; ++st) qf[st] = pack8(q + 8 * st, rq);
}
DEVI void qprep_ck(bf16x8 (&qf)[4]) {
    float q[32];
#pragma unroll
    for (int st = 0; st < 4; ++st) unpack8(qf[st], q + 8 * st);
    float ss = 0.f;
#pragma unroll
    for (int i = 0; i < 32; ++i) ss += q[i] * q[i];
    ss = xhalf_sum(ss);
    const float r = rsqrtf(ss * (1.f / 64.f) + EPS) * (0.125f * L2E);
#pragma unroll
    for (int st = 0; st < 4; ++st) qf[st] = pack8(q + 8 * st, r);
}

template <int TYPE, int PF = 0>
DEVI void unit(const Ctx& cin, const Params& p, int l, int b, int hh, int qt) {
    constexpr int DK = (TYPE == T_MLA) ? 96 : 64;
    Ctx c = cin; { int ln = cin.lane; asm volatile("" : "+v"(ln)); c.lane = ln; c.tid = cin.wid * 64 + ln; }
    const bf16_t* proj = (const bf16_t*)(p.ws + WS_PROJ); const bf16_t* qb = (const bf16_t*)(p.ws + WS_Q); const bf16_t* kvb = (const bf16_t*)(p.ws + WS_KV);
    bf16_t* O = (bf16_t*)(p.ws + WS_H);
    const size_t rowb = (size_t)b * SEQ;
    const bf16_t *Qg, *Kg, *Vg; int pitchQ, pitchKV, ocol;
    if (TYPE == T_MLA) { Qg = qb + rowb * QLD + hh * 96; pitchQ = QLD; Kg = kvb + rowb * KVLD + hh * 160; Vg = Kg + 96; pitchKV = KVLD; ocol = 256 + hh * 64; }
    else if (TYPE == T_SB) { Qg = proj + rowb * PROJ_LD + PC_SBQ + hh * 64; pitchQ = PROJ_LD; Kg = proj + rowb * PROJ_LD + PC_SBK + hh * 64; Vg = proj + rowb * PROJ_LD + PC_SBV + hh * 64; pitchKV = PROJ_LD; ocol = hh * 64; }
    else { Qg = proj + rowb * PROJ_LD + PC_CKQ + hh * 64; pitchQ = PROJ_LD; Kg = proj + rowb * PROJ_LD + PC_CKK + hh * 64; Vg = proj + rowb * PROJ_LD + PC_CKV + hh * 64; pitchKV = PROJ_LD; ocol = 768 + hh * 64; }
    LAS unsigned char* ring = c.ring;
    const int w = c.wid, r32 = c.lane & 31, h = c.lane >> 5, q0 = qt * 256, trow = q0 + 32 * w + r32;
    int jlo, jhi;
    if (TYPE == T_MLA) { jlo = 0; jhi = 4 * qt + 3; }
    else if (TYPE == T_SB) { jlo = 0; jhi = 4 * qt + 3; }
    else { jlo = 4 * qt - 8 < 0 ? 0 : 4 * qt - 8; jhi = 4 * qt + 3; }
    const int cw = 4 * qt + (w >> 1);
    bf16x8 qf[DK / 16];
#pragma unroll
    for (int st = 0; st < DK / 16; ++st) qf[st] = *(const bf16x8*)(Qg + (size_t)trow * pitchQ + st * 16 + h * 8);
    if constexpr (TYPE == T_MLA) qprep_mla(qf, p, rowb + trow, h);
    if constexpr (TYPE == T_CK) qprep_ck(qf);
    if (TYPE == T_CK) { LAS float* bt = (LAS float*)(ring + LBIAS); const float* rb = p.in[I_RELB] + (l * 4 + hh) * 257; if (c.tid < 257) bt[c.tid] = rb[c.tid] * L2E; }
    if (TYPE == T_SB) { LAS unsigned* fl = (LAS unsigned*)(ring + LFLAG); if (c.tid < 16) fl[c.tid] = 0u; }
    f32x16 o[2];
#pragma unroll
    for (int i = 0; i < 16; ++i) { o[0][i] = 0.f; o[1][i] = 0.f; }
    float m_run = -1.0e30f, l_run = 0.f, carry = 0.f;
    bool wave_done = false;
    const int vlane = (4 * h + ((c.lane & 15) >> 2)) * 64 + (((c.lane >> 4) & 1) * 16 + 4 * (c.lane & 3)) * 2;
    const int ntile = jhi - jlo + 1;
    TileRegs<DK> tr;
    auto tile_of = [&](int it) { return (TYPE == T_SB) ? (jhi - it) : (jlo + it); };
    tile_load<DK>(tr, Kg, pitchKV, Vg, pitchKV, tile_of(0) * 64, c.tid);
    tile_store<DK>(tr, ring + LK0, ring + LV0, c.tid);
    __syncthreads();
    for (int it = 0; it < ntile; ++it) {
        const int j = tile_of(it), buf = it & 1;
        const bool more = (it + 1 < ntile);
        if (more) tile_load<DK>(tr, Kg, pitchKV, Vg, pitchKV, tile_of(it + 1) * 64, c.tid);
        const LAS unsigned char* kb = ring + (buf ? LK1 : LK0); const LAS unsigned char* vb = ring + (buf ? LV1 : LV0);
        bool active;
        if (TYPE == T_MLA) active = (j <= cw);
        else if (TYPE == T_SB) active = (j <= cw) && !wave_done;
        else active = (j <= cw) && (j >= cw - 8);
        if (active) {
            f32x16 s0, s1; bf16x8 pf[4];
            qk_tile<DK>(s0, s1, kb, qf, r32, h);
            if (TYPE == T_MLA) softmax_tile(s0, s1, m_run, l_run, o, pf);
            else if (TYPE == T_CK) {
                const int dlt = cw - j;
                const LAS float* bt = (const LAS float*)(ring + LBIAS);
                if (dlt >= 3) { const float bc = bt[256];
#pragma unroll
                    for (int i = 0; i < 16; ++i) { s0[i] += bc; s1[i] += bc; } }
                else { const int base = 64 * dlt + (32 * (w & 1) + r32) - 4 * h + 128;
#pragma unroll
                    for (int i = 0; i < 16; ++i) { int i0 = base - (8 * (i >> 2) + (i & 3)), i1 = i0 - 32; i0 = i0 > 256 ? 256 : i0; i1 = i1 > 256 ? 256 : i1; s0[i] += bt[i0]; s1[i] += bt[i1]; } }
                softmax_tile(s0, s1, m_run, l_run, o, pf);
            } else {
                if (j == cw) sb_tile<true>(s0, s1, carry, pf, h, trow - j * 64); else sb_tile<false>(s0, s1, carry, pf, h, 0);
                if (__all(carry <= -144.3f)) wave_done = true;
            }
            pv_tile(o, vb + vlane, pf);
        }
        if (TYPE == T_SB) { LAS unsigned* fl = (LAS unsigned*)(ring + LFLAG); if (c.lane == 0) fl[(it & 1) * 8 + w] = wave_done ? 0u : 1u; }
        if (more) tile_store<DK>(tr, ring + (buf ? LK0 : LK1), ring + (buf ? LV0 : LV1), c.tid);
        __syncthreads();
        if (TYPE == T_SB) {
            const LAS unsigned* fl = (const LAS unsigned*)(ring + LFLAG); unsigned any = 0u;
#pragma unroll
            for (int k = 0; k < 8; ++k) any |= fl[(it & 1) * 8 + k];
            if (any == 0u) break;
        }
    }
    float inv = 1.f;
    if (TYPE != T_SB) { const float lt = l_run + __shfl_xor(l_run, 32, 64); inv = 1.f / lt; }
    bf16_t* orow = O + (rowb + trow) * DM + ocol;
    float sq = 0.f;
#pragma unroll
    for (int db = 0; db < 2; ++db)
#pragma unroll
        for (int g = 0; g < 4; ++g) {
            const float v0 = o[db][4 * g] * inv, v1 = o[db][4 * g + 1] * inv, v2 = o[db][4 * g + 2] * inv, v3 = o[db][4 * g + 3] * inv;
            sq += (v0 * v0 + v1 * v1) + (v2 * v2 + v3 * v3);
            uint2 v; v.x = pg8::cvt_pk_bf16(v0, v1); v.y = pg8::cvt_pk_bf16(v2, v3);
            *(uint2*)(orow + 32 * db + 8 * g + 4 * h) = v;
        }
    sq = xhalf_sum(sq);
    if (h == 0 && ATT_WRITE_SS) ((float*)(p.ws + WS_SSH))[(rowb + trow) * 16 + (ocol >> 6)] = sq;
    __syncthreads();
}


#ifndef ATT_UNIT
#define ATT_UNIT unit2
#endif
#ifndef ATT_FUSED_SEG1
#define ATT_FUSED_SEG1 0
#endif

template <int DK> DEVI void qk_tile_c(f32x16& s0, f32x16& s1, const f32x16& cin, const LAS unsigned char* kb, const bf16x8 (&qf)[DK / 16], int r32, int h) {
    constexpr int PITCH = DK * 2 + 16, NS = DK / 16;
    const LAS unsigned char* k0 = kb + r32 * PITCH + h * 16;
    bf16x8 a0[NS], a1[NS];
#pragma unroll
    for (int st = 0; st < NS; ++st) { a0[st] = *(const LAS bf16x8*)(k0 + st * 32); a1[st] = *(const LAS bf16x8*)(k0 + 32 * PITCH + st * 32); }
    __builtin_amdgcn_sched_barrier(0);
    s0 = __builtin_amdgcn_mfma_f32_32x32x16_bf16(a0[0], qf[0], cin, 0, 0, 0);
    s1 = __builtin_amdgcn_mfma_f32_32x32x16_bf16(a1[0], qf[0], cin, 0, 0, 0);
#pragma unroll
    for (int st = 1; st < NS; ++st) {
        s0 = __builtin_amdgcn_mfma_f32_32x32x16_bf16(a0[st], qf[st], s0, 0, 0, 0);
        s1 = __builtin_amdgcn_mfma_f32_32x32x16_bf16(a1[st], qf[st], s1, 0, 0, 0);
    }
    __builtin_amdgcn_sched_barrier(0);
}
constexpr float DEFER_THR = 6.0f;
DEVI void softmax_tile_defer(f32x16& s0, f32x16& s1, float& m_run, f32x16& negm, float& l_run, f32x16 (&o)[2], bf16x8 (&pf)[4], bool first) {
    float mx = fmaxf(s0[0], s1[0]);
#pragma unroll
    for (int i = 1; i < 16; ++i) mx = fmaxf(fmaxf(mx, s0[i]), s1[i]);
    mx = xhalf_max(mx);
    if (first || __any(mx > DEFER_THR)) {
        const float d = first ? mx : fmaxf(mx, 0.f);
        const float corr = __builtin_amdgcn_exp2f(-d);
        const f32x2 c2 = (f32x2){corr, corr}, d2 = (f32x2){d, d};
        l_run *= corr; m_run += d;
#pragma unroll
        for (int i = 0; i < 16; i += 2) {
            f32x2 a = (f32x2){o[0][i], o[0][i + 1]} * c2, b = (f32x2){o[1][i], o[1][i + 1]} * c2;
            o[0][i] = a.x; o[0][i + 1] = a.y; o[1][i] = b.x; o[1][i + 1] = b.y;
            f32x2 u = (f32x2){s0[i], s0[i + 1]} - d2, v = (f32x2){s1[i], s1[i + 1]} - d2;
            s0[i] = u.x; s0[i + 1] = u.y; s1[i] = v.x; s1[i + 1] = v.y;
        }
#pragma unroll
        for (int i = 0; i < 16; ++i) negm[i] = -m_run;
    }
    f32x2 sum2 = (f32x2){0.f, 0.f};
#pragma unroll
    for (int i = 0; i < 16; i += 2) {
        f32x2 a, b;
        a.x = __builtin_amdgcn_exp2f(s0[i]); a.y = __builtin_amdgcn_exp2f(s0[i + 1]); b.x = __builtin_amdgcn_exp2f(s1[i]); b.y = __builtin_amdgcn_exp2f(s1[i + 1]);
        s0[i] = a.x; s0[i + 1] = a.y; s1[i] = b.x; s1[i + 1] = b.y;
        sum2 += a + b;
    }
    l_run += sum2.x + sum2.y;
    pack_p(pf, s0, s1);
}

#define ATT_BAR() do { asm volatile("s_waitcnt lgkmcnt(0)" ::: "memory"); __builtin_amdgcn_s_barrier(); asm volatile("" ::: "memory"); } while (0)
template <int TYPE, int PF = 0>
DEVI void unit2(const Ctx& cin, const Params& p, int l, int b, int hh, int qt) {
    constexpr int DK = (TYPE == T_MLA) ? 96 : 64;
    Ctx c = cin; { int ln = cin.lane; asm volatile("" : "+v"(ln)); c.lane = ln; c.tid = cin.wid * 64 + ln; }
    const bf16_t* proj = (const bf16_t*)(p.ws + WS_PROJ); const bf16_t* qb = (const bf16_t*)(p.ws + WS_Q); const bf16_t* kvb = (const bf16_t*)(p.ws + WS_KV);
    bf16_t* O = (PF & 16) ? (bf16_t*)p.out : (bf16_t*)(p.ws + WS_H);
    const size_t rowb = (size_t)b * SEQ;
    const bf16_t *Qg, *Kg, *Vg; int pitchQ, pitchKV, ocol;
    if (TYPE == T_MLA) { Qg = qb + rowb * QLD + hh * 96; pitchQ = QLD; Kg = kvb + rowb * KVLD + hh * 160; Vg = Kg + 96; pitchKV = KVLD; ocol = 256 + hh * 64; }
    else if (TYPE == T_SB) { Qg = proj + rowb * PROJ_LD + PC_SBQ + hh * 64; pitchQ = PROJ_LD; Kg = proj + rowb * PROJ_LD + PC_SBK + hh * 64; Vg = proj + rowb * PROJ_LD + PC_SBV + hh * 64; pitchKV = PROJ_LD; ocol = hh * 64; }
    else { Qg = proj + rowb * PROJ_LD + PC_CKQ + hh * 64; pitchQ = PROJ_LD; Kg = proj + rowb * PROJ_LD + PC_CKK + hh * 64; Vg = proj + rowb * PROJ_LD + PC_CKV + hh * 64; pitchKV = PROJ_LD; ocol = 768 + hh * 64; }
    LAS unsigned char* ring = c.ring;
    const int w = c.wid, hb = w >> 2, r32 = c.lane & 31, h = c.lane >> 5, q0 = qt * 256, trow = q0 + 32 * w + r32;
    int jlo, jhi;
    if (TYPE == T_CK) { jlo = 4 * qt - 8 < 0 ? 0 : 4 * qt - 8; jhi = 4 * qt + 3; } else { jlo = 0; jhi = 4 * qt + 3; }
    const int cw = 4 * qt + (w >> 1);
    bf16x8 qf[DK / 16];
#pragma unroll
    for (int st = 0; st < DK / 16; ++st) qf[st] = *(const bf16x8*)(Qg + (size_t)trow * pitchQ + st * 16 + h * 8);
    if (TYPE == T_CK) { LAS float* bt = (LAS float*)(ring + LBIAS); const float* rb = p.in[I_RELB] + (l * 4 + hh) * 257; if (c.tid < 257) bt[c.tid] = rb[c.tid] * L2E; }
    if (TYPE == T_SB) { LAS unsigned* fl = (LAS unsigned*)(ring + LFLAG); if (c.tid < 32) fl[c.tid] = 1u; }
    f32x16 o[2];
#pragma unroll
    for (int i = 0; i < 16; ++i) { o[0][i] = 0.f; o[1][i] = 0.f; }
    float m_run = 0.f, l_run = 0.f, carry = 0.f;
    bool wave_done = false, first_tile = true;
    f32x16 negm;
#pragma unroll
    for (int i = 0; i < 16; ++i) negm[i] = 0.f;
    const int vlane = (4 * h + ((c.lane & 15) >> 2)) * 64 + (((c.lane >> 4) & 1) * 16 + 4 * (c.lane & 3)) * 2;
    const int nt = jhi - jlo + 1;
    TileRegs<DK> tr;
    auto tile_of = [&](int it) { return (TYPE == T_SB) ? (jhi - it) : (jlo + it); };
    {
        TileRegs<DK> tr1;
        loadK<DK>(tr, Kg, pitchKV, tile_of(0) * 64, c.tid); loadV<DK>(tr, Vg, pitchKV, tile_of(0) * 64, c.tid);
        if (nt > 1) loadK<DK>(tr1, Kg, pitchKV, tile_of(1) * 64, c.tid);
        if constexpr (TYPE == T_MLA) qprep_mla(qf, p, rowb + trow, h);
        if constexpr (TYPE == T_CK) qprep_ck(qf);
        storeK<DK>(tr, ring + LK0, c.tid); storeV<DK>(tr, ring + LV0, c.tid);
        if (nt > 1) storeK<DK>(tr1, ring + LK1, c.tid);
    }
    __syncthreads();
    if (hb == 1 && !(PF & 32)) ATT_BAR();
    f32x16 s0, s1; bf16x8 pf[4];
    bool act_prev = false;
    int it = 0;
    for (; it < nt; ++it) {
        const int j = tile_of(it);
        bool act_cur;
        if (TYPE == T_MLA) act_cur = (j <= cw);
        else if (TYPE == T_SB) act_cur = (j <= cw) && !wave_done;
        else act_cur = (j <= cw) && (j >= cw - 8);
        if (ATT_FUSED_SEG1 && act_cur && act_prev && !(PF & 12)) seg1_fused<DK>(s0, s1, o, ring + ((it & 1) ? LK1 : LK0), ring + (((it - 1) & 1) ? LV1 : LV0) + vlane, qf, pf, r32, h);
        else {
        __builtin_amdgcn_s_setprio(1);
        if (act_cur) { if (!(PF & 8)) qk_tile_c<DK>(s0, s1, negm, ring + ((it & 1) ? LK1 : LK0), qf, r32, h); else {
#pragma unroll
            for (int i = 0; i < 16; ++i) { s0[i] = (float)i; s1[i] = (float)(i + it); } } }
        if (act_prev && !(PF & 4)) pv_tile(o, ring + (((it - 1) & 1) ? LV1 : LV0) + vlane, pf);
        __builtin_amdgcn_s_setprio(0);
        }
        if (it >= 1 && !(PF & 2)) { if (it + 1 < nt) storeK<DK>(tr, ring + (((it + 1) & 1) ? LK1 : LK0), c.tid); storeV<DK>(tr, ring + ((it & 1) ? LV1 : LV0), c.tid); }
        if (!(PF & 32)) ATT_BAR();
        if (!(PF & 2)) { if (it + 2 < nt) loadK<DK>(tr, Kg, pitchKV, tile_of(it + 2) * 64, c.tid);
        if (it + 1 < nt) loadV<DK>(tr, Vg, pitchKV, tile_of(it + 1) * 64, c.tid); }
        if (act_cur) {
            if (PF & 1) { l_run += s0[3]; pack_p(pf, s0, s1); }
            else if (TYPE == T_MLA) { softmax_tile_defer(s0, s1, m_run, negm, l_run, o, pf, first_tile); first_tile = false; }
            else if (TYPE == T_CK) {
                const int dlt = cw - j;
                const LAS float* bt = (const LAS float*)(ring + LBIAS);
                if (dlt >= 3) { const float bc = bt[256];
#pragma unroll
                    for (int i = 0; i < 16; ++i) { s0[i] += bc; s1[i] += bc; } }
                else { const int base = 64 * dlt + (32 * (w & 1) + r32) - 4 * h + 128;
#pragma unroll
                    for (int i = 0; i < 16; ++i) { int i0 = base - (8 * (i >> 2) + (i & 3)), i1 = i0 - 32; i0 = i0 > 256 ? 256 : i0; i1 = i1 > 256 ? 256 : i1; s0[i] += bt[i0]; s1[i] += bt[i1]; } }
                softmax_tile_defer(s0, s1, m_run, negm, l_run, o, pf, first_tile); first_tile = false;
            } else {
                if (j == cw) sb_tile<true>(s0, s1, carry, pf, h, trow - j * 64); else sb_tile<false>(s0, s1, carry, pf, h, 0);
                if (__all(carry <= -144.3f)) wave_done = true;
            }
        }
        if (TYPE == T_SB) { LAS unsigned* fl = (LAS unsigned*)(ring + LFLAG); if (c.lane == 0) fl[(it & 3) * 8 + w] = wave_done ? 0u : 1u; }
        act_prev = act_cur;
        if (!(PF & 32)) ATT_BAR();
        if (TYPE == T_SB && it >= 1) {
            const LAS unsigned* fl = (const LAS unsigned*)(ring + LFLAG); unsigned any = 0u;
#pragma unroll
            for (int k = 0; k < 8; ++k) any |= fl[((it - 1) & 3) * 8 + k];
            if (any == 0u) { ++it; break; }
        }
    }
    if (act_prev && !(PF & 4)) pv_tile(o, ring + (((it - 1) & 1) ? LV1 : LV0) + vlane, pf);
    if (hb == 0 && !(PF & 32)) ATT_BAR();
    float inv = 1.f;
    if (TYPE != T_SB) { const float lt = xhalf_sum(l_run); inv = 1.f / lt; }
    bf16_t* orow = O + (rowb + trow) * DM + ocol;
    float sq = 0.f;
#pragma unroll
    for (int db = 0; db < 2; ++db)
#pragma unroll
        for (int gp = 0; gp < 2; ++gp) {
            unsigned w[2][2];
#pragma unroll
            for (int e = 0; e < 2; ++e) {
                const int g = 2 * gp + e;
                const float v0 = o[db][4 * g] * inv, v1 = o[db][4 * g + 1] * inv, v2 = o[db][4 * g + 2] * inv, v3 = o[db][4 * g + 3] * inv;
                sq += (v0 * v0 + v1 * v1) + (v2 * v2 + v3 * v3);
                w[e][0] = pg8::cvt_pk_bf16(v0, v1); w[e][1] = pg8::cvt_pk_bf16(v2, v3);
            }
            xswap32(w[0][0], w[1][0]); xswap32(w[0][1], w[1][1]);
            pg8::u32x4 v; v.x = w[0][0]; v.y = w[0][1]; v.z = w[1][0]; v.w = w[1][1];
            *(pg8::u32x4*)(orow + 32 * db + 8 * (2 * gp + h)) = v;
        }
    sq = xhalf_sum(sq);
    if (h == 0 && ATT_WRITE_SS) ((float*)(p.ws + WS_SSH))[(rowb + trow) * 16 + (ocol >> 6)] = sq;
    __syncthreads();
}


DEVI void conv_unit(const Ctx& c, const Params& p, int cv) {
    unsigned char* ws = p.ws;
    if (cv < 176) { const int e = cv / 22, rb = cv % 22;
        conv_rowblock<MAP_GU>(c, p.in[I_MG] + (size_t)e * 1024 * DFF, p.in[I_MU] + (size_t)e * 1024 * DFF, DFF, 1024, nullptr, (bf16_t*)(ws + WS_MGU) + (size_t)e * 5632 * 1024, 1024, rb); }
    else { const int d = cv - 176, e = d >> 2, rb = d & 3;
        conv_rowblock<MAP_ID>(c, p.in[I_MD] + (size_t)e * DFF * 1024, nullptr, 1024, DFF, nullptr, (bf16_t*)(ws + WS_MD) + (size_t)e * 1024 * DFF, DFF, rb); }
    __syncthreads();
}
DEVI void run_unit(const Ctx& c, const Params& p, int l, int xq, int u, int ncv) {
    if (u >= 96 && u < 96 + ncv) { conv_unit(c, p, l == 0 ? xq * 22 + (u - 96) : 176 + xq * 4 + (u - 96)); return; }
    if (u >= 96 + ncv) u -= ncv;
    if (u < 96) { const int g = u / 24, idx = u % 24, qt = 15 - (idx >> 1), bh = 8 * (2 * g + (idx & 1)) + xq; ATT_UNIT<T_MLA>(c, p, l, bh >> 3, bh & 7, qt); }
    else if (u < 160) { const int v = u - 96, qt = 15 - (v >> 2), bh = 8 * (v & 3) + xq; ATT_UNIT<T_CK>(c, p, l, bh >> 2, bh & 3, qt); }
    else if (u < 224) { const int v = u - 160, qt = 15 - (v >> 2), bh = 8 * (v & 3) + xq; ATT_UNIT<T_SB>(c, p, l, bh >> 2, bh & 3, qt); }
    else { const int v = u - 224, qt = 3 - (v >> 3), bh = 8 * (v & 7) + xq; ATT_UNIT<T_MLA>(c, p, l, bh >> 3, bh & 7, qt); }
}
DEVI void phase(const Ctx& c, const Params& p, int lq) {
    const int l = lq & 1;
    unsigned* qbase = (unsigned*)(p.ws + WS_CTL) + 8192 + 512 * lq;
    LAS int* s_unit = (LAS int*)(c.ring + LUNIT);
    const int x0 = (int)(xb_xcc_id() & 7u);
    const int ncv = !MOE_CONV_IN_ATT ? 0 : lq == 0 ? 22 : lq == 1 ? 4 : 0, nun = 256 + ncv;
    for (int k = 0; k < 8; ++k) {
        const int xq = (x0 + k) & 7;
        if (c.tid == 0) s_unit[0] = (int)__hip_atomic_fetch_add(qbase + 64 * xq, 1u, __ATOMIC_RELAXED, __HIP_MEMORY_SCOPE_AGENT);
        __syncthreads();
        for (int par = 0;; par ^= 1) {
            const int u = s_unit[par];
            if (u >= nun) break;
            int nxt = 0;
            if (c.tid == 0) {
                unsigned long long qa = (unsigned long long)(qbase + 64 * xq);
                asm volatile("" : "+v"(qa));
                nxt = (int)__hip_atomic_fetch_add((__attribute__((address_space(1))) unsigned*)qa, 1u, __ATOMIC_RELAXED, __HIP_MEMORY_SCOPE_AGENT);
            }
            run_unit(c, p, l, xq, u, ncv);
            if (c.tid == 0) s_unit[par ^ 1] = nxt;
            __syncthreads();
        }
        __syncthreads();
    }
}
#ifndef PROBE_PF
#define PROBE_PF 0
#endif
#ifndef PROBE_TYPES
#define PROBE_TYPES 0
#endif
DEVI void phase_probe(const Ctx& c, const Params& p, int l) {
    unsigned* qbase = (unsigned*)(p.ws + WS_CTL) + 8192 + 512 * 3;
    LAS int* s_unit = (LAS int*)(c.ring + LUNIT);
    const int x0 = (int)(xb_xcc_id() & 7u);
    for (int k = 0; k < 8; ++k) {
        const int xq = (x0 + k) & 7;
        for (;;) {
            if (c.tid == 0) *s_unit = (int)__hip_atomic_fetch_add(qbase + 64 * xq, 1u, __ATOMIC_RELAXED, __HIP_MEMORY_SCOPE_AGENT);
            __syncthreads();
            const int u = *s_unit;
            __syncthreads();
            if (u >= 256) break;
            if (u < 128) { if (PROBE_TYPES & 1) { const int g = u >> 5, idx = u & 31, qt = 15 - (idx >> 1), bh = 8 * (2 * g + (idx & 1)) + xq; unit2<T_MLA, (PROBE_PF | 16)>(c, p, l, bh >> 3, bh & 7, qt); } }
            else if (u < 192) { if (PROBE_TYPES & 2) { const int v = u - 128, qt = 15 - (v >> 2), bh = 8 * (v & 3) + xq; unit2<T_SB, (PROBE_PF | 16)>(c, p, l, bh >> 2, bh & 3, qt); } }
            else { if (PROBE_TYPES & 4) { const int v = u - 192, qt = v >> 2, bh = 8 * (v & 3) + xq; unit2<T_CK, (PROBE_PF | 16)>(c, p, l, bh >> 2, bh & 3, qt); } }
        }
    }
}
}

DEVI void phase_prep(const Ctx& c, const Params& p, int l) {
    bf16_t* proj = (bf16_t*)(p.ws + WS_PROJ);
    const float* cs = (const float*)(p.ws + WS_COS); const float* sn = (const float*)(p.ws + WS_SIN);
    const float* gq = p.in[I_CKQN] + l * 64; const float* gk = p.in[I_CKKN] + l * 64;
    for (int row = c.bid * 8 + c.wid; row < MTOK; row += c.nblk * 8) {
        bf16_t* pr = proj + (size_t)row * PROJ_LD;
        {
            uint2 v = *(const uint2*)(pr + PC_CQ + 4 * c.lane);
            float a0 = lo16(v.x), a1 = hi16(v.x), a2 = lo16(v.y), a3 = hi16(v.y);
            const float ss = wave_sum(a0 * a0 + a1 * a1 + a2 * a2 + a3 * a3), r = rsqrtf(ss * (1.f / 256.f) + EPS);
            v.x = pk2(a0 * r, a1 * r); v.y = pk2(a2 * r, a3 * r);
            *(uint2*)(pr + PC_CQ + 4 * c.lane) = v;
        }
        {
            unsigned v = *(const unsigned*)(pr + PC_LAT + 2 * c.lane);
            float a0 = lo16(v), a1 = hi16(v);
            const float ss = wave_sum(a0 * a0 + a1 * a1), r = rsqrtf(ss * (1.f / 128.f) + EPS);
            *(unsigned*)(pr + PC_LAT + 2 * c.lane) = pk2(a0 * r, a1 * r);
        }
        if (c.lane < 16) {
            const float x1 = bf2f(pr[PC_KPE + c.lane]), x2 = bf2f(pr[PC_KPE + 16 + c.lane]);
            const float co = cs[row * 16 + c.lane], si = sn[row * 16 + c.lane];
            pr[PC_KPE + c.lane] = f2bf(x1 * co - x2 * si); pr[PC_KPE + 16 + c.lane] = f2bf(x2 * co + x1 * si);
        }
        {
            uint2 v = *(const uint2*)(pr + PC_CKQ + 4 * c.lane);
            float a0 = lo16(v.x), a1 = hi16(v.x), a2 = lo16(v.y), a3 = hi16(v.y);
            const float ss = sum16(a0 * a0 + a1 * a1 + a2 * a2 + a3 * a3), r = rsqrtf(ss * (1.f / 64.f) + EPS) * (0.125f * 1.4426950408889634f);
            const int d = (4 * c.lane) & 63;
            v.x = pk2(a0 * r * gq[d], a1 * r * gq[d + 1]); v.y = pk2(a2 * r * gq[d + 2], a3 * r * gq[d + 3]);
            *(uint2*)(pr + PC_CKQ + 4 * c.lane) = v;
        }
        {
            uint2 v = *(const uint2*)(pr + PC_CKK + 4 * c.lane);
            float a0 = lo16(v.x), a1 = hi16(v.x), a2 = lo16(v.y), a3 = hi16(v.y);
            const float ss = sum16(a0 * a0 + a1 * a1 + a2 * a2 + a3 * a3), r = rsqrtf(ss * (1.f / 64.f) + EPS);
            const int d = (4 * c.lane) & 63;
            v.x = pk2(a0 * r * gk[d], a1 * r * gk[d + 1]); v.y = pk2(a2 * r * gk[d + 2], a3 * r * gk[d + 3]);
            *(uint2*)(pr + PC_CKK + 4 * c.lane) = v;
        }
    }
}

DEVI void phase_fin(const Ctx& c, const Params& p, int l) {
    bf16_t* qb = (bf16_t*)(p.ws + WS_Q); bf16_t* kvb = (bf16_t*)(p.ws + WS_KV); const bf16_t* proj = (const bf16_t*)(p.ws + WS_PROJ);
    const float* cs = (const float*)(p.ws + WS_COS); const float* sn = (const float*)(p.ws + WS_SIN);
    const float* gq = p.in[I_QQK] + l * 96; const float* gk = p.in[I_KQK] + l * 96;
    const float qscale = 0.10206207261596577f * 1.4426950408889634f;
#pragma unroll 1
    for (int it = c.bid * 512 + c.tid; it < MTOK * 8; it += c.nblk * 512) {
        const int row = it >> 3, hh = it & 7;
        {
            bf16_t* qp = qb + (size_t)row * QLD + hh * 96;
            float ss = 0.f;
#pragma unroll 1
            for (int i = 0; i < 12; ++i) { float t8[8]; load_bf16_row<8>(qp + 8 * i, t8);
#pragma unroll
                for (int j = 0; j < 8; ++j) ss += t8[j] * t8[j]; }
            const float r = rsqrtf(ss * (1.f / 96.f) + EPS) * qscale;
#pragma unroll 1
            for (int i = 0; i < 8; ++i) { float t8[8]; load_bf16_row<8>(qp + 8 * i, t8);
#pragma unroll
                for (int j = 0; j < 8; ++j) t8[j] *= r * gq[8 * i + j];
                store_bf16_row<8>(qp + 8 * i, t8); }
#pragma unroll 1
            for (int i = 0; i < 2; ++i) { float x1[8], x2[8]; load_bf16_row<8>(qp + 64 + 8 * i, x1); load_bf16_row<8>(qp + 80 + 8 * i, x2);
#pragma unroll
                for (int j = 0; j < 8; ++j) { const float co = cs[row * 16 + 8 * i + j], si = sn[row * 16 + 8 * i + j], a = x1[j], b2 = x2[j];
                    x1[j] = (a * co - b2 * si) * r * gq[64 + 8 * i + j]; x2[j] = (b2 * co + a * si) * r * gq[80 + 8 * i + j]; }
                store_bf16_row<8>(qp + 64 + 8 * i, x1); store_bf16_row<8>(qp + 80 + 8 * i, x2); }
        }
    }
#pragma unroll 1
    for (int it = c.bid * 512 + c.tid; it < MTOK * 8; it += c.nblk * 512) {
        const int row = it >> 3, hh = it & 7;
        {
            bf16_t* kp = kvb + (size_t)row * KVLD + hh * 160;
            float kn[64]; load_bf16_row<64>(kp, kn);
            float kr[32]; load_bf16_row<32>(proj + (size_t)row * PROJ_LD + PC_KPE, kr);
            float ss = 0.f;
#pragma unroll
            for (int i = 0; i < 64; ++i) ss += kn[i] * kn[i];
#pragma unroll
            for (int i = 0; i < 32; ++i) ss += kr[i] * kr[i];
            const float r = rsqrtf(ss * (1.f / 96.f) + EPS);
#pragma unroll
            for (int i = 0; i < 64; ++i) kn[i] *= r * gk[i];
#pragma unroll
            for (int i = 0; i < 32; ++i) kr[i] *= r * gk[64 + i];
            store_bf16_row<64>(kp, kn); store_bf16_row<32>(kp + 64, kr);
        }
    }
}

DEVI void phase_att(const Ctx& c, const Params& p, int l) {
    const bf16_t* proj = (const bf16_t*)(p.ws + WS_PROJ); const bf16_t* qb = (const bf16_t*)(p.ws + WS_Q); const bf16_t* kvb = (const bf16_t*)(p.ws + WS_KV);
    bf16_t* o = (bf16_t*)(p.ws + WS_H);
    const float* relb = p.in[I_RELB] + l * 4 * 257;
    for (int wi = c.bid * 8 + c.wid; wi < 8192; wi += c.nblk * 8) {
        if (wi < 2048) {
            const int tt = 63 - (wi & 63), bh = wi >> 6, b = bh >> 2, hh = bh & 3, t0 = tt * 64, t = t0 + c.lane;
            const size_t rowb = (size_t)b * SEQ;
            float q[64], acc[64];
            load_bf16_row<64>(proj + (rowb + t) * PROJ_LD + PC_SBQ + hh * 64, q);
#pragma unroll
            for (int d = 0; d < 64; ++d) acc[d] = 0.f;
            float tail = 0.f;
            for (int s = t0 + 62; s >= 0; --s) {
                float z = dot_bf16<64>(proj + (rowb + s) * PROJ_LD + PC_SBK + hh * 64, q) * 0.125f;
                if (s < t) {
                    const float sp = fmaxf(z, 0.f) + log1pf(__expf(-fabsf(z)));
                    const float w = __expf(z - sp + tail);
                    tail -= sp;
                    axpy_bf16<64>(acc, 1.f, w, proj + (rowb + s) * PROJ_LD + PC_SBV + hh * 64);
                }
            }
            store_bf16_row<64>(o + (rowb + t) * DM + hh * 64, acc);
        } else if (wi < 6144) {
            const int w2 = wi - 2048, tt = 63 - (w2 & 63), bh = w2 >> 6, b = bh >> 3, hh = bh & 7, t0 = tt * 64, t = t0 + c.lane;
            const size_t rowb = (size_t)b * SEQ;
            unsigned q[48]; float acc[64];
#pragma unroll
            for (int i = 0; i < 12; ++i) { const uint4 v = *(const uint4*)(qb + (rowb + t) * QLD + hh * 96 + 8 * i); q[4 * i] = v.x; q[4 * i + 1] = v.y; q[4 * i + 2] = v.z; q[4 * i + 3] = v.w; }
#pragma unroll
            for (int d = 0; d < 64; ++d) acc[d] = 0.f;
            float mx = -3.0e38f, den = 0.f;
            for (int s = 0; s < t0 + 64; ++s) {
                const bf16_t* kp = kvb + (rowb + s) * KVLD + hh * 160;
                const float z = dot_bf16_pk<96>(kp, q);
                const float mn = fmaxf(mx, z), corr = exp2f(mx - mn), pw = exp2f(z - mn);
                mx = mn; den = den * corr + pw;
                axpy_bf16<64>(acc, corr, pw, kp + 96);
            }
            const float inv = 1.f / den;
#pragma unroll
            for (int d = 0; d < 64; ++d) acc[d] *= inv;
            store_bf16_row<64>(o + (rowb + t) * DM + 256 + hh * 64, acc);
        } else {
            const int w2 = wi - 6144, n = w2 & 63, bh = w2 >> 6, b = bh >> 2, hh = bh & 3, t0 = n * 64, t = t0 + c.lane;
            const size_t rowb = (size_t)b * SEQ;
            float q[64], acc[64];
            load_bf16_row<64>(proj + (rowb + t) * PROJ_LD + PC_CKQ + hh * 64, q);
#pragma unroll
            for (int d = 0; d < 64; ++d) acc[d] = 0.f;
            float mx = -3.0e38f, den = 0.f;
            const int s_lo = (n - 8) * 64 < 0 ? 0 : (n - 8) * 64;
            for (int s = s_lo; s < t0 + 64; ++s) {
                float z = dot_bf16<64>(proj + (rowb + s) * PROJ_LD + PC_CKK + hh * 64, q);
                int rel = t - s; rel = rel < -128 ? -128 : rel > 128 ? 128 : rel;
                z += relb[hh * 257 + rel + 128] * 1.4426950408889634f;
                const float mn = fmaxf(mx, z), corr = exp2f(mx - mn), pw = exp2f(z - mn);
                mx = mn; den = den * corr + pw;
                axpy_bf16<64>(acc, corr, pw, proj + (rowb + s) * PROJ_LD + PC_CKV + hh * 64);
            }
            const float inv = 1.f / den;
#pragma unroll
            for (int d = 0; d < 64; ++d) acc[d] *= inv;
            store_bf16_row<64>(o + (rowb + t) * DM + 768 + hh * 64, acc);
        }
    }
}

DEVI void phase_mergenorm(const Ctx& c, const Params& p) {
    bf16_t* o = (bf16_t*)(p.ws + WS_H);
    for (int row = c.bid * 8 + c.wid; row < MTOK; row += c.nblk * 8) {
        bf16_t* orow = o + (size_t)row * DM + 16 * c.lane;
        float v[16]; load_bf16_row<16>(orow, v);
        float ss = 0.f;
#pragma unroll
        for (int i = 0; i < 16; ++i) ss += v[i] * v[i];
        ss = sum16(ss);
        const float s0 = __shfl(ss, 0, 64), s1 = __shfl(ss, 16, 64), s2 = __shfl(ss, 32, 64), s3 = __shfl(ss, 48, 64);
        const int g = c.lane >> 4;
        const float r = g == 0 ? rsqrtf(s0 * (1.f / 256.f) + EPS) : g == 3 ? rsqrtf(s3 * (1.f / 256.f) + EPS) : rsqrtf((s1 + s2) * (1.f / 512.f) + EPS);
#pragma unroll
        for (int i = 0; i < 16; ++i) v[i] *= r;
        store_bf16_row<16>(orow, v);
    }
}


DEVI void phase_fin2(const Ctx& c, const Params& p, int l) {
    bf16_t* __restrict__ kvb = (bf16_t*)(p.ws + WS_KV); bf16_t* __restrict__ proj = (bf16_t*)(p.ws + WS_PROJ);
    const float* __restrict__ cs = (const float*)(p.ws + WS_COS); const float* __restrict__ sn = (const float*)(p.ws + WS_SIN);
    const float* gq = p.in[I_QQK] + l * 96; const float* gk = p.in[I_KQK] + l * 96;
    const float* gcq = p.in[I_CKQN] + l * 64; const float* gck = p.in[I_CKKN] + l * 64;
    LAS float* wsm = (LAS float*)(c.ring + 131072) + c.wid * 32;
    const int lane = c.lane, hq = lane >> 3, p8 = lane & 7, pos0 = 12 * p8;
    float* __restrict__ alpha_arr = (float*)(p.ws + WS_ALPHA);
    float gkp[12];
#pragma unroll
    for (int j = 0; j < 12; ++j) { const int pos = pos0 + j, og = pos < 64 ? pos : 64 + ((pos - 64) >> 1) + 16 * ((pos - 64) & 1); gkp[j] = gk[og] * gq[og]; }
    const int dck = (4 * lane) & 63;
    float gck4[4];
#pragma unroll
    for (int j = 0; j < 4; ++j) gck4[j] = gck[dck + j] * gcq[dck + j];
#pragma unroll 1
    for (int row = c.bid * 8 + c.wid; row < MTOK; row += c.nblk * 8) {
        bf16_t* pr = proj + (size_t)row * PROJ_LD;
        bf16_t* kp = kvb + (size_t)row * KVLD + 160 * hq + pos0;
        bf16_t* vp = kvb + (size_t)row * KVLD + 160 * hq + 96 + 8 * p8;
        const uint2 cqv = *(const uint2*)(pr + PC_CQ + 4 * lane);
        const unsigned latv = *(const unsigned*)(pr + PC_LAT + 2 * lane);
        float x1 = 0.f, x2 = 0.f, co = 0.f, si = 0.f;
        if (lane < 16) { x1 = bf2f(pr[PC_KPE + lane]); x2 = bf2f(pr[PC_KPE + 16 + lane]); co = cs[row * 16 + lane]; si = sn[row * 16 + lane]; }
        uint2 kv[3];
#pragma unroll
        for (int t = 0; t < 3; ++t) { kv[t] = (pos0 + 4 * t < 64) ? *(const uint2*)(kp + 4 * t) : make_uint2(0u, 0u); }
        const uint4 vv = *(const uint4*)vp;
        const uint2 ckk = *(const uint2*)(pr + PC_CKK + 4 * lane);
        float a0 = lo16(cqv.x), a1 = hi16(cqv.x), a2 = lo16(cqv.y), a3 = hi16(cqv.y);
        const float alpha = rsqrtf(wave_sum(a0 * a0 + a1 * a1 + a2 * a2 + a3 * a3) * (1.f / 256.f) + EPS);
        a0 = lo16(latv); a1 = hi16(latv);
        const float beta = rsqrtf(wave_sum(a0 * a0 + a1 * a1) * (1.f / 128.f) + EPS);
        const float ss_pe = wave_sum(x1 * x1 + x2 * x2);
        if (lane < 16) { wsm[2 * lane] = x1 * co - x2 * si; wsm[2 * lane + 1] = x2 * co + x1 * si; }
        if (lane == 0) alpha_arr[row] = alpha;
        float k[12];
#pragma unroll
        for (int t = 0; t < 3; ++t) { k[4 * t] = lo16(kv[t].x); k[4 * t + 1] = hi16(kv[t].x); k[4 * t + 2] = lo16(kv[t].y); k[4 * t + 3] = hi16(kv[t].y); }
        float ssk = 0.f;
#pragma unroll
        for (int j = 0; j < 12; ++j) ssk += k[j] * k[j];
        ssk += __shfl_xor(ssk, 1, 64); ssk += __shfl_xor(ssk, 2, 64); ssk += __shfl_xor(ssk, 4, 64);
        const float rk = rsqrtf((beta * beta * ssk + ss_pe) * (1.f / 96.f) + EPS), rkb = rk * beta;
#pragma unroll
        for (int j = 0; j < 12; ++j) { const int pos = pos0 + j; k[j] = (pos < 64) ? k[j] * rkb * gkp[j] : wsm[pos >= 64 ? pos - 64 : 0] * rk * gkp[j]; }
#pragma unroll
        for (int t = 0; t < 3; ++t) { uint2 o; o.x = pk2(k[4 * t], k[4 * t + 1]); o.y = pk2(k[4 * t + 2], k[4 * t + 3]); *(uint2*)(kp + 4 * t) = o; }
        { uint4 o; o.x = pk2(lo16(vv.x) * beta, hi16(vv.x) * beta); o.y = pk2(lo16(vv.y) * beta, hi16(vv.y) * beta); o.z = pk2(lo16(vv.z) * beta, hi16(vv.z) * beta); o.w = pk2(lo16(vv.w) * beta, hi16(vv.w) * beta); *(uint4*)vp = o; }
        { float b0 = lo16(ckk.x), b1 = hi16(ckk.x), b2 = lo16(ckk.y), b3 = hi16(ckk.y);
          const float r = rsqrtf(sum16(b0 * b0 + b1 * b1 + b2 * b2 + b3 * b3) * (1.f / 64.f) + EPS);
          uint2 o; o.x = pk2(b0 * r * gck4[0], b1 * r * gck4[1]); o.y = pk2(b2 * r * gck4[2], b3 * r * gck4[3]); *(uint2*)(pr + PC_CKK + 4 * lane) = o; }
    }
}

DEVI void phase_mergenorm2(const Ctx& c, const Params& p) {
    bf16_t* o = (bf16_t*)(p.ws + WS_H);
#pragma unroll 1
    for (int row = (c.bid * 8 + c.wid) * 2; row < MTOK; row += c.nblk * 16) {
        uint4 raw[2][2];
#pragma unroll
        for (int q = 0; q < 2; ++q) { const uint4* rp = (const uint4*)(o + (size_t)(row + q) * DM + 16 * c.lane); raw[q][0] = rp[0]; raw[q][1] = rp[1]; }
#pragma unroll
        for (int q = 0; q < 2; ++q) {
            float v[16];
#pragma unroll
            for (int t = 0; t < 2; ++t) { const uint4 u = raw[q][t]; v[8 * t] = lo16(u.x); v[8 * t + 1] = hi16(u.x); v[8 * t + 2] = lo16(u.y); v[8 * t + 3] = hi16(u.y); v[8 * t + 4] = lo16(u.z); v[8 * t + 5] = hi16(u.z); v[8 * t + 6] = lo16(u.w); v[8 * t + 7] = hi16(u.w); }
            float ss = 0.f;
#pragma unroll
            for (int i = 0; i < 16; ++i) ss += v[i] * v[i];
            ss = sum16(ss);
            const float s0 = __shfl(ss, 0, 64), s1 = __shfl(ss, 16, 64), s2 = __shfl(ss, 32, 64), s3 = __shfl(ss, 48, 64);
            const int g = c.lane >> 4;
            const float r = g == 0 ? rsqrtf(s0 * (1.f / 256.f) + EPS) : g == 3 ? rsqrtf(s3 * (1.f / 256.f) + EPS) : rsqrtf((s1 + s2) * (1.f / 512.f) + EPS);
#pragma unroll
            for (int i = 0; i < 16; ++i) v[i] *= r;
            store_bf16_row<16>(o + (size_t)(row + q) * DM + 16 * c.lane, v);
        }
    }
}

DEVI void phase_route(const Ctx& c, const Params& p) {
    const int* cnt = (const int*)(p.ws + WS_CNT); const int* te = (const int*)(p.ws + WS_TOKE); const float* tw = (const float*)(p.ws + WS_TOKW);
    int* perm = (int*)(p.ws + WS_PERM); float* permw = (float*)(p.ws + WS_PERMW); int* texp = (int*)(p.ws + WS_TEXP);
    int* s_tot = (int*)c.sm; int* s_base = s_tot + 16; int* s_seg = s_tot + 32; int* s_e = s_tot + 64;
    for (int ch = c.bid; ch < MTOK / 128; ch += c.nblk) {
        __syncthreads();
        if (c.tid < 16) { int tot = 0, base = 0; for (int i = 0; i < MTOK / 128; ++i) { const int v = cnt[i * 16 + c.tid]; tot += v; base += (i < ch) ? v : 0; } s_tot[c.tid] = tot; s_base[c.tid] = base; }
        if (c.tid >= 64 && c.tid < 64 + 256) { const int i = c.tid - 64; s_e[i] = te[(ch * 128 + (i & 127)) * 2 + (i >> 7)]; }
        __syncthreads();
        if (c.tid < 2) { int a = 0; for (int e = 0; e < 8; ++e) { s_seg[c.tid * 8 + e] = a; a += (s_tot[c.tid * 8 + e] + 255) & ~255; } s_seg[16 + c.tid] = a; }
        __syncthreads();
        if (c.tid < 256) {
            const int s = c.tid >> 7, i = c.tid & 127, e = s_e[s * 128 + i];
            int rank = 0; for (int j = 0; j < i; ++j) rank += (s_e[s * 128 + j] == e);
            const int pos = s_seg[s * 8 + e] + s_base[s * 8 + e] + rank, tok = ch * 128 + i;
            perm[s * MOE_ROWS + pos] = tok; permw[s * MOE_ROWS + pos] = tw[tok * 2 + s];
        }
        if (ch == 0) {
            for (int s = 0; s < 2; ++s) {
                for (int e = 0; e < 8; ++e) {
                    const int beg = s_seg[s * 8 + e] + s_tot[s * 8 + e], end = s_seg[s * 8 + e] + ((s_tot[s * 8 + e] + 255) & ~255);
                    for (int q = beg + c.tid; q < end; q += 512) { perm[s * MOE_ROWS + q] = -1; permw[s * MOE_ROWS + q] = 0.f; }
                    const int t0 = s_seg[s * 8 + e] >> 8, t1 = end >> 8;
                    for (int t = t0 + c.tid; t < t1; t += 512) texp[s * MOE_TILES + t] = e;
                }
                if (c.tid == 0) texp[2 * MOE_TILES + s] = s_seg[16 + s] >> 8;
            }
        }
    }
}


DEVI void phase_moe_tail(const Ctx& c, const Params& p, const float* gate) {
    const int* texp = (const int*)(p.ws + WS_TEXP);
    const int ntl1 = texp[2 * MOE_TILES + 1];
    int q1 = ntl1 - (256 * 2) / 4; q1 = q1 < 0 ? 0 : q1 > 8 ? 8 : q1; if (c.nblk != 256) q1 = 0;
    const int* perm = (const int*)(p.ws + WS_PERM) + MOE_ROWS; const float* permw = (const float*)(p.ws + WS_PERMW) + MOE_ROWS;
    const bf16_t* xs2 = (const bf16_t*)(p.ws + WS_XS2); const float* part = (const float*)(p.ws + WS_PART);
    for (int row = c.bid * 8 + c.wid; row < q1 * 256; row += c.nblk * 8) {
        const int tok = perm[row]; if (tok < 0) continue;
        const float w = permw[row]; const float* gp = gate + (tok / SEQ) * 6144;
#pragma unroll
        for (int i = 0; i < 4; ++i) {
            const int col = 4 * (c.lane + 64 * i);
            const uint2 xv = *(const uint2*)(xs2 + (size_t)tok * DM + col);
            const size_t po = (size_t)row * DM + col; const size_t ps = (size_t)8 * 256 * DM;
            const f32x4 a = (*(const f32x4*)(part + po) + *(const f32x4*)(part + ps + po)) + (*(const f32x4*)(part + 2 * ps + po) + *(const f32x4*)(part + 3 * ps + po));
            const f32x4 g = *(const f32x4*)(gp + col);
            f32x4 o; o[0] = lo16(xv.x) + g[0] * w * a[0]; o[1] = hi16(xv.x) + g[1] * w * a[1]; o[2] = lo16(xv.y) + g[2] * w * a[2]; o[3] = hi16(xv.y) + g[3] * w * a[3];
            *(f32x4*)(p.out + (size_t)tok * DM + col) = o;
        }
    }
}

constexpr int NPHASE = 23;
constexpr int LDS_SM = 131072, LDS_XB = LDS_SM + 16640, LDS_BYTES = LDS_XB + 256;
template <int PH> DEVI void run_phase(const Ctx& c0, const Params& p, int repi = 0) {
    unsigned z_l = 0u; asm volatile("" : "+v"(z_l));
    int wid_l = c0.wid; asm volatile("" : "+s"(wid_l));
    const int lane_l = (int)__builtin_amdgcn_mbcnt_hi(~0u, __builtin_amdgcn_mbcnt_lo(~0u, z_l));
    Ctx c; c.tid = wid_l * 64 + lane_l; c.lane = lane_l; c.wid = wid_l; c.bid = c0.bid; c.nblk = c0.nblk; c.sm = c0.sm; c.ring = c0.ring;
    constexpr int l = PH >= 10 ? 1 : 0;
    constexpr int r = PH == 0 ? -1 : (l == 0 ? PH - 1 : PH - 10);
    unsigned char* ws = p.ws;
    const float* modl = (const float*)(ws + WS_MOD) + l * 8 * 6144;
    bf16_t* H = (bf16_t*)(ws + WS_H); bf16_t* PROJ = (bf16_t*)(ws + WS_PROJ); bf16_t* Q = (bf16_t*)(ws + WS_Q); bf16_t* KV = (bf16_t*)(ws + WS_KV); bf16_t* HID = (bf16_t*)(ws + WS_HID);
    void* XS = (void*)p.out; void* XS2 = (void*)(ws + WS_XS2);
    if constexpr (PH == 0) phase_prologue(c, p, repi);
    else if constexpr (r == 0) { if constexpr (l == 0) phase_norm<false, false>(c, p, p.in[I_X], p.in[I_NMIX] + l * DM, modl, modl + 1024); else phase_norm<false, true>(c, p, XS, p.in[I_NMIX] + l * DM, modl, modl + 1024); }
    else if constexpr (r == 1) {
        pg8::ProbPlain P{H, (const bf16_t*)(ws + WS_WIN) + (size_t)l * 2048 * 1024, 1024, 1024, 1024, {}}; P.S.init(MTOK / 256, 8, c.nblk, c.bid);
        pg8::gemm_phase(c.ring, P, pg8::EpiStoreT{PROJ, PROJ_LD, nullptr, 0, 1 << 30}, c.tid);
    } else if constexpr (r == 2) {
        pg8::ProbUp P{PROJ + PC_CQ, PROJ + PC_LAT, (const bf16_t*)(ws + WS_WQ) + (size_t)l * 768 * 256, (const bf16_t*)(ws + WS_WKV) + (size_t)l * 1280 * 256, PROJ_LD, 256, 256, {}};
        P.S.init(MTOK / 256, 8, c.nblk, c.bid);
        pg8::gemm_phase(c.ring, P, pg8::EpiStoreT{Q, QLD, KV, KVLD, 3}, c.tid);
    } else if constexpr (r == 3) phase_fin2(c, p, l);
    else if constexpr (r == 4) att::phase(c, p, l + 2 * repi);
    else if constexpr (r == 5) {
        pg8::ProbPlain P{H, (const bf16_t*)(ws + WS_WOUT) + (size_t)l * 1024 * 1024, 1024, 1024, 1024, {}}; P.S.init(MTOK / 256, 4, c.nblk, c.bid);
        {
            const float* ssh = (const float*)(ws + WS_SSH); float* rat = (float*)(ws + WS_RAT);
            pg8::Unit u;
            for (int ui = 0; P.next(ui, u); ++ui) if (c.tid < 256) {
                const size_t row = (size_t)u.pm * 256 + c.tid; const float* sp = ssh + row * 16;
                const f32x4 a = *(const f32x4*)sp, b = *(const f32x4*)(sp + 4), c2 = *(const f32x4*)(sp + 8), d = *(const f32x4*)(sp + 12);
                const float s1 = (a[0] + a[1]) + (a[2] + a[3]), s2 = ((b[0] + b[1]) + (b[2] + b[3])) + ((c2[0] + c2[1]) + (c2[2] + c2[3])), s3 = (d[0] + d[1]) + (d[2] + d[3]);
                const float q1 = rsqrtf(s1 * (1.f / 256.f) + EPS), q2 = rsqrtf(s2 * (1.f / 512.f) + EPS), q3 = rsqrtf(s3 * (1.f / 256.f) + EPS);
                *(f32x4*)(rat + row * 4) = (f32x4){q1 / q2, q2 / q3, q3, 0.f};
            }
            asm volatile("s_waitcnt vmcnt(0)" ::: "memory"); __syncthreads();
        }
        if constexpr (l == 0) pg8::gemm_phase<pg8::EpiResidT<false, true>, pg8::ProbPlain, false, true, pg8::GroupRowScale>(c.ring, P, pg8::EpiResidT<false, true>{p.in[I_X], XS, modl + 2048}, c.tid, pg8::GroupRowScale{(const float*)(ws + WS_RAT)});
        else pg8::gemm_phase<pg8::EpiResidT<true, true>, pg8::ProbPlain, false, true, pg8::GroupRowScale>(c.ring, P, pg8::EpiResidT<true, true>{XS, XS, modl + 2048}, c.tid, pg8::GroupRowScale{(const float*)(ws + WS_RAT)});
    } else if constexpr (r == 6) phase_norm<(l == 1), true>(c, p, XS, p.in[I_NFFN] + l * DM, modl + 3072, modl + 4096);
    else if constexpr (l == 0 && r == 7) {
        pg8::ProbPlain P{H, (const bf16_t*)(ws + WS_FGU), 1024, 1024, 1024, {}}; P.S.init(MTOK / 256, 22, c.nblk, c.bid);
        pg8::gemm_phase(c.ring, P, pg8::EpiSwigluT{HID}, c.tid);
    } else if constexpr (l == 0 && r == 8) {
        pg8::ProbPlain P{HID, (const bf16_t*)(ws + WS_FD), DFF, DFF, DFF, {}}; P.S.init(MTOK / 256, 4, c.nblk, c.bid);
        pg8::gemm_phase(c.ring, P, pg8::EpiResidT<true, true>{XS, XS, modl + 5120}, c.tid);
    } else if constexpr (l == 1 && r == 7) phase_route(c, p);
    else if constexpr (l == 1 && r == 12) phase_moe_tail(c, p, modl + 5120);
    else {
        constexpr int s = (r - 8) >> 1;
        const int* perm = (const int*)(ws + WS_PERM) + s * MOE_ROWS; const float* permw = (const float*)(ws + WS_PERMW) + s * MOE_ROWS;
        const int* texp = (const int*)(ws + WS_TEXP);
        const int ntl0 = texp[2 * MOE_TILES + 0];
        int q0 = ntl0 - (256 * 2) / 4; q0 = q0 < 0 ? 0 : q0 > 8 ? 8 : q0; if (c.nblk != 256) q0 = 0;
        const int ntl1 = texp[2 * MOE_TILES + 1];
        int q1 = ntl1 - (256 * 2) / 4; q1 = q1 < 0 ? 0 : q1 > 8 ? 8 : q1; if (c.nblk != 256) q1 = 0;
        bf16_t* HIDs = HID + (size_t)(s * 8) * 256 * DFF;
        int mx = 0;
        if (c.nblk == 256) { const int nw0 = 22 * ntl0, spare = ((nw0 + 255) / 256) * 256 - nw0; mx = spare / 22; int lim = ntl1 - ntl0 + 8; lim = lim < 0 ? 0 : lim; mx = mx > lim ? lim : mx; mx = mx > ntl1 ? ntl1 : mx; }
        if constexpr (((r - 8) & 1) == 0) {
            const int ntl = (s == 0) ? ntl0 : ntl1 - mx;
            if (s == 1 && c.bid >= c.nblk - 4 * q0) {
                const int k = c.bid - (c.nblk - 4 * q0);
                pg8::ProbMoeT<pg8::OneUnit> P{HID, (const bf16_t*)(ws + WS_MD), DFF, DFF, DFF, {k >> 2, k & 3}, texp, (size_t)1024 * DFF, nullptr, 0};
                pg8::gemm_phase(c.ring, P, pg8::EpiMoeDownT<true>{XS, XS2, modl + 5120, (const int*)(ws + WS_PERM), (const float*)(ws + WS_PERMW)}, c.tid);
                __syncthreads();
            }
            LAS unsigned* tab = (LAS unsigned*)(c.ring + 131072);
            pg8::ProbMoeT<pg8::SkipOrder> P{H, (const bf16_t*)(ws + WS_MGU), 1024, 1024, 1024, {{}, (s == 1) ? 4 * q0 : 0, 3, (s == 0) ? mx : 0, MOE_TILES + ntl1 - mx}, texp + s * MOE_TILES, (size_t)5632 * 1024, tab, 0};
            P.S.base.init(ntl, 22, c.nblk, c.bid);
            { pg8::Unit u; for (int ui = 0; ui < 16 && P.next(ui, u); ++ui) if (c.tid < 256) { const int tok = perm[u.pm * 256 + c.tid]; tab[ui * 256 + c.tid] = (unsigned)(tok < 0 ? 0 : tok) * 2048u; } }
            __syncthreads();
            pg8::gemm_phase<pg8::EpiSwigluT, pg8::ProbMoeT<pg8::SkipOrder>, true>(c.ring, P, pg8::EpiSwigluT{HIDs, MOE_TILES, 8 - MOE_TILES}, c.tid);
        } else {
            const int ntl = texp[2 * MOE_TILES + s], qo = (s == 0) ? q0 : q1;
            pg8::ProbMoeT<pg8::StaticOrder> P{HIDs, (const bf16_t*)(ws + WS_MD), DFF, DFF, DFF, {}, texp + s * MOE_TILES, (size_t)1024 * DFF, nullptr, qo};
            P.S.init(ntl - qo, 4, c.nblk, c.bid);
            if constexpr (s == 0) pg8::gemm_phase(c.ring, P, pg8::EpiMoeDownT<true>{XS, XS2, modl + 5120, perm, permw}, c.tid);
            else {
                pg8::gemm_phase(c.ring, P, pg8::EpiMoeDownT<false>{XS2, (void*)p.out, modl + 5120, perm, permw}, c.tid);
                if (q1 > 0) {
                    __syncthreads();
                    pg8::ProbSplitK4 PS{HIDs, (const bf16_t*)(ws + WS_MD), DFF, DFF, DFF, texp + s * MOE_TILES, (size_t)1024 * DFF, 16 * q1, c.nblk, c.bid};
                    pg8::gemm_phase(c.ring, PS, pg8::EpiPartialT{(float*)(ws + WS_PART), 8 * 256}, c.tid);
                }
            }
        }
    }
}
template <int PH, int HI> DEVI void run_range(const Ctx& c, const Params& p, const XcdBarrier& bar) {
    if constexpr (PH < HI) {
        run_phase<PH>(c, p);
        if constexpr ((REP_MASK >> PH) & 1u) { xcd_barrier(bar); run_phase<PH>(c, p, 1); }
        if constexpr (PROBE_TYPES != 0 && PH == 5) { xcd_barrier(bar); Ctx cc = c; cc.tid = threadIdx.x; cc.lane = threadIdx.x & 63; cc.wid = __builtin_amdgcn_readfirstlane(threadIdx.x >> 6); att::phase_probe(cc, p, 0); }
        if constexpr (PH + 1 < HI) { xcd_barrier(bar); run_range<PH + 1, HI>(c, p, bar); }
    }
}

template <int LO, int HI>
__global__ void __launch_bounds__(512, 2) mega_kernel(Params p) {
    extern __shared__ __attribute__((aligned(16))) unsigned char lds[];
    Ctx c; c.bid = blockIdx.x; c.nblk = gridDim.x; c.tid = threadIdx.x; c.lane = threadIdx.x & 63; c.wid = __builtin_amdgcn_readfirstlane(threadIdx.x >> 6);
    c.ring = (LAS unsigned char*)lds; c.sm = (float*)(lds + LDS_SM);
    volatile LAS unsigned* xbw = (volatile LAS unsigned*)((LAS unsigned char*)lds + LDS_XB);
    if (threadIdx.x < 4) xbw[threadIdx.x] = 0u;
    __syncthreads();
    unsigned* barw = (unsigned*)(p.ws + WS_CTL);
    XcdBarrier bar; bar.bar = barw; bar.x = 0; bar.st = xbw;
    if constexpr (HI - LO > 1) bar = xcd_barrier_post(barw, xbw);
    run_range<LO, HI>(c, p, bar);
}

template <int K> static void launch_each(int grid, hipStream_t stream, const Params& p) {
    if constexpr (K < NPHASE) {
        (void)hipFuncSetAttribute((const void*)mega_kernel<K, K + 1>, hipFuncAttributeMaxDynamicSharedMemorySize, LDS_BYTES);
        hipLaunchKernelGGL((mega_kernel<K, K + 1>), dim3(grid), dim3(512), LDS_BYTES, stream, p);
        launch_each<K + 1>(grid, stream, p);
    }
}

extern "C" void kernel_launch(void* const* d_in, const int* in_sizes, int n_in, void* d_out, int out_size, void* d_ws, size_t ws_size, hipStream_t stream) {
    (void)in_sizes; (void)out_size;
    if (n_in < 26 || ws_size < WS_END) { fprintf(stderr, "kernel_launch: bad sizes n_in=%d ws=%zu\n", n_in, ws_size); return; }
    static int grid = 0;
    if (!grid) {
        int dev = 0, cus = 0;
        (void)hipGetDevice(&dev);
        (void)hipDeviceGetAttribute(&cus, hipDeviceAttributeMultiprocessorCount, dev);
        grid = cus;
        if (grid > 256 || grid < 1) grid = 256;
    }
    (void)hipMemsetAsync((unsigned char*)d_ws + WS_CTL, 0, CTL_BYTES, stream);
    Params p{};
    for (int i = 0; i < 26; ++i) p.in[i] = (const float*)d_in[i];
    p.out = (float*)d_out; p.ws = (unsigned char*)d_ws;
#if ONE_LAUNCH
    (void)hipFuncSetAttribute((const void*)mega_kernel<0, NPHASE>, hipFuncAttributeMaxDynamicSharedMemorySize, LDS_BYTES);
    hipLaunchKernelGGL((mega_kernel<0, NPHASE>), dim3(grid), dim3(512), LDS_BYTES, stream, p);
#else
    launch_each<0>(grid, stream, p);
#endif
}
```

```cpp
#include <hip/hip_runtime.h>
#include <stdint.h>
#include <stdio.h>

#ifndef REP_MASK
#define REP_MASK 0u
#endif
#ifndef ONE_LAUNCH
#define ONE_LAUNCH 1
#endif

#define DEVI __device__ __forceinline__
#define LAS __attribute__((address_space(3)))
typedef unsigned short bf16_t;
typedef short bf16x8 __attribute__((ext_vector_type(8)));
typedef float f32x4 __attribute__((ext_vector_type(4)));

constexpr int NB = 8, SEQ = 4096, DM = 1024, MTOK = NB * SEQ;
constexpr int INC = 1952;
constexpr int PROJ_LD = 2048;
constexpr int DFF = 2816, NEXP = 8;
constexpr int QLD = 768;
constexpr int KVLD = 1280;
constexpr float EPS = 1e-6f;
constexpr int PC_SBQ = 0, PC_SBK = 256, PC_SBV = 512, PC_CQ = 768, PC_CKQ = 1024, PC_CKK = 1280, PC_CKV = 1536, PC_LAT = 1792, PC_KPE = 1920;
constexpr int MOE_TILES = 136;
constexpr int WS_BND_WORD = 12288;
constexpr float att_L2E = 1.4426950408889634f;
constexpr int MOE_ROWS = MOE_TILES * 256;

constexpr size_t MiB = 1u << 20;
constexpr size_t WS_CTL = 0, CTL_BYTES = 64 * 1024;
constexpr size_t WS_MOD = 1 * MiB;
constexpr size_t WS_COS = 2 * MiB, WS_SIN = 4 * MiB;
constexpr size_t WS_TOKE = 6 * MiB;
constexpr size_t WS_TOKW = 6 * MiB + 256 * 1024;
constexpr size_t WS_CNT = 6 * MiB + 512 * 1024;
constexpr size_t WS_PERM = 6 * MiB + 640 * 1024;
constexpr size_t WS_PERMW = 7 * MiB;
constexpr size_t WS_TEXP = 7 * MiB + 512 * 1024;
constexpr size_t WS_WIN = 8 * MiB;
constexpr size_t WS_WQ = 16 * MiB;
constexpr size_t WS_WKV = 17 * MiB;
constexpr size_t WS_WOUT = 19 * MiB;
constexpr size_t WS_FGU = 23 * MiB;
constexpr size_t WS_FD = 34 * MiB;
constexpr size_t WS_MGU = 40 * MiB;
constexpr size_t WS_MD = 128 * MiB;
constexpr size_t WS_H = 172 * MiB;
constexpr size_t WS_PROJ = 236 * MiB;
constexpr size_t WS_Q = 364 * MiB;
constexpr size_t WS_KV = 412 * MiB;
constexpr size_t WS_HID = 236 * MiB;
constexpr size_t WS_SSH = 492 * MiB;
constexpr size_t WS_RAT = 494 * MiB;
constexpr size_t WS_ALPHA = 494 * MiB + 512 * 1024;
constexpr size_t WS_XS2 = 440 * MiB;
constexpr size_t WS_PART = 172 * MiB;
constexpr size_t WS_END = 504 * MiB;
static_assert(WS_HID + (size_t)MOE_ROWS * DFF * 2 <= WS_END, "hid fits");
static_assert(WS_KV + (size_t)MTOK * KVLD * 2 <= WS_END, "kv fits");

DEVI float bf2f(bf16_t v) { return __builtin_bit_cast(float, (unsigned)v << 16); }
DEVI bf16_t f2bf(float f) { unsigned u = __builtin_bit_cast(unsigned, f); return (bf16_t)((u + 0x7fffu + ((u >> 16) & 1u)) >> 16); }
DEVI unsigned pk2(float lo, float hi) { return (unsigned)f2bf(lo) | ((unsigned)f2bf(hi) << 16); }
DEVI float lo16(unsigned u) { return __builtin_bit_cast(float, u << 16); }
DEVI float hi16(unsigned u) { return __builtin_bit_cast(float, u & 0xffff0000u); }
DEVI float wave_sum(float v) {
#pragma unroll
    for (int o = 32; o; o >>= 1) v += __shfl_xor(v, o, 64);
    return v;
}
DEVI float sum16(float v) {
#pragma unroll
    for (int o = 8; o; o >>= 1) v += __shfl_xor(v, o, 64);
    return v;
}
template <int N> DEVI void load_bf16_row(const bf16_t* p, float (&out)[N]) {
#pragma unroll
    for (int i = 0; i < N / 8; ++i) {
        const uint4 v = *(const uint4*)(p + 8 * i);
        out[8 * i + 0] = lo16(v.x); out[8 * i + 1] = hi16(v.x); out[8 * i + 2] = lo16(v.y); out[8 * i + 3] = hi16(v.y);
        out[8 * i + 4] = lo16(v.z); out[8 * i + 5] = hi16(v.z); out[8 * i + 6] = lo16(v.w); out[8 * i + 7] = hi16(v.w);
    }
}
template <int N> DEVI void store_bf16_row(bf16_t* p, const float (&v)[N]) {
#pragma unroll
    for (int i = 0; i < N / 8; ++i) {
        uint4 o; o.x = pk2(v[8 * i], v[8 * i + 1]); o.y = pk2(v[8 * i + 2], v[8 * i + 3]); o.z = pk2(v[8 * i + 4], v[8 * i + 5]); o.w = pk2(v[8 * i + 6], v[8 * i + 7]);
        *(uint4*)(p + 8 * i) = o;
    }
}

template <int N> DEVI float dot_bf16(const bf16_t* p, const float (&q)[N]) {
    float z0 = 0.f, z1 = 0.f;
#pragma unroll
    for (int i = 0; i < N / 8; ++i) {
        const uint4 v = *(const uint4*)(p + 8 * i);
        z0 += q[8 * i + 0] * lo16(v.x); z1 += q[8 * i + 1] * hi16(v.x); z0 += q[8 * i + 2] * lo16(v.y); z1 += q[8 * i + 3] * hi16(v.y);
        z0 += q[8 * i + 4] * lo16(v.z); z1 += q[8 * i + 5] * hi16(v.z); z0 += q[8 * i + 6] * lo16(v.w); z1 += q[8 * i + 7] * hi16(v.w);
    }
    return z0 + z1;
}
template <int N> DEVI void axpy_bf16(float (&acc)[N], float corr, float w, const bf16_t* p) {
#pragma unroll
    for (int i = 0; i < N / 8; ++i) {
        const uint4 v = *(const uint4*)(p + 8 * i);
        acc[8 * i + 0] = acc[8 * i + 0] * corr + w * lo16(v.x); acc[8 * i + 1] = acc[8 * i + 1] * corr + w * hi16(v.x);
        acc[8 * i + 2] = acc[8 * i + 2] * corr + w * lo16(v.y); acc[8 * i + 3] = acc[8 * i + 3] * corr + w * hi16(v.y);
        acc[8 * i + 4] = acc[8 * i + 4] * corr + w * lo16(v.z); acc[8 * i + 5] = acc[8 * i + 5] * corr + w * hi16(v.z);
        acc[8 * i + 6] = acc[8 * i + 6] * corr + w * lo16(v.w); acc[8 * i + 7] = acc[8 * i + 7] * corr + w * hi16(v.w);
    }
}

template <int N> DEVI float dot_bf16_pk(const bf16_t* p, const unsigned (&q)[N / 2]) {
    float z0 = 0.f, z1 = 0.f;
#pragma unroll
    for (int i = 0; i < N / 8; ++i) {
        const uint4 v = *(const uint4*)(p + 8 * i);
        z0 += lo16(q[4 * i + 0]) * lo16(v.x); z1 += hi16(q[4 * i + 0]) * hi16(v.x); z0 += lo16(q[4 * i + 1]) * lo16(v.y); z1 += hi16(q[4 * i + 1]) * hi16(v.y);
        z0 += lo16(q[4 * i + 2]) * lo16(v.z); z1 += hi16(q[4 * i + 2]) * hi16(v.z); z0 += lo16(q[4 * i + 3]) * lo16(v.w); z1 += hi16(q[4 * i + 3]) * hi16(v.w);
    }
    return z0 + z1;
}

#define XB_TMO      128
#define XB_XCNT(j)  (256  + 64 * (j))
#define XB_XSUB(j)  (1280 + 64 * (j))
#define XB_XGEN(j)  (2304 + 64 * (j))
#define XB_TOP      3328
#define XB_TOPGEN   3392
#define XCD_BAR_WORDS 3456
#define XB_SPIN_CAP (1u << 24)
DEVI unsigned xb_ld(unsigned* p)              { return __hip_atomic_load(p, __ATOMIC_RELAXED, __HIP_MEMORY_SCOPE_AGENT); }
DEVI unsigned xb_add(unsigned* p, unsigned v) { return __hip_atomic_fetch_add(p, v, __ATOMIC_RELAXED, __HIP_MEMORY_SCOPE_AGENT); }
DEVI unsigned xb_xcc_id() { return (unsigned)__builtin_amdgcn_s_getreg((3 << 11) | 20) & 0xFu; }
#define XB_SPIN(cond, bar) do { unsigned _sp = 0; while (cond) { __builtin_amdgcn_s_sleep(1); \
    if ((++_sp & 255u) == 0u) { if (xb_ld(&(bar)[XB_TMO])) break; if (_sp > XB_SPIN_CAP) { atomicAdd(&(bar)[XB_TMO], 1u); break; } } } } while (0)
struct XcdBarrier { unsigned* bar; unsigned x; volatile LAS unsigned* st; };
DEVI XcdBarrier xcd_barrier_post(unsigned* bar, volatile LAS unsigned* st) {
    XcdBarrier b; b.bar = bar; b.x = xb_xcc_id(); b.st = st;
    if (threadIdx.x == 0) (void)xb_add(&bar[XB_XCNT(b.x)], 1u);
    return b;
}
DEVI void xcd_barrier_complete(unsigned* bar, unsigned x, unsigned& nloc, unsigned& nx) {
    const unsigned G = gridDim.x * gridDim.y * gridDim.z;
    unsigned sum, cnt, mine, sp = 0u;
    for (;;) {
        sum = 0u; cnt = 0u; mine = 0u;
#pragma unroll
        for (unsigned j = 0; j < 16; ++j) { const unsigned c = xb_ld(&bar[XB_XCNT(j)]); sum += c; cnt += (c > 0u) ? 1u : 0u; mine = (j == x) ? c : mine; }
        if (sum == G) break;
        __builtin_amdgcn_s_sleep(1);
        if ((++sp & 255u) == 0u) { if (xb_ld(&bar[XB_TMO])) break; if (sp > XB_SPIN_CAP) { atomicAdd(&bar[XB_TMO], 1u); break; } }
    }
    nloc = mine > 0u ? mine : 1u; nx = cnt > 0u ? cnt : 1u;
}
DEVI void xcd_barrier(const XcdBarrier& b) {
    asm volatile("s_waitcnt vmcnt(0)" ::: "memory");
    __syncthreads();
    if (threadIdx.x == 0) {
        unsigned* bar = b.bar;
        __builtin_amdgcn_s_waitcnt(0);
        unsigned nloc = b.st[0], nx = b.st[1];
        if (nloc == 0u) { xcd_barrier_complete(bar, b.x, nloc, nx); b.st[0] = nloc; b.st[1] = nx; }
        const unsigned old = xb_add(&bar[XB_XSUB(b.x)], 1u);
        const unsigned gen = old / nloc;
        if (old + 1u == (gen + 1u) * nloc) {
            __builtin_amdgcn_fence(__ATOMIC_RELEASE, "agent");
            asm volatile("s_waitcnt vmcnt(0)" ::: "memory");
            const unsigned og = xb_add(&bar[XB_TOP], 1u);
            const unsigned tg = og / nx;
            if (og + 1u == (tg + 1u) * nx) xb_add(&bar[XB_TOPGEN], 1u);
            else XB_SPIN(xb_ld(&bar[XB_TOPGEN]) == tg, bar);
            __builtin_amdgcn_fence(__ATOMIC_ACQUIRE, "agent");
            xb_add(&bar[XB_XGEN(b.x)], 1u);
            asm volatile("s_waitcnt vmcnt(0)" ::: "memory");
        } else {
            XB_SPIN(xb_ld(&bar[XB_XGEN(b.x)]) == gen, bar);
            __builtin_amdgcn_fence(__ATOMIC_ACQUIRE, "agent");
            asm volatile("s_waitcnt vmcnt(0)" ::: "memory");
        }
    }
    __syncthreads();
}

struct Params {
    const float* in[26];
    float* out;
    unsigned char* ws;
};
enum { I_X = 0, I_C, I_POS, I_ADAW, I_ADAB, I_NMIX, I_NFFN, I_WIN, I_QNORM, I_WQUP, I_KVNORM, I_WKVUP, I_QQK, I_KQK, I_CKQN, I_CKKN, I_RELB, I_GON, I_WOUT,
       I_FG, I_FU, I_FD, I_ROUTER, I_MG, I_MU, I_MD };

struct Ctx {
    int bid, nblk, tid, lane, wid;
    float* sm;
    LAS unsigned char* ring;
};

enum { MAP_ID = 0, MAP_WIN, MAP_KV, MAP_GU };
template <int MAP>
DEVI void conv_job(const Ctx& c, const float* src, const float* src2, int src_ld, int Ksrc, const float* gain, bf16_t* dst, int Kdst, int nrows) {
    const int nrb = nrows / 32, nkb = Kdst / 64, total = nrb * nkb;
    float* tile = c.sm;
    for (int it = c.bid; it < total; it += c.nblk) {
        const int rb = it / nkb, kb = it % nkb, k0 = kb * 64;
        const float* s = src; int col = rb * 32;
        if (MAP == MAP_WIN) { const int r = rb * 32; col = r < 1024 ? r : r < 1792 ? 1184 + (r - 1024) : r < 1920 ? 1024 + (r - 1792) : r < 1952 ? 1152 : -1; }
        if (MAP == MAP_KV) { const int r = rb * 32, h = r / 160, o = r % 160; col = o < 64 ? 128 * h + o : o < 96 ? -1 : 128 * h + 64 + (o - 96); }
        if (MAP == MAP_GU) { const int t = rb >> 3, sb = rb & 7; s = (sb >> 2) ? src2 : src; col = 128 * t + 32 * (sb & 3); }
        for (int e = c.tid; e < 2048; e += 512) {
            const int kk = e >> 5, j = e & 31, k = k0 + kk;
            float v = 0.f;
            if (col >= 0 && k < Ksrc) { v = s[(size_t)k * src_ld + col + j]; if (gain) v *= gain[k]; }
            tile[kk * 33 + j] = v;
        }
        __syncthreads();
        for (int e = c.tid; e < 1024; e += 512) {
            const int j = e >> 5, kp = e & 31;
            *(unsigned*)(dst + (size_t)(rb * 32 + j) * Kdst + k0 + 2 * kp) = pk2(tile[(2 * kp) * 33 + j], tile[(2 * kp + 1) * 33 + j]);
        }
        __syncthreads();
    }
}


enum { MAP_Q = 4 };
template <int MAP>
DEVI void conv_job2(const Ctx& c, const float* __restrict__ src, const float* __restrict__ src2, int src_ld, int Ksrc, const float* __restrict__ gain, bf16_t* __restrict__ dst, int Kdst, int nrows) {
    const int nrb = nrows / 64, nkb = Kdst / 64, total = nrb * nkb;
    for (int it = c.bid * 8 + c.wid; it < total; it += c.nblk * 8) {
        const int kb = it / nrb, rb = it % nrb, n = rb * 64 + c.lane, k0 = kb * 64;
        const float* sp = src; int col = n;
        if (MAP == MAP_WIN) col = n < 1024 ? n : n < 1792 ? 1184 + (n - 1024) : n < 1920 ? 1024 + (n - 1792) : n < 1952 ? 1152 + (n - 1920) : -1;
        if (MAP == MAP_KV) { const int h = n / 160, o = n % 160; col = o < 64 ? 128 * h + o : o < 96 ? -1 : 128 * h + 64 + (o - 96); }
        if (MAP == MAP_GU) { const int t = n >> 8, r = n & 255; sp = (r >> 7) ? src2 : src; col = 128 * t + (r & 127); }
        if (MAP == MAP_Q) { const int h = n / 96, pos = n % 96; col = 96 * h + (pos < 64 ? pos : 64 + ((pos - 64) >> 1) + 16 * ((pos - 64) & 1)); }
        const bool live = (col >= 0);
        sp += live ? col : 0;
        bf16_t* dp = dst + (size_t)n * Kdst + k0;
        float v[64];
        if (live) {
#pragma unroll
            for (int j = 0; j < 64; ++j) v[j] = (k0 + j < Ksrc) ? __builtin_nontemporal_load(sp + (size_t)(k0 + j) * src_ld) : 0.f;
            if (gain) {
#pragma unroll
                for (int j = 0; j < 64; ++j) v[j] *= (k0 + j < Ksrc) ? gain[k0 + j] : 0.f;
            }
        } else {
#pragma unroll
            for (int j = 0; j < 64; ++j) v[j] = 0.f;
        }
#pragma unroll
        for (int k8 = 0; k8 < 8; ++k8) {
            uint4 o; o.x = pk2(v[8 * k8], v[8 * k8 + 1]); o.y = pk2(v[8 * k8 + 2], v[8 * k8 + 3]); o.z = pk2(v[8 * k8 + 4], v[8 * k8 + 5]); o.w = pk2(v[8 * k8 + 6], v[8 * k8 + 7]);
            *(uint4*)(dp + k8 * 8) = o;
        }
    }
}

template <int MAP>
DEVI void conv_job3(const Ctx& c, const float* __restrict__ src, const float* __restrict__ src2, int src_ld, int Ksrc, const float* __restrict__ gain, bf16_t* __restrict__ dst, int Kdst, int nrows) {
    const int nrb = nrows / 256, nkb = Kdst / 16, total = nrb * nkb;
    for (int it = c.bid * 8 + c.wid; it < total; it += c.nblk * 8) {
        const int kb = it % nkb, rb = it / nkb, n = rb * 256 + 4 * c.lane, k0 = kb * 16;
        const float* sp = src; int col = n;
        if (MAP == MAP_WIN) col = n < 1024 ? n : n < 1792 ? 1184 + (n - 1024) : n < 1920 ? 1024 + (n - 1792) : n < 1952 ? 1152 + (n - 1920) : -1;
        if (MAP == MAP_KV) { const int h = n / 160, o = n % 160; col = o < 64 ? 128 * h + o : o < 96 ? -1 : 128 * h + 64 + (o - 96); }
        if (MAP == MAP_GU) { const int t = n >> 8, r = n & 255; sp = (r >> 7) ? src2 : src; col = 128 * t + (r & 127); }
        const bool live = (col >= 0) && (k0 < Ksrc);
        f32x4 v[16];
        if (live) {
            sp += col;
#pragma unroll
            for (int j = 0; j < 16; ++j) v[j] = __builtin_nontemporal_load((const f32x4*)(sp + (size_t)(k0 + j) * src_ld));
            if (gain) {
#pragma unroll
                for (int j = 0; j < 16; ++j) v[j] *= gain[k0 + j];
            }
        } else {
#pragma unroll
            for (int j = 0; j < 16; ++j) v[j] = (f32x4){0.f, 0.f, 0.f, 0.f};
        }
#pragma unroll
        for (int i = 0; i < 4; ++i) {
            uint4 o0, o1;
            o0.x = pk2(v[0][i], v[1][i]); o0.y = pk2(v[2][i], v[3][i]); o0.z = pk2(v[4][i], v[5][i]); o0.w = pk2(v[6][i], v[7][i]);
            o1.x = pk2(v[8][i], v[9][i]); o1.y = pk2(v[10][i], v[11][i]); o1.z = pk2(v[12][i], v[13][i]); o1.w = pk2(v[14][i], v[15][i]);
            bf16_t* dp = dst + (size_t)(n + i) * Kdst + k0;
            *(uint4*)dp = o0; *(uint4*)(dp + 8) = o1;
        }
    }
}

template <int MAP>
DEVI void conv_rowblock(const Ctx& c, const float* __restrict__ src, const float* __restrict__ src2, int src_ld, int Ksrc, const float* __restrict__ gain, bf16_t* __restrict__ dst, int Kdst, int rb) {
    const int nkb = Kdst / 16;
    for (int kb = c.wid; kb < nkb; kb += 8) {
        const int n = rb * 256 + 4 * c.lane, k0 = kb * 16;
        const float* sp = src; int col = n;
        if (MAP == MAP_WIN) col = n < 1024 ? n : n < 1792 ? 1184 + (n - 1024) : n < 1920 ? 1024 + (n - 1792) : n < 1952 ? 1152 + (n - 1920) : -1;
        if (MAP == MAP_KV) { const int h = n / 160, o = n % 160; col = o < 64 ? 128 * h + o : o < 96 ? -1 : 128 * h + 64 + (o - 96); }
        if (MAP == MAP_GU) { const int t = n >> 8, r = n & 255; sp = (r >> 7) ? src2 : src; col = 128 * t + (r & 127); }
        const bool live = (col >= 0) && (k0 < Ksrc);
        f32x4 v[16];
        if (live) {
            sp += col;
#pragma unroll
            for (int j = 0; j < 16; ++j) v[j] = __builtin_nontemporal_load((const f32x4*)(sp + (size_t)(k0 + j) * src_ld));
            if (gain) {
#pragma unroll
                for (int j = 0; j < 16; ++j) v[j] *= gain[k0 + j];
            }
        } else {
#pragma unroll
            for (int j = 0; j < 16; ++j) v[j] = (f32x4){0.f, 0.f, 0.f, 0.f};
        }
#pragma unroll
        for (int i = 0; i < 4; ++i) {
            uint4 o0, o1;
            o0.x = pk2(v[0][i], v[1][i]); o0.y = pk2(v[2][i], v[3][i]); o0.z = pk2(v[4][i], v[5][i]); o0.w = pk2(v[6][i], v[7][i]);
            o1.x = pk2(v[8][i], v[9][i]); o1.y = pk2(v[10][i], v[11][i]); o1.z = pk2(v[12][i], v[13][i]); o1.w = pk2(v[14][i], v[15][i]);
            bf16_t* dp = dst + (size_t)(n + i) * Kdst + k0;
            *(uint4*)dp = o0; *(uint4*)(dp + 8) = o1;
        }
    }
}

#ifndef MOE_CONV_IN_ATT
#define MOE_CONV_IN_ATT 1
#endif
#ifndef PRO_SKIP
#define PRO_SKIP 0
#endif
DEVI void phase_prologue(const Ctx& c, const Params& p, int repi = 0) {
    unsigned char* ws = p.ws;
    const int skip = repi ? PRO_SKIP : 0;
    if (!(skip & 1))
    {
        LAS float* sc = (LAS float*)c.ring;
        float* part = c.sm;
        float* mod = (float*)(ws + WS_MOD);
        for (int e = c.tid; e < 8 * 1024; e += 512) { const float v = p.in[I_C][e]; sc[e] = v / (1.f + __expf(-v)); }
        __syncthreads();
        const int col_l = c.tid % 48, ks = c.tid / 48;
        for (int it = c.bid; it < 256; it += c.nblk) {
            const int gcol = it * 48 + col_l, l = gcol / 6144, col = gcol % 6144;
            if (ks < 8) {
                const float* w = p.in[I_ADAW] + (size_t)l * 1024 * 6144 + (size_t)(ks * 128) * 6144 + col;
                float acc[8];
#pragma unroll
                for (int b = 0; b < 8; ++b) acc[b] = 0.f;
#pragma unroll 1
                for (int k0 = 0; k0 < 128; k0 += 32) {
                    float wv[32];
#pragma unroll
                    for (int j = 0; j < 32; ++j) wv[j] = __builtin_nontemporal_load(w + (size_t)(k0 + j) * 6144);
#pragma unroll
                    for (int j = 0; j < 32; ++j)
#pragma unroll
                        for (int b = 0; b < 8; ++b) acc[b] += sc[b * 1024 + ks * 128 + k0 + j] * wv[j];
                }
#pragma unroll
                for (int b = 0; b < 8; ++b) part[(ks * 8 + b) * 48 + col_l] = acc[b];
            }
            __syncthreads();
            if (c.tid < 384) { const int b = c.tid / 48, cl = c.tid % 48;
              const int gc = it * 48 + cl, l2 = gc / 6144, c2 = gc % 6144;
              float a = 0.f;
#pragma unroll
              for (int k2 = 0; k2 < 8; ++k2) a += part[(k2 * 8 + b) * 48 + cl];
              mod[(l2 * 8 + b) * 6144 + c2] = a + p.in[I_ADAB][l2 * 6144 + c2]; }
            __syncthreads();
        }
        __syncthreads();
    }
    if (!(skip & 2)) {
        float* cs = (float*)(ws + WS_COS); float* sn = (float*)(ws + WS_SIN);
        const int* pos = (const int*)p.in[I_POS];
        for (int e = c.bid * 512 + c.tid; e < MTOK * 16; e += c.nblk * 512) {
            const int m = e >> 4, i = e & 15;
            const float inv_freq = powf(10000.0f, -(float)(2 * i) / 32.0f);
            const float ang = (float)pos[m] * inv_freq;
            cs[e] = cosf(ang); sn[e] = sinf(ang);
        }
    }
    if (c.bid == 0 && c.wid == 0) {
        float* bnd = (float*)(ws + WS_CTL) + WS_BND_WORD;
        for (int l = 0; l < 2; ++l) {
            const float* gq = p.in[I_QQK] + l * 96; const float* gk = p.in[I_KQK] + l * 96;
            float g = fabsf(gq[c.lane] * gk[c.lane]); if (c.lane < 32) g = fmaxf(g, fabsf(gq[64 + c.lane] * gk[64 + c.lane]));
            const float* gcq = p.in[I_CKQN] + l * 64; const float* gck = p.in[I_CKKN] + l * 64;
            float gc = fabsf(gcq[c.lane] * gck[c.lane]);
#pragma unroll
            for (int o = 32; o; o >>= 1) { g = fmaxf(g, __shfl_xor(g, o, 64)); gc = fmaxf(gc, __shfl_xor(gc, o, 64)); }
            if (c.lane == 0) bnd[l * 8] = 9.797958971132712f * att_L2E * g * 1.02f + 0.5f;
            for (int h = 0; h < 4; ++h) {
                const float* rb = p.in[I_RELB] + (l * 4 + h) * 257; float b = 0.f;
                for (int i = c.lane; i < 257; i += 64) b = fmaxf(b, fabsf(rb[i]));
#pragma unroll
                for (int o = 32; o; o >>= 1) b = fmaxf(b, __shfl_xor(b, o, 64));
                if (c.lane == 0) bnd[l * 8 + 1 + h] = att_L2E * (8.f * gc + b) * 1.02f + 0.5f;
            }
        }
    }
    if (!(skip & 8)) for (int l = 0; l < 2; ++l) {
        conv_job3<MAP_WIN>(c, p.in[I_WIN] + (size_t)l * 1024 * INC, nullptr, INC, 1024, nullptr, (bf16_t*)(ws + WS_WIN) + (size_t)l * 2048 * 1024, 1024, 2048);
        conv_job2<MAP_Q>(c, p.in[I_WQUP] + (size_t)l * 256 * 768, nullptr, 768, 256, p.in[I_QNORM] + l * 256, (bf16_t*)(ws + WS_WQ) + (size_t)l * 768 * 256, 256, 768);
        conv_job3<MAP_KV>(c, p.in[I_WKVUP] + (size_t)l * 128 * 1024, nullptr, 1024, 128, p.in[I_KVNORM] + l * 128, (bf16_t*)(ws + WS_WKV) + (size_t)l * 1280 * 256, 256, 1280);
        conv_job3<MAP_ID>(c, p.in[I_WOUT] + (size_t)l * 1024 * 1024, nullptr, 1024, 1024, p.in[I_GON] + l * 1024, (bf16_t*)(ws + WS_WOUT) + (size_t)l * 1024 * 1024, 1024, 1024);
    }
    if (!(skip & 8)) conv_job3<MAP_GU>(c, p.in[I_FG], p.in[I_FU], DFF, 1024, nullptr, (bf16_t*)(ws + WS_FGU), 1024, 5632);
    if (!(skip & 8)) conv_job3<MAP_ID>(c, p.in[I_FD], nullptr, 1024, DFF, nullptr, (bf16_t*)(ws + WS_FD), DFF, 1024);
    if (!(skip & 4) && !MOE_CONV_IN_ATT) for (int e = 0; e < NEXP; ++e) {
        conv_job3<MAP_GU>(c, p.in[I_MG] + (size_t)e * 1024 * DFF, p.in[I_MU] + (size_t)e * 1024 * DFF, DFF, 1024, nullptr, (bf16_t*)(ws + WS_MGU) + (size_t)e * 5632 * 1024, 1024, 5632);
        conv_job3<MAP_ID>(c, p.in[I_MD] + (size_t)e * DFF * 1024, nullptr, 1024, DFF, nullptr, (bf16_t*)(ws + WS_MD) + (size_t)e * 1024 * DFF, DFF, 1024);
    }
}

template <bool BF> DEVI f32x4 pg8_ld4(const void* base, size_t idx) {
    if constexpr (BF) { const uint2 v = *(const uint2*)((const bf16_t*)base + idx); return (f32x4){lo16(v.x), hi16(v.x), lo16(v.y), hi16(v.y)}; }
    else return *(const f32x4*)((const float*)base + idx);
}
DEVI float reduce8(const float (&lg)[8], int lane) {
    float t[4], u[2], v;
    const bool b5 = lane & 32, b4 = lane & 16, b3 = lane & 8;
#pragma unroll
    for (int e = 0; e < 4; ++e) { const float keep = b5 ? lg[e + 4] : lg[e], send = b5 ? lg[e] : lg[e + 4]; t[e] = keep + __shfl_xor(send, 32, 64); }
#pragma unroll
    for (int e = 0; e < 2; ++e) { const float keep = b4 ? t[e + 2] : t[e], send = b4 ? t[e] : t[e + 2]; u[e] = keep + __shfl_xor(send, 16, 64); }
    { const float keep = b3 ? u[1] : u[0], send = b3 ? u[0] : u[1]; v = keep + __shfl_xor(send, 8, 64); }
    v += __shfl_xor(v, 4, 64); v += __shfl_xor(v, 2, 64); v += __shfl_xor(v, 1, 64);
    return v;
}
template <bool ROUTER, bool XBF>
DEVI void phase_norm(const Ctx& c, const Params& p, const void* __restrict__ x, const float* __restrict__ gain, const float* __restrict__ sh, const float* __restrict__ sc  ) {
    bf16_t* __restrict__ h = (bf16_t*)(p.ws + WS_H);
    int* sm_e = (int*)c.sm;
    constexpr int NR = 2;
    LAS f32x4* wl = (LAS f32x4*)c.ring;
    if (ROUTER) {
        for (int e4 = c.tid; e4 < 2048; e4 += 512) {
            const int col = e4 >> 1, half = e4 & 1, ln = (col >> 2) & 63, i = col >> 8, j = col & 3;
            wl[((i * 4 + j) * 2 + half) * 64 + ln] = *(const f32x4*)(p.in[I_ROUTER] + (size_t)col * 8 + 4 * half);
        }
        __syncthreads();
    }
#pragma unroll 1
    for (int ch = c.bid; ch < MTOK / 128; ch += c.nblk) {
#pragma unroll 1
        for (int rr = 0; rr < 16; rr += NR) {
            if (ROUTER) asm volatile("" ::: "memory");
            const int rloc = c.wid * 16 + rr, row = ch * 128 + rloc, b = row / SEQ;
            f32x4 v[NR][4]; float ss[NR];
#pragma unroll
            for (int q = 0; q < NR; ++q)
#pragma unroll
                for (int i = 0; i < 4; ++i) v[q][i] = pg8_ld4<XBF>(x, (size_t)(row + q) * DM + 4 * (c.lane + 64 * i));
#pragma unroll
            for (int q = 0; q < NR; ++q) { float a = 0.f;
#pragma unroll
                for (int i = 0; i < 4; ++i) a += v[q][i][0] * v[q][i][0] + v[q][i][1] * v[q][i][1] + v[q][i][2] * v[q][i][2] + v[q][i][3] * v[q][i][3];
                ss[q] = a; }
            float rstdv[NR];
#pragma unroll
            for (int q = 0; q < NR; ++q) rstdv[q] = rsqrtf(wave_sum(ss[q]) * (1.f / DM) + EPS);
            float lg[NR][8];
#pragma unroll
            for (int q = 0; q < NR; ++q)
#pragma unroll
                for (int e = 0; e < 8; ++e) lg[q][e] = 0.f;
#pragma unroll
            for (int i = 0; i < 4; ++i) {
                const int col = 4 * (c.lane + 64 * i);
                const f32x4 g = *(const f32x4*)(gain + col), s1 = *(const f32x4*)(sc + b * 6144 + col), s0 = *(const f32x4*)(sh + b * 6144 + col);
                f32x4 o[NR];
#pragma unroll
                for (int q = 0; q < NR; ++q) {
#pragma unroll
                    for (int j = 0; j < 4; ++j) o[q][j] = v[q][i][j] * rstdv[q] * g[j] * (1.f + s1[j]) + s0[j];
                    uint2 pk; pk.x = pk2(o[q][0], o[q][1]); pk.y = pk2(o[q][2], o[q][3]);
                    *(uint2*)(h + (size_t)(row + q) * DM + col) = pk;
                }
                if (ROUTER) {
                    asm volatile("" ::: "memory");
#pragma unroll
                    for (int j = 0; j < 4; ++j) {
                        const f32x4 w0 = wl[((i * 4 + j) * 2) * 64 + c.lane], w1 = wl[((i * 4 + j) * 2 + 1) * 64 + c.lane];
#pragma unroll
                        for (int q = 0; q < NR; ++q) {
                            lg[q][0] += o[q][j] * w0[0]; lg[q][1] += o[q][j] * w0[1]; lg[q][2] += o[q][j] * w0[2]; lg[q][3] += o[q][j] * w0[3];
                            lg[q][4] += o[q][j] * w1[0]; lg[q][5] += o[q][j] * w1[1]; lg[q][6] += o[q][j] * w1[2]; lg[q][7] += o[q][j] * w1[3];
                        }
                    }
                }
            }
            if (ROUTER) {
#pragma unroll
                for (int q = 0; q < NR; ++q) {
                    const float mine = reduce8(lg[q], c.lane);
                    float l8[8];
#pragma unroll
                    for (int e = 0; e < 8; ++e) l8[e] = __builtin_bit_cast(float, __builtin_amdgcn_readlane(__builtin_bit_cast(int, mine), 8 * e));
                    int e0 = 0; float v0 = l8[0];
#pragma unroll
                    for (int e = 1; e < 8; ++e) if (l8[e] > v0) { v0 = l8[e]; e0 = e; }
                    int e1 = -1; float v1 = -3.0e38f;
#pragma unroll
                    for (int e = 0; e < 8; ++e) if (e != e0 && l8[e] > v1) { v1 = l8[e]; e1 = e; }
                    const float t = __expf(v1 - v0), w0 = 1.f / (1.f + t), w1 = t / (1.f + t);
                    if (c.lane == 0) {
                        int* te = (int*)(p.ws + WS_TOKE); float* tw = (float*)(p.ws + WS_TOKW);
                        te[(row + q) * 2] = e0; te[(row + q) * 2 + 1] = e1; tw[(row + q) * 2] = w0; tw[(row + q) * 2 + 1] = w1;
                        sm_e[rloc + q] = e0; sm_e[128 + rloc + q] = e1;
                    }
                }
            }
        }
        if (ROUTER) {
            __syncthreads();
            if (c.tid < 16) { const int s = c.tid >> 3, e = c.tid & 7; int n = 0; for (int i = 0; i < 128; ++i) n += (sm_e[s * 128 + i] == e); ((int*)(p.ws + WS_CNT))[ch * 16 + c.tid] = n; }
            __syncthreads();
        }
    }
}

struct GemmDesc {
    const bf16_t* A; int lda; const bf16_t* Bt; int ldb; int M, N, K;
    const int* rowidx;
    const int* tile_expert;
    size_t expert_stride;
    const int* ntiles;
};
template <bool DUAL, class Epi>
DEVI void gemm_simple(const Ctx& c, const GemmDesc& g, const Epi& epi) {
    const int fr = c.lane & 15, fq = c.lane >> 4;
    const int Mrows = g.ntiles ? (*g.ntiles) * 256 : g.M;
    const int ntn = DUAL ? (g.N / 256) * 4 : g.N / 64, ntm = Mrows / 32;
    const long total = (long)ntm * ntn;
    for (long u = (long)c.bid * 8 + c.wid; u < total; u += (long)c.nblk * 8) {
        const int mt = (int)(u / ntn), nt = (int)(u % ntn), row0 = mt * 32;
        const bf16_t* Bt = g.Bt;
        if (g.tile_expert) Bt += (size_t)g.tile_expert[row0 >> 8] * g.expert_stride;
        int colb[4];
        if (DUAL) { const int t = nt >> 2, s = nt & 3; colb[0] = 256 * t + 32 * s; colb[1] = colb[0] + 16; colb[2] = colb[0] + 128; colb[3] = colb[2] + 16; }
        else {
#pragma unroll
            for (int i = 0; i < 4; ++i) colb[i] = nt * 64 + 16 * i;
        }
        int r0 = row0 + fr, r1 = row0 + 16 + fr;
        if (g.rowidx) { r0 = g.rowidx[r0]; r1 = g.rowidx[r1]; r0 = r0 < 0 ? 0 : r0; r1 = r1 < 0 ? 0 : r1; }
        const bf16_t* a0 = g.A + (size_t)r0 * g.lda + fq * 8; const bf16_t* a1 = g.A + (size_t)r1 * g.lda + fq * 8;
        const bf16_t* b0 = Bt + (size_t)(colb[0] + fr) * g.ldb + fq * 8; const bf16_t* b1 = Bt + (size_t)(colb[1] + fr) * g.ldb + fq * 8;
        const bf16_t* b2 = Bt + (size_t)(colb[2] + fr) * g.ldb + fq * 8; const bf16_t* b3 = Bt + (size_t)(colb[3] + fr) * g.ldb + fq * 8;
        f32x4 acc[2][4];
#pragma unroll
        for (int m = 0; m < 2; ++m)
#pragma unroll
            for (int i = 0; i < 4; ++i) acc[m][i] = (f32x4){0.f, 0.f, 0.f, 0.f};
        for (int k = 0; k < g.K; k += 32) {
            const bf16x8 af0 = *(const bf16x8*)(a0 + k), af1 = *(const bf16x8*)(a1 + k);
            const bf16x8 bf0 = *(const bf16x8*)(b0 + k), bf1 = *(const bf16x8*)(b1 + k), bf2 = *(const bf16x8*)(b2 + k), bf3 = *(const bf16x8*)(b3 + k);
            acc[0][0] = __builtin_amdgcn_mfma_f32_16x16x32_bf16(af0, bf0, acc[0][0], 0, 0, 0);
            acc[0][1] = __builtin_amdgcn_mfma_f32_16x16x32_bf16(af0, bf1, acc[0][1], 0, 0, 0);
            acc[0][2] = __builtin_amdgcn_mfma_f32_16x16x32_bf16(af0, bf2, acc[0][2], 0, 0, 0);
            acc[0][3] = __builtin_amdgcn_mfma_f32_16x16x32_bf16(af0, bf3, acc[0][3], 0, 0, 0);
            acc[1][0] = __builtin_amdgcn_mfma_f32_16x16x32_bf16(af1, bf0, acc[1][0], 0, 0, 0);
            acc[1][1] = __builtin_amdgcn_mfma_f32_16x16x32_bf16(af1, bf1, acc[1][1], 0, 0, 0);
            acc[1][2] = __builtin_amdgcn_mfma_f32_16x16x32_bf16(af1, bf2, acc[1][2], 0, 0, 0);
            acc[1][3] = __builtin_amdgcn_mfma_f32_16x16x32_bf16(af1, bf3, acc[1][3], 0, 0, 0);
        }
#pragma unroll
        for (int m = 0; m < 2; ++m)
#pragma unroll
            for (int r = 0; r < 4; ++r) {
                const int row = row0 + 16 * m + 4 * fq + r;
                if (DUAL) {
                    const int t = nt >> 2, s = nt & 3, j0 = 128 * t + 32 * s + fr;
                    epi(row, j0, acc[m][0][r], acc[m][2][r]);
                    epi(row, j0 + 16, acc[m][1][r], acc[m][3][r]);
                } else {
#pragma unroll
                    for (int i = 0; i < 4; ++i) epi(row, colb[i] + fr, acc[m][i][r], 0.f);
                }
            }
    }
}

struct EpiStoreBf16 { bf16_t* O; int ldo; DEVI void operator()(int row, int col, float v, float) const { O[(size_t)row * ldo + col] = f2bf(v); } };
struct EpiResid {
    const float* xin; float* out; const float* gate;
    DEVI void operator()(int row, int col, float v, float) const { const int b = row / SEQ; out[(size_t)row * DM + col] = xin[(size_t)row * DM + col] + gate[b * 6144 + col] * v; }
};
struct EpiSwiglu { bf16_t* H; DEVI void operator()(int row, int j, float g, float u) const { H[(size_t)row * DFF + j] = f2bf(g / (1.f + __expf(-g)) * u); } };
struct EpiMoeDown {
    float* out; const float* gate; const int* perm; const float* permw;
    DEVI void operator()(int pos, int col, float v, float) const {
        const int tok = perm[pos]; if (tok < 0) return;
        const int b = tok / SEQ; out[(size_t)tok * DM + col] += gate[b * 6144 + col] * permw[pos] * v;
    }
};


namespace pg8 {
typedef unsigned u32x4 __attribute__((ext_vector_type(4)));
constexpr int BM = 256, BK = 64, HALF = 128, HTB = HALF * BK * 2, STAGE_BYTES = 8 * HTB, NXCD = 8, WGM = 8;
__host__ __device__ __forceinline__ int lds_byte(int r, int c) { const int st = (r >> 4) * 2 + (c >> 5), rr = r & 15, cc = c & 31, ob = rr * 64 + cc * 2; return st * 1024 + (ob ^ (((ob >> 9) & 1) << 5)); }
__host__ __device__ __forceinline__ void stage_rc(int b, int& R, int& C) { const int st = b / 1024, sb = b % 1024, swz = sb ^ (((sb >> 9) & 1) << 5); R = (st >> 1) * 16 + swz / 64; C = (st & 1) * 32 + (swz % 64) / 2; }
__host__ __device__ __forceinline__ int perm32(int rho) { const int n = rho >> 4, i = rho & 15; return 8 * (i >> 2) + 4 * n + (i & 3); }
struct Unit { int pm, pn, ks; };
struct StaticOrder {
    int nM, nN, nwg, G, c;
    __device__ void init(int nM_, int nN_, int G_, int c_) { nM = nM_; nN = nN_; nwg = nM * nN; G = G_; c = c_; }
    __device__ bool next(int i, Unit& u) const { return unit_of((long)i * G + c, u); }
    __device__ bool unit_of(long L, Unit& u) const {
        if (L >= nwg) return false;
        int wgid = (int)L; { const int q = nwg / NXCD, r = nwg % NXCD, xcd = wgid % NXCD, off = wgid / NXCD; wgid = (xcd < r ? xcd * (q + 1) : r * (q + 1) + (xcd - r) * q) + off; }
        const int nig = WGM * nN, gid = wgid / nig, fm = gid * WGM, gsz = (nM - fm) < WGM ? (nM - fm) : WGM;
        u.pm = fm + ((wgid % nig) % gsz); u.pn = (wgid % nig) / gsz; u.ks = 0; return true;
    }
};
DEVI unsigned cvt_pk_bf16(float lo, float hi) { unsigned r; asm volatile("v_cvt_pk_bf16_f32 %0, %1, %2" : "=v"(r) : "v"(lo), "v"(hi)); return r; }

struct NoRowScale { static constexpr bool ON = false; DEVI void load(int, int, int, int, float (&)[8]) const {} };
struct GroupRowScale {
    static constexpr bool ON = true; const float* rat;
    DEVI void load(int pm, int wr, int fr, int sel, float (&f)[8]) const {
#pragma unroll
        for (int ai = 0; ai < 2; ++ai)
#pragma unroll
            for (int m = 0; m < 4; ++m) f[ai * 4 + m] = rat[(unsigned)((pm * BM + ai * HALF + wr * 64 + m * 16 + fr) * 4 + sel)];
    }
};
template <class Epi, class Prob, bool GATHER = false, bool ALIGN_EPI = true, class RS = NoRowScale>
DEVI void gemm_phase(LAS unsigned char* lds, const Prob& P, const Epi& E, int tid_in, const RS& rs = RS()) {
    const int tid = tid_in, wid = __builtin_amdgcn_readfirstlane(tid >> 6), lane = tid & 63, wr = wid >> 2, wc = wid & 3, fr = lane & 15, fq = lane >> 4;
    int nt = P.nt_of_first();
    int RA[2], CA[2];
    unsigned voffA[2], voffB[2];
#pragma unroll
    for (int i = 0; i < 2; ++i) { int R, C; stage_rc(tid * 16 + i * 8192, R, C); const int Rb = Epi::PERM ? ((R & ~31) + perm32(R & 31)) : R;
        RA[i] = R; CA[i] = C; voffA[i] = (unsigned)(R * P.lda + C) * 2u; voffB[i] = (unsigned)(Rb * P.ldb + C) * 2u; }
    const size_t kstep = (size_t)(BK * 2);
    const size_t hstepA = (size_t)HALF * P.lda * 2, hstepB = (size_t)HALF * P.ldb * 2;
    const unsigned ldsw = (unsigned)wid * 1024u;
    const int aoff = lds_byte(wr * 64 + fr, fq * 8), boff = lds_byte(wc * 32 + fr, fq * 8);
#define PG8_SA(b, h) (((b) * 2 + (h)) * HTB)
#define PG8_SB(b, h) ((4 + (b) * 2 + (h)) * HTB)
#define PG8_STAGE(bufoff, gbase, voff) do { _Pragma("unroll") for (int _i = 0; _i < 2; ++_i) \
        __builtin_amdgcn_global_load_lds((const unsigned*)((const char*)(gbase) + (voff)[_i]), (LAS unsigned*)(lds + (bufoff) + ldsw + _i * 8192), 16, 0, 0); } while (0)
#define PG8_LDA(dst, b, h) do { _Pragma("unroll") for (int m = 0; m < 4; ++m) _Pragma("unroll") for (int k = 0; k < 2; ++k) dst[m][k] = *(const LAS bf16x8*)(lds + PG8_SA(b, h) + aoff + m * 2048 + k * 1024); } while (0)
#define PG8_LDB(dst, b, h) do { _Pragma("unroll") for (int n = 0; n < 2; ++n) _Pragma("unroll") for (int k = 0; k < 2; ++k) dst[n][k] = *(const LAS bf16x8*)(lds + PG8_SB(b, h) + boff + n * 2048 + k * 1024); } while (0)
#define PG8_MMA(ai, bj, At, Bt) do { __builtin_amdgcn_s_setprio(1); _Pragma("unroll") for (int m = 0; m < 4; ++m) _Pragma("unroll") for (int n = 0; n < 2; ++n) _Pragma("unroll") for (int k = 0; k < 2; ++k) \
        acc[ai][bj][m][n] = __builtin_amdgcn_mfma_f32_16x16x32_bf16(Bt[n][k], At[m][k], acc[ai][bj][m][n], 0, 0, 0); __builtin_amdgcn_s_setprio(0); } while (0)
#define PG8_WAIT_V(n) asm volatile("s_waitcnt vmcnt(" #n ")" ::: "memory")
#define PG8_WAIT_L(n) asm volatile("s_waitcnt lgkmcnt(" #n ")" ::: "memory")
#define PG8_BAR __builtin_amdgcn_s_barrier()
#define PG8_SCHED __builtin_amdgcn_sched_barrier(0)
#define PG8_STAGE_A(bufoff, ptr, h, vG) do { if constexpr (GATHER) PG8_STAGE(bufoff, ptr, vG[h]); else PG8_STAGE(bufoff, (ptr) + (h) * hstepA, voffA); } while (0)
    Unit cur, nxt; int ui = 0;
    if (!P.next(0, cur)) return;
    f32x4 acc[2][2][4][2];
#pragma unroll
    for (int a = 0; a < 2; ++a)
#pragma unroll
        for (int b = 0; b < 2; ++b)
#pragma unroll
            for (int m = 0; m < 4; ++m)
#pragma unroll
                for (int n = 0; n < 2; ++n) acc[a][b][m][n] = (f32x4){0.f, 0.f, 0.f, 0.f};
    bf16x8 At[4][2], B0[2][2], B1[2][2];
    unsigned vAc[2][2] = {{0u, 0u}, {0u, 0u}}, vAn[2][2] = {{0u, 0u}, {0u, 0u}};
#define PG8_RSCALE(arr) do { _Pragma("unroll") for (int a_ = 0; a_ < 2; ++a_) _Pragma("unroll") for (int m_ = 0; m_ < 4; ++m_) _Pragma("unroll") for (int b_ = 0; b_ < 2; ++b_) _Pragma("unroll") for (int n_ = 0; n_ < 2; ++n_) acc[a_][b_][m_][n_] *= arr[a_ * 4 + m_]; } while (0)
    const char* cA; const char* cB = P.b_tile(cur);
    if constexpr (GATHER) { cA = P.a_base();
#pragma unroll
        for (int h = 0; h < 2; ++h)
#pragma unroll
            for (int i = 0; i < 2; ++i) vAc[h][i] = P.a_rowoff(0, h * HALF + RA[i]) + (unsigned)CA[i] * 2u;
    } else { cA = P.a_tile(cur); }
    PG8_STAGE(PG8_SB(0, 0), cB, voffB); PG8_STAGE(PG8_SB(0, 1), cB + hstepB, voffB); PG8_STAGE_A(PG8_SA(0, 0), cA, 0, vAc); PG8_STAGE_A(PG8_SA(0, 1), cA, 1, vAc);
    if (wr == 1) PG8_BAR;
    PG8_WAIT_V(2); PG8_BAR;
    PG8_STAGE(PG8_SB(1, 0), cB + kstep, voffB); PG8_STAGE_A(PG8_SA(1, 0), cA + kstep, 0, vAc); PG8_STAGE(PG8_SB(1, 1), cB + hstepB + kstep, voffB);
    PG8_WAIT_V(6); PG8_BAR;
    for (;;) {
        const bool has_next = P.next(ui + 1, nxt);
        nt = P.nt_of(cur);
        const char* nA; const char* nB = has_next ? P.b_tile(nxt) : cB;
        if constexpr (GATHER) { nA = cA;
#pragma unroll
            for (int h = 0; h < 2; ++h)
#pragma unroll
                for (int i = 0; i < 2; ++i) vAn[h][i] = has_next ? P.a_rowoff(ui + 1, h * HALF + RA[i]) + (unsigned)CA[i] * 2u : vAc[h][i];
        } else { nA = has_next ? P.a_tile(nxt) : cA; }
        for (int t = 0; t < nt; t += 2) {
            const bool last = (t == nt - 2);
            if constexpr (RS::ON) { if (t == 4 || t == 12) { float rsf[8]; rs.load(cur.pm, wr, fr, t == 4 ? 0 : 1, rsf); PG8_RSCALE(rsf); } }
            const char* a1 = cA + (size_t)(t + 1) * kstep;
            const char* a2 = last ? nA : cA + (size_t)(t + 2) * kstep; const char* b2 = last ? nB : cB + (size_t)(t + 2) * kstep;
            const char* a3 = a2 + kstep; const char* b3 = b2 + kstep;
            unsigned vA2[2][2];
#pragma unroll
            for (int h = 0; h < 2; ++h)
#pragma unroll
                for (int i = 0; i < 2; ++i) vA2[h][i] = (GATHER && last) ? vAn[h][i] : vAc[h][i];
            PG8_LDB(B0, 0, 0); PG8_LDB(B1, 0, 1); PG8_SCHED; PG8_LDA(At, 0, 0); PG8_STAGE_A(PG8_SA(1, 1), a1, 1, vAc);
            PG8_WAIT_V(8); PG8_WAIT_L(0); PG8_BAR; PG8_MMA(0, 0, At, B0); PG8_MMA(0, 1, At, B1); PG8_BAR; PG8_SCHED;
            PG8_LDA(At, 0, 1); PG8_STAGE(PG8_SB(0, 0), b2, voffB); PG8_STAGE(PG8_SB(0, 1), b2 + hstepB, voffB); PG8_STAGE_A(PG8_SA(0, 0), a2, 0, vA2);
            PG8_WAIT_V(8); PG8_WAIT_L(0); PG8_BAR; PG8_MMA(1, 0, At, B0); PG8_MMA(1, 1, At, B1); PG8_BAR; PG8_SCHED;
            PG8_LDB(B0, 1, 0); PG8_LDB(B1, 1, 1); PG8_SCHED; PG8_LDA(At, 1, 0); PG8_STAGE_A(PG8_SA(0, 1), a2, 1, vA2);
            PG8_WAIT_V(8); PG8_WAIT_L(0); PG8_BAR; PG8_MMA(0, 0, At, B0); PG8_MMA(0, 1, At, B1); PG8_BAR; PG8_SCHED;
            PG8_LDA(At, 1, 1); PG8_STAGE(PG8_SB(1, 0), b3, voffB); PG8_STAGE(PG8_SB(1, 1), b3 + hstepB, voffB); PG8_STAGE_A(PG8_SA(1, 0), a3, 0, vA2);
            PG8_WAIT_V(8); PG8_WAIT_L(0); PG8_BAR; PG8_MMA(1, 0, At, B0); PG8_MMA(1, 1, At, B1); PG8_BAR; PG8_SCHED;
        }
        if constexpr (ALIGN_EPI) { if (wr == 0) PG8_BAR; }
        if constexpr (RS::ON) { float rsf[8]; rs.load(cur.pm, wr, fr, 2, rsf); PG8_RSCALE(rsf); }
        E(acc, cur, wr, wc, fr, fq);
        if (!has_next) break;
#pragma unroll
        for (int a = 0; a < 2; ++a)
#pragma unroll
            for (int b = 0; b < 2; ++b)
#pragma unroll
                for (int m = 0; m < 4; ++m)
#pragma unroll
                    for (int n = 0; n < 2; ++n) acc[a][b][m][n] = (f32x4){0.f, 0.f, 0.f, 0.f};
        cur = nxt; cA = nA; cB = nB; ++ui;
        if constexpr (GATHER) {
#pragma unroll
            for (int h = 0; h < 2; ++h)
#pragma unroll
                for (int i = 0; i < 2; ++i) vAc[h][i] = vAn[h][i];
        }
        if constexpr (ALIGN_EPI) { if (wr == 1) PG8_BAR; }
    }
    PG8_WAIT_V(0);
    if constexpr (!ALIGN_EPI) { if (wr == 0) PG8_BAR; }
    PG8_BAR;
#undef PG8_SA
#undef PG8_RSCALE
#undef PG8_SB
#undef PG8_STAGE
#undef PG8_STAGE_A
#undef PG8_LDA
#undef PG8_LDB
#undef PG8_MMA
#undef PG8_WAIT_V
#undef PG8_WAIT_L
#undef PG8_BAR
#undef PG8_SCHED
}

typedef f32x4 Acc[2][2][4][2];
struct EpiStoreT {
    static constexpr bool PERM = true;
    bf16_t* O; int ldc; bf16_t* O2; int ldc2; int split_pn;
    DEVI void operator()(const Acc& acc, const Unit& u, int wr, int wc, int fr, int fq) const {
        const int row0 = u.pm * BM + wr * 64 + fr;
        bf16_t* base = O; int ld = ldc, pn = u.pn;
        if (pn >= split_pn) { base = O2; ld = ldc2; pn -= split_pn; }
        const int col0 = pn * BM + wc * 32 + 8 * fq;
#pragma unroll
        for (int ai = 0; ai < 2; ++ai)
#pragma unroll
            for (int m = 0; m < 4; ++m) { bf16_t* rowp = base + (size_t)(row0 + ai * HALF + m * 16) * ld + col0;
#pragma unroll
                for (int bj = 0; bj < 2; ++bj) { const f32x4 v0 = acc[ai][bj][m][0], v1 = acc[ai][bj][m][1];
                    u32x4 w; w.x = cvt_pk_bf16(v0[0], v0[1]); w.y = cvt_pk_bf16(v0[2], v0[3]); w.z = cvt_pk_bf16(v1[0], v1[1]); w.w = cvt_pk_bf16(v1[2], v1[3]);
                    *(u32x4*)(rowp + bj * HALF) = w; } }
    }
};
struct F8 { f32x4 lo, hi; };
template <bool BF> DEVI F8 ld8(const void* base, size_t idx) {
    F8 r;
    if constexpr (BF) { const u32x4 v = *(const u32x4*)((const bf16_t*)base + idx); r.lo = (f32x4){lo16(v.x), hi16(v.x), lo16(v.y), hi16(v.y)}; r.hi = (f32x4){lo16(v.z), hi16(v.z), lo16(v.w), hi16(v.w)}; }
    else { r.lo = *(const f32x4*)((const float*)base + idx); r.hi = *(const f32x4*)((const float*)base + idx + 4); }
    return r;
}
template <bool BF> DEVI void st8(void* base, size_t idx, const f32x4& lo, const f32x4& hi) {
    if constexpr (BF) { u32x4 o; o.x = cvt_pk_bf16(lo[0], lo[1]); o.y = cvt_pk_bf16(lo[2], lo[3]); o.z = cvt_pk_bf16(hi[0], hi[1]); o.w = cvt_pk_bf16(hi[2], hi[3]); *(u32x4*)((bf16_t*)base + idx) = o; }
    else { *(f32x4*)((float*)base + idx) = lo; *(f32x4*)((float*)base + idx + 4) = hi; }
}
template <bool XBF, bool OBF>
struct EpiResidT {
    static constexpr bool PERM = true;
    const void* xin; void* out; const float* gate;
    DEVI void operator()(const Acc& acc, const Unit& u, int wr, int wc, int fr, int fq) const {
        const int row0 = u.pm * BM + wr * 64 + fr, col0 = u.pn * BM + wc * 32 + 8 * fq, b = (u.pm * BM) / SEQ;
        const float* gp = gate + b * 6144 + col0;
#pragma unroll
        for (int bj = 0; bj < 2; ++bj) {
            const f32x4 g0 = *(const f32x4*)(gp + bj * HALF), g1 = *(const f32x4*)(gp + bj * HALF + 4);
            constexpr int RB = XBF ? 4 : 2;
#pragma unroll
            for (int ai = 0; ai < 2; ++ai)
#pragma unroll
                for (int m0 = 0; m0 < 4; m0 += RB) {
                    F8 xv[RB];
#pragma unroll
                    for (int m = 0; m < RB; ++m) xv[m] = ld8<XBF>(xin, (size_t)(row0 + ai * HALF + (m0 + m) * 16) * DM + col0 + bj * HALF);
                    asm volatile("" ::: "memory");
#pragma unroll
                    for (int m = 0; m < RB; ++m) st8<OBF>(out, (size_t)(row0 + ai * HALF + (m0 + m) * 16) * DM + col0 + bj * HALF, xv[m].lo + g0 * acc[ai][bj][m0 + m][0], xv[m].hi + g1 * acc[ai][bj][m0 + m][1]);
                    asm volatile("" ::: "memory");
                }
        }
    }
};
struct EpiSwigluT {
    static constexpr bool PERM = true;
    bf16_t* H; int pm_wrap = 1 << 30, pm_shift = 0;
    DEVI void operator()(const Acc& acc, const Unit& u, int wr, int wc, int fr, int fq) const {
        const int row0 = (u.pm >= pm_wrap ? u.pm + pm_shift : u.pm) * BM + wr * 64 + fr, j0 = u.pn * HALF + wc * 32 + 8 * fq;
#pragma unroll
        for (int ai = 0; ai < 2; ++ai)
#pragma unroll
            for (int m = 0; m < 4; ++m) {
                float hv[8];
#pragma unroll
                for (int n = 0; n < 2; ++n)
#pragma unroll
                    for (int i = 0; i < 4; ++i) { const float g = acc[ai][0][m][n][i], up = acc[ai][1][m][n][i]; hv[4 * n + i] = g * __builtin_amdgcn_rcpf(1.f + __expf(-g)) * up; }
                u32x4 w; w.x = cvt_pk_bf16(hv[0], hv[1]); w.y = cvt_pk_bf16(hv[2], hv[3]); w.z = cvt_pk_bf16(hv[4], hv[5]); w.w = cvt_pk_bf16(hv[6], hv[7]);
                *(u32x4*)(H + (size_t)(row0 + ai * HALF + m * 16) * DFF + j0) = w;
            }
    }
};
template <bool OBF>
struct EpiMoeDownT {
    static constexpr bool PERM = true;
    const void* xin; void* out; const float* gate; const int* perm; const float* permw;
    DEVI void operator()(const Acc& acc, const Unit& u, int wr, int wc, int fr, int fq) const {
        const int pos0 = u.pm * BM + wr * 64 + fr, col0 = u.pn * BM + wc * 32 + 8 * fq;
        int tk[8]; float wv[8];
#pragma unroll
        for (int r = 0; r < 8; ++r) { const int pos = pos0 + (r >> 2) * HALF + (r & 3) * 16; tk[r] = perm[pos]; wv[r] = permw[pos]; }
#pragma unroll
        for (int r = 0; r < 8; ++r) {
            const int tok = tk[r];
            if (tok >= 0) { const float w = wv[r]; const float* gp = gate + (tok / SEQ) * 6144 + col0; const size_t ro = (size_t)tok * DM + col0;
                F8 xv[2]; f32x4 gv[2][2];
#pragma unroll
                for (int bj = 0; bj < 2; ++bj) { xv[bj] = ld8<true>(xin, ro + bj * HALF); gv[bj][0] = *(const f32x4*)(gp + bj * HALF); gv[bj][1] = *(const f32x4*)(gp + bj * HALF + 4); }
                asm volatile("" ::: "memory");
#pragma unroll
                for (int bj = 0; bj < 2; ++bj) st8<OBF>(out, ro + bj * HALF, xv[bj].lo + gv[bj][0] * w * acc[r >> 2][bj][r & 3][0], xv[bj].hi + gv[bj][1] * w * acc[r >> 2][bj][r & 3][1]);
            }
        }
    }
};

struct ProbPlain {
    static constexpr bool dummy = false;
    const bf16_t* A; const bf16_t* Bt; int lda, ldb, K; StaticOrder S;
    DEVI int nt_of(const Unit&) const { return K / BK; }
    DEVI int nt_of_first() const { return K / BK; }
    DEVI bool next(int i, Unit& u) const { return S.next(i, u); }
    DEVI const char* a_tile(const Unit& u) const { return (const char*)(A + (size_t)u.pm * BM * lda); }
    DEVI const char* b_tile(const Unit& u) const { return (const char*)(Bt + (size_t)u.pn * BM * ldb); }
    DEVI const char* a_base() const { return (const char*)A; }
    DEVI unsigned a_rowoff(int, int) const { return 0u; }
};
struct ProbUp {
    const bf16_t* A1; const bf16_t* A2; const bf16_t* B1; const bf16_t* B2; int lda, ldb, K; StaticOrder S;
    DEVI int nt_of(const Unit& u) const { return u.pn < 3 ? 4 : 2; }
    DEVI int nt_of_first() const { return 4; }
    DEVI bool next(int i, Unit& u) const { return S.next(i, u); }
    DEVI const char* a_tile(const Unit& u) const { return (const char*)((u.pn < 3 ? A1 : A2) + (size_t)u.pm * BM * lda); }
    DEVI const char* b_tile(const Unit& u) const { return (const char*)(u.pn < 3 ? B1 + (size_t)u.pn * BM * ldb : B2 + (size_t)(u.pn - 3) * BM * ldb); }
    DEVI const char* a_base() const { return (const char*)A1; }
    DEVI unsigned a_rowoff(int, int) const { return 0u; }
};
struct SkipOrder {
    StaticOrder base; int nskip, R, m, pmx0;
    DEVI bool next(int i, Unit& u) const {
        const int c = base.c, G = base.G, Gs = G - nskip; const bool lo = c >= Gs; const int round = i + (lo ? R : 0);
        const long L = (round < R) ? (long)round * Gs + c : (long)R * Gs + (long)(round - R) * G + c;
        if (base.unit_of(L, u)) return true;
        const int rounds = (base.nwg + G - 1) / G, x = c - (base.nwg - (rounds - 1) * G);
        if (i != rounds - 1 || x < 0 || x >= 22 * m) return false;
        u.pm = pmx0 + x % m; u.pn = x / m; u.ks = 0; return true;
    }
};
struct OneUnit { int pm, pn; DEVI bool next(int i, Unit& u) const { if (i != 0) return false; u.pm = pm; u.pn = pn; u.ks = 0; return true; } };
template <class Ord>
struct ProbMoeT {
    const bf16_t* A; const bf16_t* Bt; int lda, ldb, K; Ord S; const int* texp; size_t estride; const LAS unsigned* tab; int pm_off;
    DEVI int nt_of(const Unit&) const { return K / BK; }
    DEVI int nt_of_first() const { return K / BK; }
    DEVI bool next(int i, Unit& u) const { if (!S.next(i, u)) return false; u.pm += pm_off; return true; }
    DEVI const char* a_tile(const Unit& u) const { return (const char*)(A + (size_t)u.pm * BM * lda); }
    DEVI const char* b_tile(const Unit& u) const { return (const char*)(Bt + (size_t)texp[u.pm] * estride + (size_t)u.pn * BM * ldb); }
    DEVI const char* a_base() const { return (const char*)A; }
    DEVI unsigned a_rowoff(int ui, int r) const { return tab[ui * 256 + r]; }
};

struct ProbSplitK4 {
    const bf16_t* A; const bf16_t* Bt; int lda, ldb, K; const int* texp; size_t estride; int nsub, G, c;
    DEVI int nt_of(const Unit& u) const { return u.ks < 2 ? 12 : 10; }
    DEVI int nt_of_first() const { return 12; }
    DEVI static int k0_of(int ks) { return 64 * (ks < 2 ? 12 * ks : 24 + 10 * (ks - 2)); }
    DEVI bool next(int i, Unit& u) const { const long L = (long)i * G + c; if (L >= nsub) return false; const int l = (int)L; u.ks = l & 3; u.pn = (l >> 2) & 3; u.pm = l >> 4; return true; }
    DEVI const char* a_tile(const Unit& u) const { return (const char*)(A + (size_t)u.pm * BM * lda + k0_of(u.ks)); }
    DEVI const char* b_tile(const Unit& u) const { return (const char*)(Bt + (size_t)texp[u.pm] * estride + (size_t)u.pn * BM * ldb + k0_of(u.ks)); }
    DEVI const char* a_base() const { return (const char*)A; }
    DEVI unsigned a_rowoff(int, int) const { return 0u; }
};
struct EpiPartialT {
    static constexpr bool PERM = true;
    float* part; int rows;
    DEVI void operator()(const Acc& acc, const Unit& u, int wr, int wc, int fr, int fq) const {
        const int pos0 = u.pm * BM + wr * 64 + fr, col0 = u.pn * BM + wc * 32 + 8 * fq;
        float* base = part + (size_t)u.ks * rows * DM;
#pragma unroll
        for (int ai = 0; ai < 2; ++ai)
#pragma unroll
            for (int m = 0; m < 4; ++m)
#pragma unroll
                for (int bj = 0; bj < 2; ++bj) st8<false>(base, (size_t)(pos0 + ai * HALF + m * 16) * DM + col0 + bj * HALF, acc[ai][bj][m][0], acc[ai][bj][m][1]);
    }
};
}


namespace att {
#define ATT_WRITE_SS (!(PF & 16))
typedef float f32x16 __attribute__((ext_vector_type(16)));
typedef short s16x4 __attribute__((ext_vector_type(4)));
constexpr int LK0 = 0, LK1 = 13312, LV0 = 26624, LV1 = 34816, LBIAS = 43008, LFLAG = 44544, LUNIT = 44672  ;
constexpr float L2E = 1.4426950408889634f;
enum { T_MLA = 0, T_SB = 1, T_CK = 2 };

template <int DK> struct TileRegs { pg8::u32x4 k0, k1, v; };
template <int DK> DEVI void tile_load(TileRegs<DK>& r, const bf16_t* Kg, int pitchK, const bf16_t* Vg, int pitchV, int key0, int tid) {
    constexpr int CPR = DK / 8;
    { const int row = tid / CPR, cc = tid % CPR; r.k0 = *(const pg8::u32x4*)(Kg + (size_t)(key0 + row) * pitchK + cc * 8); }
    if (DK == 96 && tid < 256) { const int ch = tid + 512, row = ch / CPR, cc = ch % CPR; r.k1 = *(const pg8::u32x4*)(Kg + (size_t)(key0 + row) * pitchK + cc * 8); }
    { const int row = tid >> 3, cc = tid & 7; r.v = *(const pg8::u32x4*)(Vg + (size_t)(key0 + row) * pitchV + cc * 8); }
}
template <int DK> DEVI void tile_store(const TileRegs<DK>& r, LAS unsigned char* kb, LAS unsigned char* vb, int tid) {
    constexpr int CPR = DK / 8, PITCH = DK * 2 + 16;
    { const int row = tid / CPR, cc = tid % CPR; *(LAS pg8::u32x4*)(kb + row * PITCH + cc * 16) = r.k0; }
    if (DK == 96 && tid < 256) { const int ch = tid + 512, row = ch / CPR, cc = ch % CPR; *(LAS pg8::u32x4*)(kb + row * PITCH + cc * 16) = r.k1; }
    { const int row = tid >> 3, cc = tid & 7; *(LAS pg8::u32x4*)(vb + (cc >> 2) * 4096 + row * 64 + (cc & 3) * 16) = r.v; }
}
template <int DK> DEVI void loadK(TileRegs<DK>& r, const bf16_t* Kg, int pitchK, int key0, int tid) {
    constexpr int CPR = DK / 8;
    { const int row = tid / CPR, cc = tid % CPR; r.k0 = *(const pg8::u32x4*)(Kg + (size_t)(key0 + row) * pitchK + cc * 8); }
    if (DK == 96 && tid < 256) { const int ch = tid + 512, row = ch / CPR, cc = ch % CPR; r.k1 = *(const pg8::u32x4*)(Kg + (size_t)(key0 + row) * pitchK + cc * 8); }
}
template <int DK> DEVI void loadV(TileRegs<DK>& r, const bf16_t* Vg, int pitchV, int key0, int tid) {
    const int row = tid >> 3, cc = tid & 7; r.v = *(const pg8::u32x4*)(Vg + (size_t)(key0 + row) * pitchV + cc * 8);
}
template <int DK> DEVI void storeK(const TileRegs<DK>& r, LAS unsigned char* kb, int tid) {
    constexpr int CPR = DK / 8, PITCH = DK * 2 + 16;
    { const int row = tid / CPR, cc = tid % CPR; *(LAS pg8::u32x4*)(kb + row * PITCH + cc * 16) = r.k0; }
    if (DK == 96 && tid < 256) { const int ch = tid + 512, row = ch / CPR, cc = ch % CPR; *(LAS pg8::u32x4*)(kb + row * PITCH + cc * 16) = r.k1; }
}
template <int DK> DEVI void storeV(const TileRegs<DK>& r, LAS unsigned char* vb, int tid) {
    const int row = tid >> 3, cc = tid & 7; *(LAS pg8::u32x4*)(vb + (cc >> 2) * 4096 + row * 64 + (cc & 3) * 16) = r.v;
}
DEVI void xswap32(unsigned& a, unsigned& b) { asm volatile("s_nop 1\n\tv_permlane32_swap_b32 %0, %1" : "+v"(a), "+v"(b)); }
DEVI float xhalf_max(float v) { unsigned a = __builtin_bit_cast(unsigned, v), b = a; xswap32(a, b); return fmaxf(__builtin_bit_cast(float, a), __builtin_bit_cast(float, b)); }
DEVI float xhalf_sum(float v) { unsigned a = __builtin_bit_cast(unsigned, v), b = a; xswap32(a, b); return __builtin_bit_cast(float, a) + __builtin_bit_cast(float, b); }
template <int DK> DEVI void qk_tile(f32x16& s0, f32x16& s1, const LAS unsigned char* kb, const bf16x8 (&qf)[DK / 16], int r32, int h) {
    constexpr int PITCH = DK * 2 + 16, NS = DK / 16;
    const LAS unsigned char* k0 = kb + r32 * PITCH + h * 16;
    bf16x8 a0[NS], a1[NS];
#pragma unroll
    for (int st = 0; st < NS; ++st) { a0[st] = *(const LAS bf16x8*)(k0 + st * 32); a1[st] = *(const LAS bf16x8*)(k0 + 32 * PITCH + st * 32); }
#pragma unroll
    for (int i = 0; i < 16; ++i) { s0[i] = 0.f; s1[i] = 0.f; }
    __builtin_amdgcn_sched_barrier(0);
#pragma unroll
    for (int st = 0; st < NS; ++st) {
        s0 = __builtin_amdgcn_mfma_f32_32x32x16_bf16(a0[st], qf[st], s0, 0, 0, 0);
        s1 = __builtin_amdgcn_mfma_f32_32x32x16_bf16(a1[st], qf[st], s1, 0, 0, 0);
    }
    __builtin_amdgcn_sched_barrier(0);
}
DEVI s16x4 vtr(const LAS unsigned char* p) { return __builtin_bit_cast(s16x4, __builtin_amdgcn_ds_read_tr16_b64_v4i16((LAS s16x4*)p)); }
DEVI void pv_tile(f32x16 (&o)[2], const LAS unsigned char* vlane, const bf16x8 (&pf)[4]) {
#pragma unroll
    for (int db = 0; db < 2; ++db) {
        s16x4 lo[4], hi[4];
#pragma unroll
        for (int ks = 0; ks < 4; ++ks) { lo[ks] = vtr(vlane + db * 4096 + ks * 1024); hi[ks] = vtr(vlane + db * 4096 + ks * 1024 + 512); }
        __builtin_amdgcn_sched_barrier(0);
#pragma unroll
        for (int ks = 0; ks < 4; ++ks) {
            const bf16x8 a = (bf16x8){lo[ks][0], lo[ks][1], lo[ks][2], lo[ks][3], hi[ks][0], hi[ks][1], hi[ks][2], hi[ks][3]};
            o[db] = __builtin_amdgcn_mfma_f32_32x32x16_bf16(a, pf[ks], o[db], 0, 0, 0);
        }
        __builtin_amdgcn_sched_barrier(0);
    }
}

template <int DK> DEVI void seg1_fused(f32x16& s0, f32x16& s1, f32x16 (&o)[2], const LAS unsigned char* kb, const LAS unsigned char* vlane, const bf16x8 (&qf)[DK / 16], const bf16x8 (&pf)[4], int r32, int h) {
    constexpr int PITCH = DK * 2 + 16, NS = DK / 16, NH = NS / 2;
    const LAS unsigned char* k0 = kb + r32 * PITCH + h * 16;
    s16x4 lo0[4], hi0[4], lo1[4], hi1[4];
    bf16x8 ka0[NH], ka1[NH], kb0[NH], kb1[NH];
#pragma unroll
    for (int ks = 0; ks < 4; ++ks) { lo0[ks] = vtr(vlane + ks * 1024); hi0[ks] = vtr(vlane + ks * 1024 + 512); }
#pragma unroll
    for (int st = 0; st < NH; ++st) { ka0[st] = *(const LAS bf16x8*)(k0 + st * 32); ka1[st] = *(const LAS bf16x8*)(k0 + 32 * PITCH + st * 32); }
#pragma unroll
    for (int i = 0; i < 16; ++i) { s0[i] = 0.f; s1[i] = 0.f; }
    __builtin_amdgcn_sched_barrier(0);
#pragma unroll
    for (int ks = 0; ks < 4; ++ks) {
        const bf16x8 a = (bf16x8){lo0[ks][0], lo0[ks][1], lo0[ks][2], lo0[ks][3], hi0[ks][0], hi0[ks][1], hi0[ks][2], hi0[ks][3]};
        o[0] = __builtin_amdgcn_mfma_f32_32x32x16_bf16(a, pf[ks], o[0], 0, 0, 0);
    }
#pragma unroll
    for (int ks = 0; ks < 4; ++ks) { lo1[ks] = vtr(vlane + 4096 + ks * 1024); hi1[ks] = vtr(vlane + 4096 + ks * 1024 + 512); }
    __builtin_amdgcn_sched_barrier(0);
#pragma unroll
    for (int st = 0; st < NH; ++st) {
        s0 = __builtin_amdgcn_mfma_f32_32x32x16_bf16(ka0[st], qf[st], s0, 0, 0, 0);
        s1 = __builtin_amdgcn_mfma_f32_32x32x16_bf16(ka1[st], qf[st], s1, 0, 0, 0);
    }
#pragma unroll
    for (int st = 0; st < NH; ++st) { kb0[st] = *(const LAS bf16x8*)(k0 + (NH + st) * 32); kb1[st] = *(const LAS bf16x8*)(k0 + 32 * PITCH + (NH + st) * 32); }
    __builtin_amdgcn_sched_barrier(0);
#pragma unroll
    for (int ks = 0; ks < 4; ++ks) {
        const bf16x8 a = (bf16x8){lo1[ks][0], lo1[ks][1], lo1[ks][2], lo1[ks][3], hi1[ks][0], hi1[ks][1], hi1[ks][2], hi1[ks][3]};
        o[1] = __builtin_amdgcn_mfma_f32_32x32x16_bf16(a, pf[ks], o[1], 0, 0, 0);
    }
    __builtin_amdgcn_sched_barrier(0);
#pragma unroll
    for (int st = 0; st < NH; ++st) {
        s0 = __builtin_amdgcn_mfma_f32_32x32x16_bf16(kb0[st], qf[NH + st], s0, 0, 0, 0);
        s1 = __builtin_amdgcn_mfma_f32_32x32x16_bf16(kb1[st], qf[NH + st], s1, 0, 0, 0);
    }
    __builtin_amdgcn_sched_barrier(0);
}
DEVI void pack_p(bf16x8 (&pf)[4], const f32x16& s0, const f32x16& s1) {
#pragma unroll
    for (int st = 0; st < 2; ++st) {
        unsigned a[4], b[4];
#pragma unroll
        for (int i = 0; i < 4; ++i) { a[i] = pg8::cvt_pk_bf16(s0[8 * st + 2 * i], s0[8 * st + 2 * i + 1]); b[i] = pg8::cvt_pk_bf16(s1[8 * st + 2 * i], s1[8 * st + 2 * i + 1]); }
        pf[st] = __builtin_bit_cast(bf16x8, (pg8::u32x4){a[0], a[1], a[2], a[3]});
        pf[2 + st] = __builtin_bit_cast(bf16x8, (pg8::u32x4){b[0], b[1], b[2], b[3]});
    }
}
typedef float f32x2 __attribute__((ext_vector_type(2)));
DEVI void softmax_tile(f32x16& s0, f32x16& s1, float& m_run, float& l_run, f32x16 (&o)[2], bf16x8 (&pf)[4]) {
    float mx = fmaxf(s0[0], s1[0]);
#pragma unroll
    for (int i = 1; i < 16; ++i) mx = fmaxf(fmaxf(mx, s0[i]), s1[i]);
    mx = xhalf_max(mx);
    const float mn = fmaxf(m_run, mx);
    const f32x2 mn2 = (f32x2){mn, mn};
    f32x2 sum2 = (f32x2){0.f, 0.f};
#pragma unroll
    for (int i = 0; i < 16; i += 2) {
        f32x2 a = (f32x2){s0[i], s0[i + 1]} - mn2, b = (f32x2){s1[i], s1[i + 1]} - mn2;
        a.x = __builtin_amdgcn_exp2f(a.x); a.y = __builtin_amdgcn_exp2f(a.y); b.x = __builtin_amdgcn_exp2f(b.x); b.y = __builtin_amdgcn_exp2f(b.y);
        s0[i] = a.x; s0[i + 1] = a.y; s1[i] = b.x; s1[i + 1] = b.y;
        sum2 += a + b;
    }
    if (__any(mn != m_run)) {
        const float corr = __builtin_amdgcn_exp2f(m_run - mn);
        const f32x2 c2 = (f32x2){corr, corr};
        l_run *= corr;
#pragma unroll
        for (int i = 0; i < 16; i += 2) {
            f32x2 a = (f32x2){o[0][i], o[0][i + 1]} * c2, b = (f32x2){o[1][i], o[1][i + 1]} * c2;
            o[0][i] = a.x; o[0][i + 1] = a.y; o[1][i] = b.x; o[1][i + 1] = b.y;
        }
        m_run = mn;
    }
    l_run += sum2.x + sum2.y;
    pack_p(pf, s0, s1);
}
template <bool MASKED>
DEVI void sb_tile(f32x16& s0, f32x16& s1, float& carry, bf16x8 (&pf)[4], int h, int t_rel  ) {
    constexpr float ZS = 0.125f * 1.4426950408889634f;
    f32x16 L0, L1;
    float G[2][4], Gp[2][4];
#pragma unroll
    for (int x = 0; x < 2; ++x)
#pragma unroll
        for (int g = 0; g < 4; ++g) {
            float gs = 0.f;
#pragma unroll
            for (int i = 0; i < 4; ++i) {
                const int rr = 4 * g + i;
                const float z = (x ? s1[rr] : s0[rr]) * ZS;
                const float e = __builtin_amdgcn_exp2f(-fabsf(z));
                const float sp = fmaxf(z, 0.f) + __builtin_amdgcn_logf(1.f + e);
                float L = -sp, ls = z - sp;
                if (MASKED) { const bool valid = (32 * x + 8 * g + 4 * h + i) < t_rel; L = valid ? L : 0.f; ls = valid ? ls : -1.0e30f; }
                gs += L;
                if (x) { s1[rr] = ls; L1[rr] = L; } else { s0[rr] = ls; L0[rr] = L; }
            }
            G[x][g] = gs;
        }
#pragma unroll
    for (int x = 0; x < 2; ++x)
#pragma unroll
        for (int g = 0; g < 4; ++g) Gp[x][g] = xhalf_sum(G[x][g]) - G[x][g];
    float T[2][4]; float run = 0.f;
#pragma unroll
    for (int x = 1; x >= 0; --x)
#pragma unroll
        for (int g = 3; g >= 0; --g) { T[x][g] = run; run += G[x][g] + Gp[x][g]; }
#pragma unroll
    for (int x = 0; x < 2; ++x)
#pragma unroll
        for (int g = 0; g < 4; ++g) {
            float tl = carry + T[x][g] + (h == 0 ? Gp[x][g] : 0.f);
#pragma unroll
            for (int i = 3; i >= 0; --i) {
                const int rr = 4 * g + i;
                if (x) { const float w = __builtin_amdgcn_exp2f(s1[rr] + tl); tl += L1[rr]; s1[rr] = w; }
                else   { const float w = __builtin_amdgcn_exp2f(s0[rr] + tl); tl += L0[rr]; s0[rr] = w; }
            }
        }
    carry += run;
    pack_p(pf, s0, s1);
}


DEVI void unpack8(const bf16x8& f, float* q) {
#pragma unroll
    for (int j = 0; j < 8; ++j) q[j] = __builtin_bit_cast(float, (unsigned)(unsigned short)f[j] << 16);
}
DEVI bf16x8 pack8(const float* q, float sc) {
    pg8::u32x4 w; w.x = pg8::cvt_pk_bf16(q[0] * sc, q[1] * sc); w.y = pg8::cvt_pk_bf16(q[2] * sc, q[3] * sc); w.z = pg8::cvt_pk_bf16(q[4] * sc, q[5] * sc); w.w = pg8::cvt_pk_bf16(q[6] * sc, q[7] * sc);
    return __builtin_bit_cast(bf16x8, w);
}
DEVI void qprep_mla(bf16x8 (&qf)[6], const Params& p, size_t grow, int h) {
    float q[48];
#pragma unroll
    for (int st = 0; st < 6; ++st) unpack8(qf[st], q + 8 * st);
    const float* cs = (const float*)(p.ws + WS_COS) + grow * 16; const float* sn = (const float*)(p.ws + WS_SIN) + grow * 16;
    const f32x4 c0 = *(const f32x4*)(cs + 4 * h), c1 = *(const f32x4*)(cs + 8 + 4 * h), s0 = *(const f32x4*)(sn + 4 * h), s1 = *(const f32x4*)(sn + 8 + 4 * h);
    float ss = 0.f;
#pragma unroll
    for (int i = 0; i < 48; ++i) ss += q[i] * q[i];
    ss = xhalf_sum(ss);
#pragma unroll
    for (int m = 0; m < 4; ++m) {
        { const float a = q[32 + 2 * m], b = q[33 + 2 * m]; q[32 + 2 * m] = a * c0[m] - b * s0[m]; q[33 + 2 * m] = b * c0[m] + a * s0[m]; }
        { const float a = q[40 + 2 * m], b = q[41 + 2 * m]; q[40 + 2 * m] = a * c1[m] - b * s1[m]; q[41 + 2 * m] = b * c1[m] + a * s1[m]; }
    }
    const float alpha = ((const float*)(p.ws + WS_ALPHA))[grow];
    const float rq = rsqrtf(alpha * alpha * ss * (1.f / 96.f) + EPS) * alpha * (0.10206207261596577f * L2E);
#pragma unroll
    for (int st = 0; st < 6; ++st) qf[st] = pack8(q + 8 * st, rq);
}
DEVI void qprep_ck(bf16x8 (&qf)[4]) {
    float q[32];
#pragma unroll
    for (int st = 0; st < 4; ++st) unpack8(qf[st], q + 8 * st);
    float ss = 0.f;
#pragma unroll
    for (int i = 0; i < 32; ++i) ss += q[i] * q[i];
    ss = xhalf_sum(ss);
    const float r = rsqrtf(ss * (1.f / 64.f) + EPS) * (0.125f * L2E);
#pragma unroll
    for (int st = 0; st < 4; ++st) qf[st] = pack8(q + 8 * st, r);
}

template <int TYPE, int PF = 0>
DEVI void unit(const Ctx& cin, const Params& p, int l, int b, int hh, int qt) {
    constexpr int DK = (TYPE == T_MLA) ? 96 : 64;
    Ctx c = cin; { int ln = cin.lane; asm volatile("" : "+v"(ln)); c.lane = ln; c.tid = cin.wid * 64 + ln; }
    const bf16_t* proj = (const bf16_t*)(p.ws + WS_PROJ); const bf16_t* qb = (const bf16_t*)(p.ws + WS_Q); const bf16_t* kvb = (const bf16_t*)(p.ws + WS_KV);
    bf16_t* O = (bf16_t*)(p.ws + WS_H);
    const size_t rowb = (size_t)b * SEQ;
    const bf16_t *Qg, *Kg, *Vg; int pitchQ, pitchKV, ocol;
    if (TYPE == T_MLA) { Qg = qb + rowb * QLD + hh * 96; pitchQ = QLD; Kg = kvb + rowb * KVLD + hh * 160; Vg = Kg + 96; pitchKV = KVLD; ocol = 256 + hh * 64; }
    else if (TYPE == T_SB) { Qg = proj + rowb * PROJ_LD + PC_SBQ + hh * 64; pitchQ = PROJ_LD; Kg = proj + rowb * PROJ_LD + PC_SBK + hh * 64; Vg = proj + rowb * PROJ_LD + PC_SBV + hh * 64; pitchKV = PROJ_LD; ocol = hh * 64; }
    else { Qg = proj + rowb * PROJ_LD + PC_CKQ + hh * 64; pitchQ = PROJ_LD; Kg = proj + rowb * PROJ_LD + PC_CKK + hh * 64; Vg = proj + rowb * PROJ_LD + PC_CKV + hh * 64; pitchKV = PROJ_LD; ocol = 768 + hh * 64; }
    LAS unsigned char* ring = c.ring;
    const int w = c.wid, r32 = c.lane & 31, h = c.lane >> 5, q0 = qt * 256, trow = q0 + 32 * w + r32;
    int jlo, jhi;
    if (TYPE == T_MLA) { jlo = 0; jhi = 4 * qt + 3; }
    else if (TYPE == T_SB) { jlo = 0; jhi = 4 * qt + 3; }
    else { jlo = 4 * qt - 8 < 0 ? 0 : 4 * qt - 8; jhi = 4 * qt + 3; }
    const int cw = 4 * qt + (w >> 1);
    bf16x8 qf[DK / 16];
#pragma unroll
    for (int st = 0; st < DK / 16; ++st) qf[st] = *(const bf16x8*)(Qg + (size_t)trow * pitchQ + st * 16 + h * 8);
    if constexpr (TYPE == T_MLA) qprep_mla(qf, p, rowb + trow, h);
    if constexpr (TYPE == T_CK) qprep_ck(qf);
    if (TYPE == T_CK) { LAS float* bt = (LAS float*)(ring + LBIAS); const float* rb = p.in[I_RELB] + (l * 4 + hh) * 257; if (c.tid < 257) bt[c.tid] = rb[c.tid] * L2E; }
    if (TYPE == T_SB) { LAS unsigned* fl = (LAS unsigned*)(ring + LFLAG); if (c.tid < 16) fl[c.tid] = 0u; }
    f32x16 o[2];
#pragma unroll
    for (int i = 0; i < 16; ++i) { o[0][i] = 0.f; o[1][i] = 0.f; }
    float m_run = -1.0e30f, l_run = 0.f, carry = 0.f;
    bool wave_done = false;
    const int vlane = (4 * h + ((c.lane & 15) >> 2)) * 64 + (((c.lane >> 4) & 1) * 16 + 4 * (c.lane & 3)) * 2;
    const int ntile = jhi - jlo + 1;
    TileRegs<DK> tr;
    auto tile_of = [&](int it) { return (TYPE == T_SB) ? (jhi - it) : (jlo + it); };
    tile_load<DK>(tr, Kg, pitchKV, Vg, pitchKV, tile_of(0) * 64, c.tid);
    tile_store<DK>(tr, ring + LK0, ring + LV0, c.tid);
    __syncthreads();
    for (int it = 0; it < ntile; ++it) {
        const int j = tile_of(it), buf = it & 1;
        const bool more = (it + 1 < ntile);
        if (more) tile_load<DK>(tr, Kg, pitchKV, Vg, pitchKV, tile_of(it + 1) * 64, c.tid);
        const LAS unsigned char* kb = ring + (buf ? LK1 : LK0); const LAS unsigned char* vb = ring + (buf ? LV1 : LV0);
        bool active;
        if (TYPE == T_MLA) active = (j <= cw);
        else if (TYPE == T_SB) active = (j <= cw) && !wave_done;
        else active = (j <= cw) && (j >= cw - 8);
        if (active) {
            f32x16 s0, s1; bf16x8 pf[4];
            qk_tile<DK>(s0, s1, kb, qf, r32, h);
            if (TYPE == T_MLA) softmax_tile(s0, s1, m_run, l_run, o, pf);
            else if (TYPE == T_CK) {
                const int dlt = cw - j;
                const LAS float* bt = (const LAS float*)(ring + LBIAS);
                if (dlt >= 3) { const float bc = bt[256];
#pragma unroll
                    for (int i = 0; i < 16; ++i) { s0[i] += bc; s1[i] += bc; } }
                else { const int base = 64 * dlt + (32 * (w & 1) + r32) - 4 * h + 128;
#pragma unroll
                    for (int i = 0; i < 16; ++i) { int i0 = base - (8 * (i >> 2) + (i & 3)), i1 = i0 - 32; i0 = i0 > 256 ? 256 : i0; i1 = i1 > 256 ? 256 : i1; s0[i] += bt[i0]; s1[i] += bt[i1]; } }
                softmax_tile(s0, s1, m_run, l_run, o, pf);
            } else {
                if (j == cw) sb_tile<true>(s0, s1, carry, pf, h, trow - j * 64); else sb_tile<false>(s0, s1, carry, pf, h, 0);
                if (__all(carry <= -144.3f)) wave_done = true;
            }
            pv_tile(o, vb + vlane, pf);
        }
        if (TYPE == T_SB) { LAS unsigned* fl = (LAS unsigned*)(ring + LFLAG); if (c.lane == 0) fl[(it & 1) * 8 + w] = wave_done ? 0u : 1u; }
        if (more) tile_store<DK>(tr, ring + (buf ? LK0 : LK1), ring + (buf ? LV0 : LV1), c.tid);
        __syncthreads();
        if (TYPE == T_SB) {
            const LAS unsigned* fl = (const LAS unsigned*)(ring + LFLAG); unsigned any = 0u;
#pragma unroll
            for (int k = 0; k < 8; ++k) any |= fl[(it & 1) * 8 + k];
            if (any == 0u) break;
        }
    }
    float inv = 1.f;
    if (TYPE != T_SB) { const float lt = l_run + __shfl_xor(l_run, 32, 64); inv = 1.f / lt; }
    bf16_t* orow = O + (rowb + trow) * DM + ocol;
    float sq = 0.f;
#pragma unroll
    for (int db = 0; db < 2; ++db)
#pragma unroll
        for (int g = 0; g < 4; ++g) {
            const float v0 = o[db][4 * g] * inv, v1 = o[db][4 * g + 1] * inv, v2 = o[db][4 * g + 2] * inv, v3 = o[db][4 * g + 3] * inv;
            sq += (v0 * v0 + v1 * v1) + (v2 * v2 + v3 * v3);
            uint2 v; v.x = pg8::cvt_pk_bf16(v0, v1); v.y = pg8::cvt_pk_bf16(v2, v3);
            *(uint2*)(orow + 32 * db + 8 * g + 4 * h) = v;
        }
    sq = xhalf_sum(sq);
    if (h == 0 && ATT_WRITE_SS) ((float*)(p.ws + WS_SSH))[(rowb + trow) * 16 + (ocol >> 6)] = sq;
    __syncthreads();
}


#ifndef ATT_UNIT
#define ATT_UNIT unit2
#endif
#ifndef ATT_FUSED_SEG1
#define ATT_FUSED_SEG1 0
#endif

template <int DK> DEVI void qk_tile_c(f32x16& s0, f32x16& s1, const f32x16& cin, const LAS unsigned char* kb, const bf16x8 (&qf)[DK / 16], int r32, int h) {
    constexpr int PITCH = DK * 2 + 16, NS = DK / 16;
    const LAS unsigned char* k0 = kb + r32 * PITCH + h * 16;
    bf16x8 a0[NS], a1[NS];
#pragma unroll
    for (int st = 0; st < NS; ++st) { a0[st] = *(const LAS bf16x8*)(k0 + st * 32); a1[st] = *(const LAS bf16x8*)(k0 + 32 * PITCH + st * 32); }
    __builtin_amdgcn_sched_barrier(0);
    s0 = __builtin_amdgcn_mfma_f32_32x32x16_bf16(a0[0], qf[0], cin, 0, 0, 0);
    s1 = __builtin_amdgcn_mfma_f32_32x32x16_bf16(a1[0], qf[0], cin, 0, 0, 0);
#pragma unroll
    for (int st = 1; st < NS; ++st) {
        s0 = __builtin_amdgcn_mfma_f32_32x32x16_bf16(a0[st], qf[st], s0, 0, 0, 0);
        s1 = __builtin_amdgcn_mfma_f32_32x32x16_bf16(a1[st], qf[st], s1, 0, 0, 0);
    }
    __builtin_amdgcn_sched_barrier(0);
}
constexpr float DEFER_THR = 6.0f;
DEVI void softmax_tile_defer(f32x16& s0, f32x16& s1, float& m_run, f32x16& negm, float& l_run, f32x16 (&o)[2], bf16x8 (&pf)[4], bool first, bool fixed) {
    if (!fixed) {
    float mx = fmaxf(s0[0], s1[0]);
#pragma unroll
    for (int i = 1; i < 16; ++i) mx = fmaxf(fmaxf(mx, s0[i]), s1[i]);
    mx = xhalf_max(mx);
    if (first || __any(mx > DEFER_THR)) {
        const float d = first ? mx : fmaxf(mx, 0.f);
        const float corr = __builtin_amdgcn_exp2f(-d);
        const f32x2 c2 = (f32x2){corr, corr}, d2 = (f32x2){d, d};
        l_run *= corr; m_run += d;
#pragma unroll
        for (int i = 0; i < 16; i += 2) {
            f32x2 a = (f32x2){o[0][i], o[0][i + 1]} * c2, b = (f32x2){o[1][i], o[1][i + 1]} * c2;
            o[0][i] = a.x; o[0][i + 1] = a.y; o[1][i] = b.x; o[1][i + 1] = b.y;
            f32x2 u = (f32x2){s0[i], s0[i + 1]} - d2, v = (f32x2){s1[i], s1[i + 1]} - d2;
            s0[i] = u.x; s0[i + 1] = u.y; s1[i] = v.x; s1[i + 1] = v.y;
        }
#pragma unroll
        for (int i = 0; i < 16; ++i) negm[i] = -m_run;
    }
    }
    float sum = 0.f;
#pragma unroll
    for (int i = 0; i < 16; ++i) {
        s0[i] = __builtin_amdgcn_exp2f(s0[i]); s1[i] = __builtin_amdgcn_exp2f(s1[i]);
        sum += s0[i]; sum += s1[i];
    }
    l_run += sum;
    pack_p(pf, s0, s1);
}

#define ATT_BAR() do { asm volatile("s_waitcnt lgkmcnt(0)" ::: "memory"); __builtin_amdgcn_s_barrier(); asm volatile("" ::: "memory"); } while (0)
template <int TYPE, int PF = 0>
DEVI void unit2(const Ctx& cin, const Params& p, int l, int b, int hh, int qt) {
    constexpr int DK = (TYPE == T_MLA) ? 96 : 64;
    Ctx c = cin; { int ln = cin.lane; asm volatile("" : "+v"(ln)); c.lane = ln; c.tid = cin.wid * 64 + ln; }
    const bf16_t* proj = (const bf16_t*)(p.ws + WS_PROJ); const bf16_t* qb = (const bf16_t*)(p.ws + WS_Q); const bf16_t* kvb = (const bf16_t*)(p.ws + WS_KV);
    bf16_t* O = (PF & 16) ? (bf16_t*)p.out : (bf16_t*)(p.ws + WS_H);
    const size_t rowb = (size_t)b * SEQ;
    const bf16_t *Qg, *Kg, *Vg; int pitchQ, pitchKV, ocol;
    if (TYPE == T_MLA) { Qg = qb + rowb * QLD + hh * 96; pitchQ = QLD; Kg = kvb + rowb * KVLD + hh * 160; Vg = Kg + 96; pitchKV = KVLD; ocol = 256 + hh * 64; }
    else if (TYPE == T_SB) { Qg = proj + rowb * PROJ_LD + PC_SBQ + hh * 64; pitchQ = PROJ_LD; Kg = proj + rowb * PROJ_LD + PC_SBK + hh * 64; Vg = proj + rowb * PROJ_LD + PC_SBV + hh * 64; pitchKV = PROJ_LD; ocol = hh * 64; }
    else { Qg = proj + rowb * PROJ_LD + PC_CKQ + hh * 64; pitchQ = PROJ_LD; Kg = proj + rowb * PROJ_LD + PC_CKK + hh * 64; Vg = proj + rowb * PROJ_LD + PC_CKV + hh * 64; pitchKV = PROJ_LD; ocol = 768 + hh * 64; }
    LAS unsigned char* ring = c.ring;
    const int w = c.wid, hb = w >> 2, r32 = c.lane & 31, h = c.lane >> 5, q0 = qt * 256, trow = q0 + 32 * w + r32;
    int jlo, jhi;
    if (TYPE == T_CK) { jlo = 4 * qt - 8 < 0 ? 0 : 4 * qt - 8; jhi = 4 * qt + 3; } else { jlo = 0; jhi = 4 * qt + 3; }
    const int cw = 4 * qt + (w >> 1);
    bf16x8 qf[DK / 16];
#pragma unroll
    for (int st = 0; st < DK / 16; ++st) qf[st] = *(const bf16x8*)(Qg + (size_t)trow * pitchQ + st * 16 + h * 8);
    if (TYPE == T_CK) { LAS float* bt = (LAS float*)(ring + LBIAS); const float* rb = p.in[I_RELB] + (l * 4 + hh) * 257; if (c.tid < 257) bt[c.tid] = rb[c.tid] * L2E; }
    if (TYPE == T_SB) { LAS unsigned* fl = (LAS unsigned*)(ring + LFLAG); if (c.tid < 32) fl[c.tid] = 1u; }
    f32x16 o[2];
#pragma unroll
    for (int i = 0; i < 16; ++i) { o[0][i] = 0.f; o[1][i] = 0.f; }
    float m_run = 0.f, l_run = 0.f, carry = 0.f;
    bool wave_done = false, first_tile = true, fixed = false;
    if (TYPE != T_SB) {
        const float b2 = __builtin_bit_cast(float, __builtin_amdgcn_readfirstlane(__builtin_bit_cast(int, ((const float*)(p.ws + WS_CTL))[WS_BND_WORD + l * 8 + (TYPE == T_MLA ? 0 : 1 + hh)])));
        fixed = b2 < 50.f; if (fixed) m_run = b2;
    }
    f32x16 negm;
#pragma unroll
    for (int i = 0; i < 16; ++i) negm[i] = -m_run;
    const int vlane = (4 * h + ((c.lane & 15) >> 2)) * 64 + (((c.lane >> 4) & 1) * 16 + 4 * (c.lane & 3)) * 2;
    const int nt = jhi - jlo + 1;
    TileRegs<DK> tr;
    auto tile_of = [&](int it) { return (TYPE == T_SB) ? (jhi - it) : (jlo + it); };
    {
        TileRegs<DK> tr1;
        loadK<DK>(tr, Kg, pitchKV, tile_of(0) * 64, c.tid); loadV<DK>(tr, Vg, pitchKV, tile_of(0) * 64, c.tid);
        if (nt > 1) loadK<DK>(tr1, Kg, pitchKV, tile_of(1) * 64, c.tid);
        if constexpr (TYPE == T_MLA) qprep_mla(qf, p, rowb + trow, h);
        if constexpr (TYPE == T_CK) qprep_ck(qf);
        storeK<DK>(tr, ring + LK0, c.tid); storeV<DK>(tr, ring + LV0, c.tid);
        if (nt > 1) storeK<DK>(tr1, ring + LK1, c.tid);
    }
    __syncthreads();
    if (hb == 1 && !(PF & 32)) ATT_BAR();
    f32x16 s0, s1; bf16x8 pf[4];
    bool act_prev = false;
    int it = 0;
    for (; it < nt; ++it) {
        const int j = tile_of(it);
        bool act_cur;
        if (TYPE == T_MLA) act_cur = (j <= cw);
        else if (TYPE == T_SB) act_cur = (j <= cw) && !wave_done;
        else act_cur = (j <= cw) && (j >= cw - 8);
        if (ATT_FUSED_SEG1 && act_cur && act_prev && !(PF & 12)) seg1_fused<DK>(s0, s1, o, ring + ((it & 1) ? LK1 : LK0), ring + (((it - 1) & 1) ? LV1 : LV0) + vlane, qf, pf, r32, h);
        else {
        if (act_cur) { if (!(PF & 8)) qk_tile_c<DK>(s0, s1, negm, ring + ((it & 1) ? LK1 : LK0), qf, r32, h); else {
#pragma unroll
            for (int i = 0; i < 16; ++i) { s0[i] = (float)i; s1[i] = (float)(i + it); } } }
        if (act_prev && !(PF & 4)) pv_tile(o, ring + (((it - 1) & 1) ? LV1 : LV0) + vlane, pf);
        }
        if (it >= 1 && !(PF & 2)) { if (it + 1 < nt) storeK<DK>(tr, ring + (((it + 1) & 1) ? LK1 : LK0), c.tid); storeV<DK>(tr, ring + ((it & 1) ? LV1 : LV0), c.tid); }
        if (!(PF & 32)) ATT_BAR();
        if (!(PF & 2)) { if (it + 2 < nt) loadK<DK>(tr, Kg, pitchKV, tile_of(it + 2) * 64, c.tid);
        if (it + 1 < nt) loadV<DK>(tr, Vg, pitchKV, tile_of(it + 1) * 64, c.tid); }
        if (act_cur) {
            if (PF & 1) { l_run += s0[3]; pack_p(pf, s0, s1); }
            else if (TYPE == T_MLA) { softmax_tile_defer(s0, s1, m_run, negm, l_run, o, pf, first_tile, fixed); first_tile = false; }
            else if (TYPE == T_CK) {
                const int dlt = cw - j;
                const LAS float* bt = (const LAS float*)(ring + LBIAS);
                if (dlt >= 3) { const float bc = bt[256];
#pragma unroll
                    for (int i = 0; i < 16; ++i) { s0[i] += bc; s1[i] += bc; } }
                else { const int base = 64 * dlt + (32 * (w & 1) + r32) - 4 * h + 128;
#pragma unroll
                    for (int i = 0; i < 16; ++i) { int i0 = base - (8 * (i >> 2) + (i & 3)), i1 = i0 - 32; i0 = i0 > 256 ? 256 : i0; i1 = i1 > 256 ? 256 : i1; s0[i] += bt[i0]; s1[i] += bt[i1]; } }
                softmax_tile_defer(s0, s1, m_run, negm, l_run, o, pf, first_tile, fixed); first_tile = false;
            } else {
                if (j == cw) sb_tile<true>(s0, s1, carry, pf, h, trow - j * 64); else sb_tile<false>(s0, s1, carry, pf, h, 0);
                if (__all(carry <= -144.3f)) wave_done = true;
            }
        }
        if (TYPE == T_SB) { LAS unsigned* fl = (LAS unsigned*)(ring + LFLAG); if (c.lane == 0) fl[(it & 3) * 8 + w] = wave_done ? 0u : 1u; }
        act_prev = act_cur;
        if (!(PF & 32)) ATT_BAR();
        if (TYPE == T_SB && it >= 1) {
            const LAS unsigned* fl = (const LAS unsigned*)(ring + LFLAG); unsigned any = 0u;
#pragma unroll
            for (int k = 0; k < 8; ++k) any |= fl[((it - 1) & 3) * 8 + k];
            if (any == 0u) { ++it; break; }
        }
    }
    if (act_prev && !(PF & 4)) pv_tile(o, ring + (((it - 1) & 1) ? LV1 : LV0) + vlane, pf);
    if (hb == 0 && !(PF & 32)) ATT_BAR();
    float inv = 1.f;
    if (TYPE != T_SB) { const float lt = xhalf_sum(l_run); inv = 1.f / lt; }
    bf16_t* orow = O + (rowb + trow) * DM + ocol;
    float sq = 0.f;
#pragma unroll
    for (int db = 0; db < 2; ++db)
#pragma unroll
        for (int gp = 0; gp < 2; ++gp) {
            unsigned w[2][2];
#pragma unroll
            for (int e = 0; e < 2; ++e) {
                const int g = 2 * gp + e;
                const float v0 = o[db][4 * g] * inv, v1 = o[db][4 * g + 1] * inv, v2 = o[db][4 * g + 2] * inv, v3 = o[db][4 * g + 3] * inv;
                sq += (v0 * v0 + v1 * v1) + (v2 * v2 + v3 * v3);
                w[e][0] = pg8::cvt_pk_bf16(v0, v1); w[e][1] = pg8::cvt_pk_bf16(v2, v3);
            }
            xswap32(w[0][0], w[1][0]); xswap32(w[0][1], w[1][1]);
            pg8::u32x4 v; v.x = w[0][0]; v.y = w[0][1]; v.z = w[1][0]; v.w = w[1][1];
            *(pg8::u32x4*)(orow + 32 * db + 8 * (2 * gp + h)) = v;
        }
    sq = xhalf_sum(sq);
    if (h == 0 && ATT_WRITE_SS) ((float*)(p.ws + WS_SSH))[(rowb + trow) * 16 + (ocol >> 6)] = sq;
    __syncthreads();
}


DEVI void conv_unit(const Ctx& c, const Params& p, int cv) {
    unsigned char* ws = p.ws;
    if (cv < 176) { const int e = cv / 22, rb = cv % 22;
        conv_rowblock<MAP_GU>(c, p.in[I_MG] + (size_t)e * 1024 * DFF, p.in[I_MU] + (size_t)e * 1024 * DFF, DFF, 1024, nullptr, (bf16_t*)(ws + WS_MGU) + (size_t)e * 5632 * 1024, 1024, rb); }
    else { const int d = cv - 176, e = d >> 2, rb = d & 3;
        conv_rowblock<MAP_ID>(c, p.in[I_MD] + (size_t)e * DFF * 1024, nullptr, 1024, DFF, nullptr, (bf16_t*)(ws + WS_MD) + (size_t)e * 1024 * DFF, DFF, rb); }
    __syncthreads();
}
DEVI void run_unit(const Ctx& c, const Params& p, int l, int xq, int u, int ncv) {
    if (u >= 96 && u < 96 + ncv) { conv_unit(c, p, l == 0 ? xq * 22 + (u - 96) : 176 + xq * 4 + (u - 96)); return; }
    if (u >= 96 + ncv) u -= ncv;
    if (u < 96) { const int g = u / 24, idx = u % 24, qt = 15 - (idx >> 1), bh = 8 * (2 * g + (idx & 1)) + xq; ATT_UNIT<T_MLA>(c, p, l, bh >> 3, bh & 7, qt); }
    else if (u < 160) { const int v = u - 96, qt = 15 - (v >> 2), bh = 8 * (v & 3) + xq; ATT_UNIT<T_CK>(c, p, l, bh >> 2, bh & 3, qt); }
    else if (u < 224) { const int v = u - 160, qt = 15 - (v >> 2), bh = 8 * (v & 3) + xq; ATT_UNIT<T_SB>(c, p, l, bh >> 2, bh & 3, qt); }
    else { const int v = u - 224, qt = 3 - (v >> 3), bh = 8 * (v & 7) + xq; ATT_UNIT<T_MLA>(c, p, l, bh >> 3, bh & 7, qt); }
}
DEVI void phase(const Ctx& c, const Params& p, int lq) {
    const int l = lq & 1;
    unsigned* qbase = (unsigned*)(p.ws + WS_CTL) + 8192 + 512 * lq;
    LAS int* s_unit = (LAS int*)(c.ring + LUNIT);
    const int x0 = (int)(xb_xcc_id() & 7u);
    const int ncv = !MOE_CONV_IN_ATT ? 0 : lq == 0 ? 22 : lq == 1 ? 4 : 0, nun = 256 + ncv;
    for (int k = 0; k < 8; ++k) {
        const int xq = (x0 + k) & 7;
        if (c.tid == 0) s_unit[0] = (int)__hip_atomic_fetch_add(qbase + 64 * xq, 1u, __ATOMIC_RELAXED, __HIP_MEMORY_SCOPE_AGENT);
        __syncthreads();
        for (int par = 0;; par ^= 1) {
            const int u = s_unit[par];
            if (u >= nun) break;
            int nxt = 0;
            if (c.tid == 0) {
                unsigned long long qa = (unsigned long long)(qbase + 64 * xq);
                asm volatile("" : "+v"(qa));
                nxt = (int)__hip_atomic_fetch_add((__attribute__((address_space(1))) unsigned*)qa, 1u, __ATOMIC_RELAXED, __HIP_MEMORY_SCOPE_AGENT);
            }
            run_unit(c, p, l, xq, u, ncv);
            if (c.tid == 0) s_unit[par ^ 1] = nxt;
            __syncthreads();
        }
        __syncthreads();
    }
}
#ifndef PROBE_PF
#define PROBE_PF 0
#endif
#ifndef PROBE_TYPES
#define PROBE_TYPES 0
#endif
DEVI void phase_probe(const Ctx& c, const Params& p, int l) {
    unsigned* qbase = (unsigned*)(p.ws + WS_CTL) + 8192 + 512 * 3;
    LAS int* s_unit = (LAS int*)(c.ring + LUNIT);
    const int x0 = (int)(xb_xcc_id() & 7u);
    for (int k = 0; k < 8; ++k) {
        const int xq = (x0 + k) & 7;
        for (;;) {
            if (c.tid == 0) *s_unit = (int)__hip_atomic_fetch_add(qbase + 64 * xq, 1u, __ATOMIC_RELAXED, __HIP_MEMORY_SCOPE_AGENT);
            __syncthreads();
            const int u = *s_unit;
            __syncthreads();
            if (u >= 256) break;
            if (u < 128) { if (PROBE_TYPES & 1) { const int g = u >> 5, idx = u & 31, qt = 15 - (idx >> 1), bh = 8 * (2 * g + (idx & 1)) + xq; unit2<T_MLA, (PROBE_PF | 16)>(c, p, l, bh >> 3, bh & 7, qt); } }
            else if (u < 192) { if (PROBE_TYPES & 2) { const int v = u - 128, qt = 15 - (v >> 2), bh = 8 * (v & 3) + xq; unit2<T_SB, (PROBE_PF | 16)>(c, p, l, bh >> 2, bh & 3, qt); } }
            else { if (PROBE_TYPES & 4) { const int v = u - 192, qt = v >> 2, bh = 8 * (v & 3) + xq; unit2<T_CK, (PROBE_PF | 16)>(c, p, l, bh >> 2, bh & 3, qt); } }
        }
    }
}
}

DEVI void phase_prep(const Ctx& c, const Params& p, int l) {
    bf16_t* proj = (bf16_t*)(p.ws + WS_PROJ);
    const float* cs = (const float*)(p.ws + WS_COS); const float* sn = (const float*)(p.ws + WS_SIN);
    const float* gq = p.in[I_CKQN] + l * 64; const float* gk = p.in[I_CKKN] + l * 64;
    for (int row = c.bid * 8 + c.wid; row < MTOK; row += c.nblk * 8) {
        bf16_t* pr = proj + (size_t)row * PROJ_LD;
        {
            uint2 v = *(const uint2*)(pr + PC_CQ + 4 * c.lane);
            float a0 = lo16(v.x), a1 = hi16(v.x), a2 = lo16(v.y), a3 = hi16(v.y);
            const float ss = wave_sum(a0 * a0 + a1 * a1 + a2 * a2 + a3 * a3), r = rsqrtf(ss * (1.f / 256.f) + EPS);
            v.x = pk2(a0 * r, a1 * r); v.y = pk2(a2 * r, a3 * r);
            *(uint2*)(pr + PC_CQ + 4 * c.lane) = v;
        }
        {
            unsigned v = *(const unsigned*)(pr + PC_LAT + 2 * c.lane);
            float a0 = lo16(v), a1 = hi16(v);
            const float ss = wave_sum(a0 * a0 + a1 * a1), r = rsqrtf(ss * (1.f / 128.f) + EPS);
            *(unsigned*)(pr + PC_LAT + 2 * c.lane) = pk2(a0 * r, a1 * r);
        }
        if (c.lane < 16) {
            const float x1 = bf2f(pr[PC_KPE + c.lane]), x2 = bf2f(pr[PC_KPE + 16 + c.lane]);
            const float co = cs[row * 16 + c.lane], si = sn[row * 16 + c.lane];
            pr[PC_KPE + c.lane] = f2bf(x1 * co - x2 * si); pr[PC_KPE + 16 + c.lane] = f2bf(x2 * co + x1 * si);
        }
        {
            uint2 v = *(const uint2*)(pr + PC_CKQ + 4 * c.lane);
            float a0 = lo16(v.x), a1 = hi16(v.x), a2 = lo16(v.y), a3 = hi16(v.y);
            const float ss = sum16(a0 * a0 + a1 * a1 + a2 * a2 + a3 * a3), r = rsqrtf(ss * (1.f / 64.f) + EPS) * (0.125f * 1.4426950408889634f);
            const int d = (4 * c.lane) & 63;
            v.x = pk2(a0 * r * gq[d], a1 * r * gq[d + 1]); v.y = pk2(a2 * r * gq[d + 2], a3 * r * gq[d + 3]);
            *(uint2*)(pr + PC_CKQ + 4 * c.lane) = v;
        }
        {
            uint2 v = *(const uint2*)(pr + PC_CKK + 4 * c.lane);
            float a0 = lo16(v.x), a1 = hi16(v.x), a2 = lo16(v.y), a3 = hi16(v.y);
            const float ss = sum16(a0 * a0 + a1 * a1 + a2 * a2 + a3 * a3), r = rsqrtf(ss * (1.f / 64.f) + EPS);
            const int d = (4 * c.lane) & 63;
            v.x = pk2(a0 * r * gk[d], a1 * r * gk[d + 1]); v.y = pk2(a2 * r * gk[d + 2], a3 * r * gk[d + 3]);
            *(uint2*)(pr + PC_CKK + 4 * c.lane) = v;
        }
    }
}

DEVI void phase_fin(const Ctx& c, const Params& p, int l) {
    bf16_t* qb = (bf16_t*)(p.ws + WS_Q); bf16_t* kvb = (bf16_t*)(p.ws + WS_KV); const bf16_t* proj = (const bf16_t*)(p.ws + WS_PROJ);
    const float* cs = (const float*)(p.ws + WS_COS); const float* sn = (const float*)(p.ws + WS_SIN);
    const float* gq = p.in[I_QQK] + l * 96; const float* gk = p.in[I_KQK] + l * 96;
    const float qscale = 0.10206207261596577f * 1.4426950408889634f;
#pragma unroll 1
    for (int it = c.bid * 512 + c.tid; it < MTOK * 8; it += c.nblk * 512) {
        const int row = it >> 3, hh = it & 7;
        {
            bf16_t* qp = qb + (size_t)row * QLD + hh * 96;
            float ss = 0.f;
#pragma unroll 1
            for (int i = 0; i < 12; ++i) { float t8[8]; load_bf16_row<8>(qp + 8 * i, t8);
#pragma unroll
                for (int j = 0; j < 8; ++j) ss += t8[j] * t8[j]; }
            const float r = rsqrtf(ss * (1.f / 96.f) + EPS) * qscale;
#pragma unroll 1
            for (int i = 0; i < 8; ++i) { float t8[8]; load_bf16_row<8>(qp + 8 * i, t8);
#pragma unroll
                for (int j = 0; j < 8; ++j) t8[j] *= r * gq[8 * i + j];
                store_bf16_row<8>(qp + 8 * i, t8); }
#pragma unroll 1
            for (int i = 0; i < 2; ++i) { float x1[8], x2[8]; load_bf16_row<8>(qp + 64 + 8 * i, x1); load_bf16_row<8>(qp + 80 + 8 * i, x2);
#pragma unroll
                for (int j = 0; j < 8; ++j) { const float co = cs[row * 16 + 8 * i + j], si = sn[row * 16 + 8 * i + j], a = x1[j], b2 = x2[j];
                    x1[j] = (a * co - b2 * si) * r * gq[64 + 8 * i + j]; x2[j] = (b2 * co + a * si) * r * gq[80 + 8 * i + j]; }
                store_bf16_row<8>(qp + 64 + 8 * i, x1); store_bf16_row<8>(qp + 80 + 8 * i, x2); }
        }
    }
#pragma unroll 1
    for (int it = c.bid * 512 + c.tid; it < MTOK * 8; it += c.nblk * 512) {
        const int row = it >> 3, hh = it & 7;
        {
            bf16_t* kp = kvb + (size_t)row * KVLD + hh * 160;
            float kn[64]; load_bf16_row<64>(kp, kn);
            float kr[32]; load_bf16_row<32>(proj + (size_t)row * PROJ_LD + PC_KPE, kr);
            float ss = 0.f;
#pragma unroll
            for (int i = 0; i < 64; ++i) ss += kn[i] * kn[i];
#pragma unroll
            for (int i = 0; i < 32; ++i) ss += kr[i] * kr[i];
            const float r = rsqrtf(ss * (1.f / 96.f) + EPS);
#pragma unroll
            for (int i = 0; i < 64; ++i) kn[i] *= r * gk[i];
#pragma unroll
            for (int i = 0; i < 32; ++i) kr[i] *= r * gk[64 + i];
            store_bf16_row<64>(kp, kn); store_bf16_row<32>(kp + 64, kr);
        }
    }
}

DEVI void phase_att(const Ctx& c, const Params& p, int l) {
    const bf16_t* proj = (const bf16_t*)(p.ws + WS_PROJ); const bf16_t* qb = (const bf16_t*)(p.ws + WS_Q); const bf16_t* kvb = (const bf16_t*)(p.ws + WS_KV);
    bf16_t* o = (bf16_t*)(p.ws + WS_H);
    const float* relb = p.in[I_RELB] + l * 4 * 257;
    for (int wi = c.bid * 8 + c.wid; wi < 8192; wi += c.nblk * 8) {
        if (wi < 2048) {
            const int tt = 63 - (wi & 63), bh = wi >> 6, b = bh >> 2, hh = bh & 3, t0 = tt * 64, t = t0 + c.lane;
            const size_t rowb = (size_t)b * SEQ;
            float q[64], acc[64];
            load_bf16_row<64>(proj + (rowb + t) * PROJ_LD + PC_SBQ + hh * 64, q);
#pragma unroll
            for (int d = 0; d < 64; ++d) acc[d] = 0.f;
            float tail = 0.f;
            for (int s = t0 + 62; s >= 0; --s) {
                float z = dot_bf16<64>(proj + (rowb + s) * PROJ_LD + PC_SBK + hh * 64, q) * 0.125f;
                if (s < t) {
                    const float sp = fmaxf(z, 0.f) + log1pf(__expf(-fabsf(z)));
                    const float w = __expf(z - sp + tail);
                    tail -= sp;
                    axpy_bf16<64>(acc, 1.f, w, proj + (rowb + s) * PROJ_LD + PC_SBV + hh * 64);
                }
            }
            store_bf16_row<64>(o + (rowb + t) * DM + hh * 64, acc);
        } else if (wi < 6144) {
            const int w2 = wi - 2048, tt = 63 - (w2 & 63), bh = w2 >> 6, b = bh >> 3, hh = bh & 7, t0 = tt * 64, t = t0 + c.lane;
            const size_t rowb = (size_t)b * SEQ;
            unsigned q[48]; float acc[64];
#pragma unroll
            for (int i = 0; i < 12; ++i) { const uint4 v = *(const uint4*)(qb + (rowb + t) * QLD + hh * 96 + 8 * i); q[4 * i] = v.x; q[4 * i + 1] = v.y; q[4 * i + 2] = v.z; q[4 * i + 3] = v.w; }
#pragma unroll
            for (int d = 0; d < 64; ++d) acc[d] = 0.f;
            float mx = -3.0e38f, den = 0.f;
            for (int s = 0; s < t0 + 64; ++s) {
                const bf16_t* kp = kvb + (rowb + s) * KVLD + hh * 160;
                const float z = dot_bf16_pk<96>(kp, q);
                const float mn = fmaxf(mx, z), corr = exp2f(mx - mn), pw = exp2f(z - mn);
                mx = mn; den = den * corr + pw;
                axpy_bf16<64>(acc, corr, pw, kp + 96);
            }
            const float inv = 1.f / den;
#pragma unroll
            for (int d = 0; d < 64; ++d) acc[d] *= inv;
            store_bf16_row<64>(o + (rowb + t) * DM + 256 + hh * 64, acc);
        } else {
            const int w2 = wi - 6144, n = w2 & 63, bh = w2 >> 6, b = bh >> 2, hh = bh & 3, t0 = n * 64, t = t0 + c.lane;
            const size_t rowb = (size_t)b * SEQ;
            float q[64], acc[64];
            load_bf16_row<64>(proj + (rowb + t) * PROJ_LD + PC_CKQ + hh * 64, q);
#pragma unroll
            for (int d = 0; d < 64; ++d) acc[d] = 0.f;
            float mx = -3.0e38f, den = 0.f;
            const int s_lo = (n - 8) * 64 < 0 ? 0 : (n - 8) * 64;
            for (int s = s_lo; s < t0 + 64; ++s) {
                float z = dot_bf16<64>(proj + (rowb + s) * PROJ_LD + PC_CKK + hh * 64, q);
                int rel = t - s; rel = rel < -128 ? -128 : rel > 128 ? 128 : rel;
                z += relb[hh * 257 + rel + 128] * 1.4426950408889634f;
                const float mn = fmaxf(mx, z), corr = exp2f(mx - mn), pw = exp2f(z - mn);
                mx = mn; den = den * corr + pw;
                axpy_bf16<64>(acc, corr, pw, proj + (rowb + s) * PROJ_LD + PC_CKV + hh * 64);
            }
            const float inv = 1.f / den;
#pragma unroll
            for (int d = 0; d < 64; ++d) acc[d] *= inv;
            store_bf16_row<64>(o + (rowb + t) * DM + 768 + hh * 64, acc);
        }
    }
}

DEVI void phase_mergenorm(const Ctx& c, const Params& p) {
    bf16_t* o = (bf16_t*)(p.ws + WS_H);
    for (int row = c.bid * 8 + c.wid; row < MTOK; row += c.nblk * 8) {
        bf16_t* orow = o + (size_t)row * DM + 16 * c.lane;
        float v[16]; load_bf16_row<16>(orow, v);
        float ss = 0.f;
#pragma unroll
        for (int i = 0; i < 16; ++i) ss += v[i] * v[i];
        ss = sum16(ss);
        const float s0 = __shfl(ss, 0, 64), s1 = __shfl(ss, 16, 64), s2 = __shfl(ss, 32, 64), s3 = __shfl(ss, 48, 64);
        const int g = c.lane >> 4;
        const float r = g == 0 ? rsqrtf(s0 * (1.f / 256.f) + EPS) : g == 3 ? rsqrtf(s3 * (1.f / 256.f) + EPS) : rsqrtf((s1 + s2) * (1.f / 512.f) + EPS);
#pragma unroll
        for (int i = 0; i < 16; ++i) v[i] *= r;
        store_bf16_row<16>(orow, v);
    }
}


DEVI void phase_fin2(const Ctx& c, const Params& p, int l) {
    bf16_t* __restrict__ kvb = (bf16_t*)(p.ws + WS_KV); bf16_t* __restrict__ proj = (bf16_t*)(p.ws + WS_PROJ);
    const float* __restrict__ cs = (const float*)(p.ws + WS_COS); const float* __restrict__ sn = (const float*)(p.ws + WS_SIN);
    const float* gq = p.in[I_QQK] + l * 96; const float* gk = p.in[I_KQK] + l * 96;
    const float* gcq = p.in[I_CKQN] + l * 64; const float* gck = p.in[I_CKKN] + l * 64;
    LAS float* wsm = (LAS float*)(c.ring + 131072) + c.wid * 32;
    const int lane = c.lane, hq = lane >> 3, p8 = lane & 7, pos0 = 12 * p8;
    float* __restrict__ alpha_arr = (float*)(p.ws + WS_ALPHA);
    float gkp[12];
#pragma unroll
    for (int j = 0; j < 12; ++j) { const int pos = pos0 + j, og = pos < 64 ? pos : 64 + ((pos - 64) >> 1) + 16 * ((pos - 64) & 1); gkp[j] = gk[og] * gq[og]; }
    const int dck = (4 * lane) & 63;
    float gck4[4];
#pragma unroll
    for (int j = 0; j < 4; ++j) gck4[j] = gck[dck + j] * gcq[dck + j];
#pragma unroll 1
    for (int row = c.bid * 8 + c.wid; row < MTOK; row += c.nblk * 8) {
        bf16_t* pr = proj + (size_t)row * PROJ_LD;
        bf16_t* kp = kvb + (size_t)row * KVLD + 160 * hq + pos0;
        bf16_t* vp = kvb + (size_t)row * KVLD + 160 * hq + 96 + 8 * p8;
        const uint2 cqv = *(const uint2*)(pr + PC_CQ + 4 * lane);
        const unsigned latv = *(const unsigned*)(pr + PC_LAT + 2 * lane);
        float x1 = 0.f, x2 = 0.f, co = 0.f, si = 0.f;
        if (lane < 16) { x1 = bf2f(pr[PC_KPE + lane]); x2 = bf2f(pr[PC_KPE + 16 + lane]); co = cs[row * 16 + lane]; si = sn[row * 16 + lane]; }
        uint2 kv[3];
#pragma unroll
        for (int t = 0; t < 3; ++t) { kv[t] = (pos0 + 4 * t < 64) ? *(const uint2*)(kp + 4 * t) : make_uint2(0u, 0u); }
        const uint4 vv = *(const uint4*)vp;
        const uint2 ckk = *(const uint2*)(pr + PC_CKK + 4 * lane);
        float a0 = lo16(cqv.x), a1 = hi16(cqv.x), a2 = lo16(cqv.y), a3 = hi16(cqv.y);
        const float alpha = rsqrtf(wave_sum(a0 * a0 + a1 * a1 + a2 * a2 + a3 * a3) * (1.f / 256.f) + EPS);
        a0 = lo16(latv); a1 = hi16(latv);
        const float beta = rsqrtf(wave_sum(a0 * a0 + a1 * a1) * (1.f / 128.f) + EPS);
        const float ss_pe = wave_sum(x1 * x1 + x2 * x2);
        if (lane < 16) { wsm[2 * lane] = x1 * co - x2 * si; wsm[2 * lane + 1] = x2 * co + x1 * si; }
        if (lane == 0) alpha_arr[row] = alpha;
        float k[12];
#pragma unroll
        for (int t = 0; t < 3; ++t) { k[4 * t] = lo16(kv[t].x); k[4 * t + 1] = hi16(kv[t].x); k[4 * t + 2] = lo16(kv[t].y); k[4 * t + 3] = hi16(kv[t].y); }
        float ssk = 0.f;
#pragma unroll
        for (int j = 0; j < 12; ++j) ssk += k[j] * k[j];
        ssk += __shfl_xor(ssk, 1, 64); ssk += __shfl_xor(ssk, 2, 64); ssk += __shfl_xor(ssk, 4, 64);
        const float rk = rsqrtf((beta * beta * ssk + ss_pe) * (1.f / 96.f) + EPS), rkb = rk * beta;
#pragma unroll
        for (int j = 0; j < 12; ++j) { const int pos = pos0 + j; k[j] = (pos < 64) ? k[j] * rkb * gkp[j] : wsm[pos >= 64 ? pos - 64 : 0] * rk * gkp[j]; }
#pragma unroll
        for (int t = 0; t < 3; ++t) { uint2 o; o.x = pk2(k[4 * t], k[4 * t + 1]); o.y = pk2(k[4 * t + 2], k[4 * t + 3]); *(uint2*)(kp + 4 * t) = o; }
        { uint4 o; o.x = pk2(lo16(vv.x) * beta, hi16(vv.x) * beta); o.y = pk2(lo16(vv.y) * beta, hi16(vv.y) * beta); o.z = pk2(lo16(vv.z) * beta, hi16(vv.z) * beta); o.w = pk2(lo16(vv.w) * beta, hi16(vv.w) * beta); *(uint4*)vp = o; }
        { float b0 = lo16(ckk.x), b1 = hi16(ckk.x), b2 = lo16(ckk.y), b3 = hi16(ckk.y);
          const float r = rsqrtf(sum16(b0 * b0 + b1 * b1 + b2 * b2 + b3 * b3) * (1.f / 64.f) + EPS);
          uint2 o; o.x = pk2(b0 * r * gck4[0], b1 * r * gck4[1]); o.y = pk2(b2 * r * gck4[2], b3 * r * gck4[3]); *(uint2*)(pr + PC_CKK + 4 * lane) = o; }
    }
}

DEVI void phase_mergenorm2(const Ctx& c, const Params& p) {
    bf16_t* o = (bf16_t*)(p.ws + WS_H);
#pragma unroll 1
    for (int row = (c.bid * 8 + c.wid) * 2; row < MTOK; row += c.nblk * 16) {
        uint4 raw[2][2];
#pragma unroll
        for (int q = 0; q < 2; ++q) { const uint4* rp = (const uint4*)(o + (size_t)(row + q) * DM + 16 * c.lane); raw[q][0] = rp[0]; raw[q][1] = rp[1]; }
#pragma unroll
        for (int q = 0; q < 2; ++q) {
            float v[16];
#pragma unroll
            for (int t = 0; t < 2; ++t) { const uint4 u = raw[q][t]; v[8 * t] = lo16(u.x); v[8 * t + 1] = hi16(u.x); v[8 * t + 2] = lo16(u.y); v[8 * t + 3] = hi16(u.y); v[8 * t + 4] = lo16(u.z); v[8 * t + 5] = hi16(u.z); v[8 * t + 6] = lo16(u.w); v[8 * t + 7] = hi16(u.w); }
            float ss = 0.f;
#pragma unroll
            for (int i = 0; i < 16; ++i) ss += v[i] * v[i];
            ss = sum16(ss);
            const float s0 = __shfl(ss, 0, 64), s1 = __shfl(ss, 16, 64), s2 = __shfl(ss, 32, 64), s3 = __shfl(ss, 48, 64);
            const int g = c.lane >> 4;
            const float r = g == 0 ? rsqrtf(s0 * (1.f / 256.f) + EPS) : g == 3 ? rsqrtf(s3 * (1.f / 256.f) + EPS) : rsqrtf((s1 + s2) * (1.f / 512.f) + EPS);
#pragma unroll
            for (int i = 0; i < 16; ++i) v[i] *= r;
            store_bf16_row<16>(o + (size_t)(row + q) * DM + 16 * c.lane, v);
        }
    }
}

DEVI void phase_route(const Ctx& c, const Params& p) {
    const int* cnt = (const int*)(p.ws + WS_CNT); const int* te = (const int*)(p.ws + WS_TOKE); const float* tw = (const float*)(p.ws + WS_TOKW);
    int* perm = (int*)(p.ws + WS_PERM); float* permw = (float*)(p.ws + WS_PERMW); int* texp = (int*)(p.ws + WS_TEXP);
    int* s_tot = (int*)c.sm; int* s_base = s_tot + 16; int* s_seg = s_tot + 32; int* s_e = s_tot + 64;
    for (int ch = c.bid; ch < MTOK / 128; ch += c.nblk) {
        __syncthreads();
        if (c.tid < 16) { int tot = 0, base = 0; for (int i = 0; i < MTOK / 128; ++i) { const int v = cnt[i * 16 + c.tid]; tot += v; base += (i < ch) ? v : 0; } s_tot[c.tid] = tot; s_base[c.tid] = base; }
        if (c.tid >= 64 && c.tid < 64 + 256) { const int i = c.tid - 64; s_e[i] = te[(ch * 128 + (i & 127)) * 2 + (i >> 7)]; }
        __syncthreads();
        if (c.tid < 2) { int a = 0; for (int e = 0; e < 8; ++e) { s_seg[c.tid * 8 + e] = a; a += (s_tot[c.tid * 8 + e] + 255) & ~255; } s_seg[16 + c.tid] = a; }
        __syncthreads();
        if (c.tid < 256) {
            const int s = c.tid >> 7, i = c.tid & 127, e = s_e[s * 128 + i];
            int rank = 0; for (int j = 0; j < i; ++j) rank += (s_e[s * 128 + j] == e);
            const int pos = s_seg[s * 8 + e] + s_base[s * 8 + e] + rank, tok = ch * 128 + i;
            perm[s * MOE_ROWS + pos] = tok; permw[s * MOE_ROWS + pos] = tw[tok * 2 + s];
        }
        if (ch == 0) {
            for (int s = 0; s < 2; ++s) {
                for (int e = 0; e < 8; ++e) {
                    const int beg = s_seg[s * 8 + e] + s_tot[s * 8 + e], end = s_seg[s * 8 + e] + ((s_tot[s * 8 + e] + 255) & ~255);
                    for (int q = beg + c.tid; q < end; q += 512) { perm[s * MOE_ROWS + q] = -1; permw[s * MOE_ROWS + q] = 0.f; }
                    const int t0 = s_seg[s * 8 + e] >> 8, t1 = end >> 8;
                    for (int t = t0 + c.tid; t < t1; t += 512) texp[s * MOE_TILES + t] = e;
                }
                if (c.tid == 0) texp[2 * MOE_TILES + s] = s_seg[16 + s] >> 8;
            }
        }
    }
}


DEVI void phase_moe_tail(const Ctx& c, const Params& p, const float* gate) {
    const int* texp = (const int*)(p.ws + WS_TEXP);
    const int ntl1 = texp[2 * MOE_TILES + 1];
    int q1 = ntl1 - (256 * 2) / 4; q1 = q1 < 0 ? 0 : q1 > 8 ? 8 : q1; if (c.nblk != 256) q1 = 0;
    const int* perm = (const int*)(p.ws + WS_PERM) + MOE_ROWS; const float* permw = (const float*)(p.ws + WS_PERMW) + MOE_ROWS;
    const bf16_t* xs2 = (const bf16_t*)(p.ws + WS_XS2); const float* part = (const float*)(p.ws + WS_PART);
    for (int row = c.bid * 8 + c.wid; row < q1 * 256; row += c.nblk * 8) {
        const int tok = perm[row]; if (tok < 0) continue;
        const float w = permw[row]; const float* gp = gate + (tok / SEQ) * 6144;
#pragma unroll
        for (int i = 0; i < 4; ++i) {
            const int col = 4 * (c.lane + 64 * i);
            const uint2 xv = *(const uint2*)(xs2 + (size_t)tok * DM + col);
            const size_t po = (size_t)row * DM + col; const size_t ps = (size_t)8 * 256 * DM;
            const f32x4 a = (*(const f32x4*)(part + po) + *(const f32x4*)(part + ps + po)) + (*(const f32x4*)(part + 2 * ps + po) + *(const f32x4*)(part + 3 * ps + po));
            const f32x4 g = *(const f32x4*)(gp + col);
            f32x4 o; o[0] = lo16(xv.x) + g[0] * w * a[0]; o[1] = hi16(xv.x) + g[1] * w * a[1]; o[2] = lo16(xv.y) + g[2] * w * a[2]; o[3] = hi16(xv.y) + g[3] * w * a[3];
            *(f32x4*)(p.out + (size_t)tok * DM + col) = o;
        }
    }
}

constexpr int NPHASE = 23;
constexpr int LDS_SM = 131072, LDS_XB = LDS_SM + 16640, LDS_BYTES = LDS_XB + 256;
template <int PH> DEVI void run_phase(const Ctx& c0, const Params& p, int repi = 0) {
    unsigned z_l = 0u; asm volatile("" : "+v"(z_l));
    int wid_l = c0.wid; asm volatile("" : "+s"(wid_l));
    const int lane_l = (int)__builtin_amdgcn_mbcnt_hi(~0u, __builtin_amdgcn_mbcnt_lo(~0u, z_l));
    Ctx c; c.tid = wid_l * 64 + lane_l; c.lane = lane_l; c.wid = wid_l; c.bid = c0.bid; c.nblk = c0.nblk; c.sm = c0.sm; c.ring = c0.ring;
    constexpr int l = PH >= 10 ? 1 : 0;
    constexpr int r = PH == 0 ? -1 : (l == 0 ? PH - 1 : PH - 10);
    unsigned char* ws = p.ws;
    const float* modl = (const float*)(ws + WS_MOD) + l * 8 * 6144;
    bf16_t* H = (bf16_t*)(ws + WS_H); bf16_t* PROJ = (bf16_t*)(ws + WS_PROJ); bf16_t* Q = (bf16_t*)(ws + WS_Q); bf16_t* KV = (bf16_t*)(ws + WS_KV); bf16_t* HID = (bf16_t*)(ws + WS_HID);
    void* XS = (void*)p.out; void* XS2 = (void*)(ws + WS_XS2);
    if constexpr (PH == 0) phase_prologue(c, p, repi);
    else if constexpr (r == 0) { if constexpr (l == 0) phase_norm<false, false>(c, p, p.in[I_X], p.in[I_NMIX] + l * DM, modl, modl + 1024); else phase_norm<false, true>(c, p, XS, p.in[I_NMIX] + l * DM, modl, modl + 1024); }
    else if constexpr (r == 1) {
        pg8::ProbPlain P{H, (const bf16_t*)(ws + WS_WIN) + (size_t)l * 2048 * 1024, 1024, 1024, 1024, {}}; P.S.init(MTOK / 256, 8, c.nblk, c.bid);
        pg8::gemm_phase(c.ring, P, pg8::EpiStoreT{PROJ, PROJ_LD, nullptr, 0, 1 << 30}, c.tid);
    } else if constexpr (r == 2) {
        pg8::ProbUp P{PROJ + PC_CQ, PROJ + PC_LAT, (const bf16_t*)(ws + WS_WQ) + (size_t)l * 768 * 256, (const bf16_t*)(ws + WS_WKV) + (size_t)l * 1280 * 256, PROJ_LD, 256, 256, {}};
        P.S.init(MTOK / 256, 8, c.nblk, c.bid);
        pg8::gemm_phase(c.ring, P, pg8::EpiStoreT{Q, QLD, KV, KVLD, 3}, c.tid);
    } else if constexpr (r == 3) phase_fin2(c, p, l);
    else if constexpr (r == 4) att::phase(c, p, l + 2 * repi);
    else if constexpr (r == 5) {
        pg8::ProbPlain P{H, (const bf16_t*)(ws + WS_WOUT) + (size_t)l * 1024 * 1024, 1024, 1024, 1024, {}}; P.S.init(MTOK / 256, 4, c.nblk, c.bid);
        {
            const float* ssh = (const float*)(ws + WS_SSH); float* rat = (float*)(ws + WS_RAT);
            pg8::Unit u;
            for (int ui = 0; P.next(ui, u); ++ui) if (c.tid < 256) {
                const size_t row = (size_t)u.pm * 256 + c.tid; const float* sp = ssh + row * 16;
                const f32x4 a = *(const f32x4*)sp, b = *(const f32x4*)(sp + 4), c2 = *(const f32x4*)(sp + 8), d = *(const f32x4*)(sp + 12);
                const float s1 = (a[0] + a[1]) + (a[2] + a[3]), s2 = ((b[0] + b[1]) + (b[2] + b[3])) + ((c2[0] + c2[1]) + (c2[2] + c2[3])), s3 = (d[0] + d[1]) + (d[2] + d[3]);
                const float q1 = rsqrtf(s1 * (1.f / 256.f) + EPS), q2 = rsqrtf(s2 * (1.f / 512.f) + EPS), q3 = rsqrtf(s3 * (1.f / 256.f) + EPS);
                *(f32x4*)(rat + row * 4) = (f32x4){q1 / q2, q2 / q3, q3, 0.f};
            }
            asm volatile("s_waitcnt vmcnt(0)" ::: "memory"); __syncthreads();
        }
        if constexpr (l == 0) pg8::gemm_phase<pg8::EpiResidT<false, true>, pg8::ProbPlain, false, true, pg8::GroupRowScale>(c.ring, P, pg8::EpiResidT<false, true>{p.in[I_X], XS, modl + 2048}, c.tid, pg8::GroupRowScale{(const float*)(ws + WS_RAT)});
        else pg8::gemm_phase<pg8::EpiResidT<true, true>, pg8::ProbPlain, false, true, pg8::GroupRowScale>(c.ring, P, pg8::EpiResidT<true, true>{XS, XS, modl + 2048}, c.tid, pg8::GroupRowScale{(const float*)(ws + WS_RAT)});
    } else if constexpr (r == 6) phase_norm<(l == 1), true>(c, p, XS, p.in[I_NFFN] + l * DM, modl + 3072, modl + 4096);
    else if constexpr (l == 0 && r == 7) {
        pg8::ProbPlain P{H, (const bf16_t*)(ws + WS_FGU), 1024, 1024, 1024, {}}; P.S.init(MTOK / 256, 22, c.nblk, c.bid);
        pg8::gemm_phase(c.ring, P, pg8::EpiSwigluT{HID}, c.tid);
    } else if constexpr (l == 0 && r == 8) {
        pg8::ProbPlain P{HID, (const bf16_t*)(ws + WS_FD), DFF, DFF, DFF, {}}; P.S.init(MTOK / 256, 4, c.nblk, c.bid);
        pg8::gemm_phase(c.ring, P, pg8::EpiResidT<true, true>{XS, XS, modl + 5120}, c.tid);
    } else if constexpr (l == 1 && r == 7) phase_route(c, p);
    else if constexpr (l == 1 && r == 12) phase_moe_tail(c, p, modl + 5120);
    else {
        constexpr int s = (r - 8) >> 1;
        const int* perm = (const int*)(ws + WS_PERM) + s * MOE_ROWS; const float* permw = (const float*)(ws + WS_PERMW) + s * MOE_ROWS;
        const int* texp = (const int*)(ws + WS_TEXP);
        const int ntl0 = texp[2 * MOE_TILES + 0];
        int q0 = ntl0 - (256 * 2) / 4; q0 = q0 < 0 ? 0 : q0 > 8 ? 8 : q0; if (c.nblk != 256) q0 = 0;
        const int ntl1 = texp[2 * MOE_TILES + 1];
        int q1 = ntl1 - (256 * 2) / 4; q1 = q1 < 0 ? 0 : q1 > 8 ? 8 : q1; if (c.nblk != 256) q1 = 0;
        bf16_t* HIDs = HID + (size_t)(s * 8) * 256 * DFF;
        int mx = 0;
        if (c.nblk == 256) { const int nw0 = 22 * ntl0, spare = ((nw0 + 255) / 256) * 256 - nw0; mx = spare / 22; int lim = ntl1 - ntl0 + 8; lim = lim < 0 ? 0 : lim; mx = mx > lim ? lim : mx; mx = mx > ntl1 ? ntl1 : mx; }
        if constexpr (((r - 8) & 1) == 0) {
            const int ntl = (s == 0) ? ntl0 : ntl1 - mx;
            if (s == 1 && c.bid >= c.nblk - 4 * q0) {
                const int k = c.bid - (c.nblk - 4 * q0);
                pg8::ProbMoeT<pg8::OneUnit> P{HID, (const bf16_t*)(ws + WS_MD), DFF, DFF, DFF, {k >> 2, k & 3}, texp, (size_t)1024 * DFF, nullptr, 0};
                pg8::gemm_phase(c.ring, P, pg8::EpiMoeDownT<true>{XS, XS2, modl + 5120, (const int*)(ws + WS_PERM), (const float*)(ws + WS_PERMW)}, c.tid);
                __syncthreads();
            }
            LAS unsigned* tab = (LAS unsigned*)(c.ring + 131072);
            pg8::ProbMoeT<pg8::SkipOrder> P{H, (const bf16_t*)(ws + WS_MGU), 1024, 1024, 1024, {{}, (s == 1) ? 4 * q0 : 0, 3, (s == 0) ? mx : 0, MOE_TILES + ntl1 - mx}, texp + s * MOE_TILES, (size_t)5632 * 1024, tab, 0};
            P.S.base.init(ntl, 22, c.nblk, c.bid);
            { pg8::Unit u; for (int ui = 0; ui < 16 && P.next(ui, u); ++ui) if (c.tid < 256) { const int tok = perm[u.pm * 256 + c.tid]; tab[ui * 256 + c.tid] = (unsigned)(tok < 0 ? 0 : tok) * 2048u; } }
            __syncthreads();
            pg8::gemm_phase<pg8::EpiSwigluT, pg8::ProbMoeT<pg8::SkipOrder>, true>(c.ring, P, pg8::EpiSwigluT{HIDs, MOE_TILES, 8 - MOE_TILES}, c.tid);
        } else {
            const int ntl = texp[2 * MOE_TILES + s], qo = (s == 0) ? q0 : q1;
            pg8::ProbMoeT<pg8::StaticOrder> P{HIDs, (const bf16_t*)(ws + WS_MD), DFF, DFF, DFF, {}, texp + s * MOE_TILES, (size_t)1024 * DFF, nullptr, qo};
            P.S.init(ntl - qo, 4, c.nblk, c.bid);
            if constexpr (s == 0) pg8::gemm_phase(c.ring, P, pg8::EpiMoeDownT<true>{XS, XS2, modl + 5120, perm, permw}, c.tid);
            else {
                pg8::gemm_phase(c.ring, P, pg8::EpiMoeDownT<false>{XS2, (void*)p.out, modl + 5120, perm, permw}, c.tid);
                if (q1 > 0) {
                    __syncthreads();
                    pg8::ProbSplitK4 PS{HIDs, (const bf16_t*)(ws + WS_MD), DFF, DFF, DFF, texp + s * MOE_TILES, (size_t)1024 * DFF, 16 * q1, c.nblk, c.bid};
                    pg8::gemm_phase(c.ring, PS, pg8::EpiPartialT{(float*)(ws + WS_PART), 8 * 256}, c.tid);
                }
            }
        }
    }
}
template <int PH, int HI> DEVI void run_range(const Ctx& c, const Params& p, const XcdBarrier& bar) {
    if constexpr (PH < HI) {
        run_phase<PH>(c, p);
        if constexpr ((REP_MASK >> PH) & 1u) { xcd_barrier(bar); run_phase<PH>(c, p, 1); }
        if constexpr (PROBE_TYPES != 0 && PH == 5) { xcd_barrier(bar); Ctx cc = c; cc.tid = threadIdx.x; cc.lane = threadIdx.x & 63; cc.wid = __builtin_amdgcn_readfirstlane(threadIdx.x >> 6); att::phase_probe(cc, p, 0); }
        if constexpr (PH + 1 < HI) { xcd_barrier(bar); run_range<PH + 1, HI>(c, p, bar); }
    }
}

template <int LO, int HI>
__global__ void __launch_bounds__(512, 2) mega_kernel(Params p) {
    extern __shared__ __attribute__((aligned(16))) unsigned char lds[];
    Ctx c; c.bid = blockIdx.x; c.nblk = gridDim.x; c.tid = threadIdx.x; c.lane = threadIdx.x & 63; c.wid = __builtin_amdgcn_readfirstlane(threadIdx.x >> 6);
    c.ring = (LAS unsigned char*)lds; c.sm = (float*)(lds + LDS_SM);
    volatile LAS unsigned* xbw = (volatile LAS unsigned*)((LAS unsigned char*)lds + LDS_XB);
    if (threadIdx.x < 4) xbw[threadIdx.x] = 0u;
    __syncthreads();
    unsigned* barw = (unsigned*)(p.ws + WS_CTL);
    XcdBarrier bar; bar.bar = barw; bar.x = 0; bar.st = xbw;
    if constexpr (HI - LO > 1) bar = xcd_barrier_post(barw, xbw);
    run_range<LO, HI>(c, p, bar);
}

template <int K> static void launch_each(int grid, hipStream_t stream, const Params& p) {
    if constexpr (K < NPHASE) {
        (void)hipFuncSetAttribute((const void*)mega_kernel<K, K + 1>, hipFuncAttributeMaxDynamicSharedMemorySize, LDS_BYTES);
        hipLaunchKernelGGL((mega_kernel<K, K + 1>), dim3(grid), dim3(512), LDS_BYTES, stream, p);
        launch_each<K + 1>(grid, stream, p);
    }
}

extern "C" void kernel_launch(void* const* d_in, const int* in_sizes, int n_in, void* d_out, int out_size, void* d_ws, size_t ws_size, hipStream_t stream) {
    (void)in_sizes; (void)out_size;
    if (n_in < 26 || ws_size < WS_END) { fprintf(stderr, "kernel_launch: bad sizes n_in=%d ws=%zu\n", n_in, ws_size); return; }
    static int grid = 0;
    if (!grid) {
        int dev = 0, cus = 0;
        (void)hipGetDevice(&dev);
        (void)hipDeviceGetAttribute(&cus, hipDeviceAttributeMultiprocessorCount, dev);
        grid = cus;
        if (grid > 256 || grid < 1) grid = 256;
    }
    (void)hipMemsetAsync((unsigned char*)d_ws + WS_CTL, 0, CTL_BYTES, stream);
    Params p{};
    for (int i = 0; i < 26; ++i) p.in[i] = (const float*)d_in[i];
    p.out = (float*)d_out; p.ws = (unsigned char*)d_ws;
#if ONE_LAUNCH
    (void)hipFuncSetAttribute((const void*)mega_kernel<0, NPHASE>, hipFuncAttributeMaxDynamicSharedMemorySize, LDS_BYTES);
    hipLaunchKernelGGL((mega_kernel<0, NPHASE>), dim3(grid), dim3(512), LDS_BYTES, stream, p);
#else
    launch_each<0>(grid, stream, p);
#endif
}
```

```cpp
#include <hip/hip_runtime.h>
#include <stdint.h>
#include <stdio.h>

#ifndef REP_MASK
#define REP_MASK 0u
#endif
#ifndef ONE_LAUNCH
#define ONE_LAUNCH 1
#endif

#define DEVI __device__ __forceinline__
#define LAS __attribute__((address_space(3)))
typedef unsigned short bf16_t;
typedef short bf16x8 __attribute__((ext_vector_type(8)));
typedef float f32x4 __attribute__((ext_vector_type(4)));

constexpr int NB = 8, SEQ = 4096, DM = 1024, MTOK = NB * SEQ;
constexpr int INC = 1952;
constexpr int PROJ_LD = 2048;
constexpr int DFF = 2816, NEXP = 8;
constexpr int QLD = 768;
constexpr int KVLD = 1280;
constexpr float EPS = 1e-6f;
constexpr int PC_SBQ = 0, PC_SBK = 256, PC_SBV = 512, PC_CQ = 768, PC_CKQ = 1024, PC_CKK = 1280, PC_CKV = 1536, PC_LAT = 1792, PC_KPE = 1920;
constexpr int MOE_TILES = 136;
constexpr int WS_BND_WORD = 12288;
constexpr float att_L2E = 1.4426950408889634f;
constexpr int MOE_ROWS = MOE_TILES * 256;

constexpr size_t MiB = 1u << 20;
constexpr size_t WS_CTL = 0, CTL_BYTES = 64 * 1024;
constexpr size_t WS_MOD = 1 * MiB;
constexpr size_t WS_COS = 2 * MiB, WS_SIN = 4 * MiB;
constexpr size_t WS_TOKE = 6 * MiB;
constexpr size_t WS_TOKW = 6 * MiB + 256 * 1024;
constexpr size_t WS_CNT = 6 * MiB + 512 * 1024;
constexpr size_t WS_PERM = 6 * MiB + 640 * 1024;
constexpr size_t WS_PERMW = 7 * MiB;
constexpr size_t WS_TEXP = 7 * MiB + 512 * 1024;
constexpr size_t WS_WIN = 8 * MiB;
constexpr size_t WS_WQ = 16 * MiB;
constexpr size_t WS_WKV = 17 * MiB;
constexpr size_t WS_WOUT = 19 * MiB;
constexpr size_t WS_FGU = 23 * MiB;
constexpr size_t WS_FD = 34 * MiB;
constexpr size_t WS_MGU = 40 * MiB;
constexpr size_t WS_MD = 128 * MiB;
constexpr size_t WS_H = 172 * MiB;
constexpr size_t WS_PROJ = 236 * MiB;
constexpr size_t WS_Q = 364 * MiB;
constexpr size_t WS_KV = 412 * MiB;
constexpr size_t WS_HID = 236 * MiB;
constexpr size_t WS_SSH = 492 * MiB;
constexpr size_t WS_RAT = 494 * MiB;
constexpr size_t WS_ALPHA = 494 * MiB + 512 * 1024;
constexpr size_t WS_XS2 = 440 * MiB;
constexpr size_t WS_PART = 172 * MiB;
constexpr size_t WS_END = 504 * MiB;
static_assert(WS_HID + (size_t)MOE_ROWS * DFF * 2 <= WS_END, "hid fits");
static_assert(WS_KV + (size_t)MTOK * KVLD * 2 <= WS_END, "kv fits");

DEVI float bf2f(bf16_t v) { return __builtin_bit_cast(float, (unsigned)v << 16); }
DEVI bf16_t f2bf(float f) { unsigned u = __builtin_bit_cast(unsigned, f); return (bf16_t)((u + 0x7fffu + ((u >> 16) & 1u)) >> 16); }
DEVI unsigned pk2(float lo, float hi) { return (unsigned)f2bf(lo) | ((unsigned)f2bf(hi) << 16); }
DEVI float lo16(unsigned u) { return __builtin_bit_cast(float, u << 16); }
DEVI float hi16(unsigned u) { return __builtin_bit_cast(float, u & 0xffff0000u); }
DEVI float wave_sum(float v) {
#pragma unroll
    for (int o = 32; o; o >>= 1) v += __shfl_xor(v, o, 64);
    return v;
}
DEVI float sum16(float v) {
#pragma unroll
    for (int o = 8; o; o >>= 1) v += __shfl_xor(v, o, 64);
    return v;
}
template <int N> DEVI void load_bf16_row(const bf16_t* p, float (&out)[N]) {
#pragma unroll
    for (int i = 0; i < N / 8; ++i) {
        const uint4 v = *(const uint4*)(p + 8 * i);
        out[8 * i + 0] = lo16(v.x); out[8 * i + 1] = hi16(v.x); out[8 * i + 2] = lo16(v.y); out[8 * i + 3] = hi16(v.y);
        out[8 * i + 4] = lo16(v.z); out[8 * i + 5] = hi16(v.z); out[8 * i + 6] = lo16(v.w); out[8 * i + 7] = hi16(v.w);
    }
}
template <int N> DEVI void store_bf16_row(bf16_t* p, const float (&v)[N]) {
#pragma unroll
    for (int i = 0; i < N / 8; ++i) {
        uint4 o; o.x = pk2(v[8 * i], v[8 * i + 1]); o.y = pk2(v[8 * i + 2], v[8 * i + 3]); o.z = pk2(v[8 * i + 4], v[8 * i + 5]); o.w = pk2(v[8 * i + 6], v[8 * i + 7]);
        *(uint4*)(p + 8 * i) = o;
    }
}

template <int N> DEVI float dot_bf16(const bf16_t* p, const float (&q)[N]) {
    float z0 = 0.f, z1 = 0.f;
#pragma unroll
    for (int i = 0; i < N / 8; ++i) {
        const uint4 v = *(const uint4*)(p + 8 * i);
        z0 += q[8 * i + 0] * lo16(v.x); z1 += q[8 * i + 1] * hi16(v.x); z0 += q[8 * i + 2] * lo16(v.y); z1 += q[8 * i + 3] * hi16(v.y);
        z0 += q[8 * i + 4] * lo16(v.z); z1 += q[8 * i + 5] * hi16(v.z); z0 += q[8 * i + 6] * lo16(v.w); z1 += q[8 * i + 7] * hi16(v.w);
    }
    return z0 + z1;
}
template <int N> DEVI void axpy_bf16(float (&acc)[N], float corr, float w, const bf16_t* p) {
#pragma unroll
    for (int i = 0; i < N / 8; ++i) {
        const uint4 v = *(const uint4*)(p + 8 * i);
        acc[8 * i + 0] = acc[8 * i + 0] * corr + w * lo16(v.x); acc[8 * i + 1] = acc[8 * i + 1] * corr + w * hi16(v.x);
        acc[8 * i + 2] = acc[8 * i + 2] * corr + w * lo16(v.y); acc[8 * i + 3] = acc[8 * i + 3] * corr + w * hi16(v.y);
        acc[8 * i + 4] = acc[8 * i + 4] * corr + w * lo16(v.z); acc[8 * i + 5] = acc[8 * i + 5] * corr + w * hi16(v.z);
        acc[8 * i + 6] = acc[8 * i + 6] * corr + w * lo16(v.w); acc[8 * i + 7] = acc[8 * i + 7] * corr + w * hi16(v.w);
    }
}

template <int N> DEVI float dot_bf16_pk(const bf16_t* p, const unsigned (&q)[N / 2]) {
    float z0 = 0.f, z1 = 0.f;
#pragma unroll
    for (int i = 0; i < N / 8; ++i) {
        const uint4 v = *(const uint4*)(p + 8 * i);
        z0 += lo16(q[4 * i + 0]) * lo16(v.x); z1 += hi16(q[4 * i + 0]) * hi16(v.x); z0 += lo16(q[4 * i + 1]) * lo16(v.y); z1 += hi16(q[4 * i + 1]) * hi16(v.y);
        z0 += lo16(q[4 * i + 2]) * lo16(v.z); z1 += hi16(q[4 * i + 2]) * hi16(v.z); z0 += lo16(q[4 * i + 3]) * lo16(v.w); z1 += hi16(q[4 * i + 3]) * hi16(v.w);
    }
    return z0 + z1;
}

#define XB_TMO      128
#define XB_XCNT(j)  (256  + 64 * (j))
#define XB_XSUB(j)  (1280 + 64 * (j))
#define XB_XGEN(j)  (2304 + 64 * (j))
#define XB_TOP      3328
#define XB_TOPGEN   3392
#define XCD_BAR_WORDS 3456
#define XB_SPIN_CAP (1u << 24)
DEVI unsigned xb_ld(unsigned* p)              { return __hip_atomic_load(p, __ATOMIC_RELAXED, __HIP_MEMORY_SCOPE_AGENT); }
DEVI unsigned xb_add(unsigned* p, unsigned v) { return __hip_atomic_fetch_add(p, v, __ATOMIC_RELAXED, __HIP_MEMORY_SCOPE_AGENT); }
DEVI unsigned xb_xcc_id() { return (unsigned)__builtin_amdgcn_s_getreg((3 << 11) | 20) & 0xFu; }
#define XB_SPIN(cond, bar) do { unsigned _sp = 0; while (cond) { __builtin_amdgcn_s_sleep(1); \
    if ((++_sp & 255u) == 0u) { if (xb_ld(&(bar)[XB_TMO])) break; if (_sp > XB_SPIN_CAP) { atomicAdd(&(bar)[XB_TMO], 1u); break; } } } } while (0)
struct XcdBarrier { unsigned* bar; unsigned x; volatile LAS unsigned* st; };
DEVI XcdBarrier xcd_barrier_post(unsigned* bar, volatile LAS unsigned* st) {
    XcdBarrier b; b.bar = bar; b.x = xb_xcc_id(); b.st = st;
    if (threadIdx.x == 0) (void)xb_add(&bar[XB_XCNT(b.x)], 1u);
    return b;
}
DEVI void xcd_barrier_complete(unsigned* bar, unsigned x, unsigned& nloc, unsigned& nx) {
    const unsigned G = gridDim.x * gridDim.y * gridDim.z;
    unsigned sum, cnt, mine, sp = 0u;
    for (;;) {
        sum = 0u; cnt = 0u; mine = 0u;
#pragma unroll
        for (unsigned j = 0; j < 16; ++j) { const unsigned c = xb_ld(&bar[XB_XCNT(j)]); sum += c; cnt += (c > 0u) ? 1u : 0u; mine = (j == x) ? c : mine; }
        if (sum == G) break;
        __builtin_amdgcn_s_sleep(1);
        if ((++sp & 255u) == 0u) { if (xb_ld(&bar[XB_TMO])) break; if (sp > XB_SPIN_CAP) { atomicAdd(&bar[XB_TMO], 1u); break; } }
    }
    nloc = mine > 0u ? mine : 1u; nx = cnt > 0u ? cnt : 1u;
}
DEVI void xcd_barrier(const XcdBarrier& b) {
    asm volatile("s_waitcnt vmcnt(0)" ::: "memory");
    __syncthreads();
    if (threadIdx.x == 0) {
        unsigned* bar = b.bar;
        __builtin_amdgcn_s_waitcnt(0);
        unsigned nloc = b.st[0], nx = b.st[1];
        if (nloc == 0u) { xcd_barrier_complete(bar, b.x, nloc, nx); b.st[0] = nloc; b.st[1] = nx; }
        const unsigned old = xb_add(&bar[XB_XSUB(b.x)], 1u);
        const unsigned gen = old / nloc;
        if (old + 1u == (gen + 1u) * nloc) {
            __builtin_amdgcn_fence(__ATOMIC_RELEASE, "agent");
            asm volatile("s_waitcnt vmcnt(0)" ::: "memory");
            const unsigned og = xb_add(&bar[XB_TOP], 1u);
            const unsigned tg = og / nx;
            if (og + 1u == (tg + 1u) * nx) xb_add(&bar[XB_TOPGEN], 1u);
            else XB_SPIN(xb_ld(&bar[XB_TOPGEN]) == tg, bar);
            __builtin_amdgcn_fence(__ATOMIC_ACQUIRE, "agent");
            xb_add(&bar[XB_XGEN(b.x)], 1u);
            asm volatile("s_waitcnt vmcnt(0)" ::: "memory");
        } else {
            XB_SPIN(xb_ld(&bar[XB_XGEN(b.x)]) == gen, bar);
            __builtin_amdgcn_fence(__ATOMIC_ACQUIRE, "agent");
            asm volatile("s_waitcnt vmcnt(0)" ::: "memory");
        }
    }
    __syncthreads();
}

struct Params {
    const float* in[26];
    float* out;
    unsigned char* ws;
};
enum { I_X = 0, I_C, I_POS, I_ADAW, I_ADAB, I_NMIX, I_NFFN, I_WIN, I_QNORM, I_WQUP, I_KVNORM, I_WKVUP, I_QQK, I_KQK, I_CKQN, I_CKKN, I_RELB, I_GON, I_WOUT,
       I_FG, I_FU, I_FD, I_ROUTER, I_MG, I_MU, I_MD };

struct Ctx {
    int bid, nblk, tid, lane, wid;
    float* sm;
    LAS unsigned char* ring;
};

enum { MAP_ID = 0, MAP_WIN, MAP_KV, MAP_GU };
template <int MAP>
DEVI void conv_job(const Ctx& c, const float* src, const float* src2, int src_ld, int Ksrc, const float* gain, bf16_t* dst, int Kdst, int nrows) {
    const int nrb = nrows / 32, nkb = Kdst / 64, total = nrb * nkb;
    float* tile = c.sm;
    for (int it = c.bid; it < total; it += c.nblk) {
        const int rb = it / nkb, kb = it % nkb, k0 = kb * 64;
        const float* s = src; int col = rb * 32;
        if (MAP == MAP_WIN) { const int r = rb * 32; col = r < 1024 ? r : r < 1792 ? 1184 + (r - 1024) : r < 1920 ? 1024 + (r - 1792) : r < 1952 ? 1152 : -1; }
        if (MAP == MAP_KV) { const int r = rb * 32, h = r / 160, o = r % 160; col = o < 64 ? 128 * h + o : o < 96 ? -1 : 128 * h + 64 + (o - 96); }
        if (MAP == MAP_GU) { const int t = rb >> 3, sb = rb & 7; s = (sb >> 2) ? src2 : src; col = 128 * t + 32 * (sb & 3); }
        for (int e = c.tid; e < 2048; e += 512) {
            const int kk = e >> 5, j = e & 31, k = k0 + kk;
            float v = 0.f;
            if (col >= 0 && k < Ksrc) { v = s[(size_t)k * src_ld + col + j]; if (gain) v *= gain[k]; }
            tile[kk * 33 + j] = v;
        }
        __syncthreads();
        for (int e = c.tid; e < 1024; e += 512) {
            const int j = e >> 5, kp = e & 31;
            *(unsigned*)(dst + (size_t)(rb * 32 + j) * Kdst + k0 + 2 * kp) = pk2(tile[(2 * kp) * 33 + j], tile[(2 * kp + 1) * 33 + j]);
        }
        __syncthreads();
    }
}


enum { MAP_Q = 4 };
template <int MAP>
DEVI void conv_job2(const Ctx& c, const float* __restrict__ src, const float* __restrict__ src2, int src_ld, int Ksrc, const float* __restrict__ gain, bf16_t* __restrict__ dst, int Kdst, int nrows) {
    const int nrb = nrows / 64, nkb = Kdst / 64, total = nrb * nkb;
    for (int it = c.bid * 8 + c.wid; it < total; it += c.nblk * 8) {
        const int kb = it / nrb, rb = it % nrb, n = rb * 64 + c.lane, k0 = kb * 64;
        const float* sp = src; int col = n;
        if (MAP == MAP_WIN) col = n < 1024 ? n : n < 1792 ? 1184 + (n - 1024) : n < 1920 ? 1024 + (n - 1792) : n < 1952 ? 1152 + (n - 1920) : -1;
        if (MAP == MAP_KV) { const int h = n / 160, o = n % 160; col = o < 64 ? 128 * h + o : o < 96 ? -1 : 128 * h + 64 + (o - 96); }
        if (MAP == MAP_GU) { const int t = n >> 8, r = n & 255; sp = (r >> 7) ? src2 : src; col = 128 * t + (r & 127); }
        if (MAP == MAP_Q) { const int h = n / 96, pos = n % 96; col = 96 * h + (pos < 64 ? pos : 64 + ((pos - 64) >> 1) + 16 * ((pos - 64) & 1)); }
        const bool live = (col >= 0);
        sp += live ? col : 0;
        bf16_t* dp = dst + (size_t)n * Kdst + k0;
        float v[64];
        if (live) {
#pragma unroll
            for (int j = 0; j < 64; ++j) v[j] = (k0 + j < Ksrc) ? __builtin_nontemporal_load(sp + (size_t)(k0 + j) * src_ld) : 0.f;
            if (gain) {
#pragma unroll
                for (int j = 0; j < 64; ++j) v[j] *= (k0 + j < Ksrc) ? gain[k0 + j] : 0.f;
            }
        } else {
#pragma unroll
            for (int j = 0; j < 64; ++j) v[j] = 0.f;
        }
#pragma unroll
        for (int k8 = 0; k8 < 8; ++k8) {
            uint4 o; o.x = pk2(v[8 * k8], v[8 * k8 + 1]); o.y = pk2(v[8 * k8 + 2], v[8 * k8 + 3]); o.z = pk2(v[8 * k8 + 4], v[8 * k8 + 5]); o.w = pk2(v[8 * k8 + 6], v[8 * k8 + 7]);
            *(uint4*)(dp + k8 * 8) = o;
        }
    }
}

template <int MAP>
DEVI void conv_job3(const Ctx& c, const float* __restrict__ src, const float* __restrict__ src2, int src_ld, int Ksrc, const float* __restrict__ gain, bf16_t* __restrict__ dst, int Kdst, int nrows) {
    const int nrb = nrows / 256, nkb = Kdst / 16, total = nrb * nkb;
    for (int it = c.bid * 8 + c.wid; it < total; it += c.nblk * 8) {
        const int kb = it % nkb, rb = it / nkb, n = rb * 256 + 4 * c.lane, k0 = kb * 16;
        const float* sp = src; int col = n;
        if (MAP == MAP_WIN) col = n < 1024 ? n : n < 1792 ? 1184 + (n - 1024) : n < 1920 ? 1024 + (n - 1792) : n < 1952 ? 1152 + (n - 1920) : -1;
        if (MAP == MAP_KV) { const int h = n / 160, o = n % 160; col = o < 64 ? 128 * h + o : o < 96 ? -1 : 128 * h + 64 + (o - 96); }
        if (MAP == MAP_GU) { const int t = n >> 8, r = n & 255; sp = (r >> 7) ? src2 : src; col = 128 * t + (r & 127); }
        const bool live = (col >= 0) && (k0 < Ksrc);
        f32x4 v[16];
        if (live) {
            sp += col;
#pragma unroll
            for (int j = 0; j < 16; ++j) v[j] = __builtin_nontemporal_load((const f32x4*)(sp + (size_t)(k0 + j) * src_ld));
            if (gain) {
#pragma unroll
                for (int j = 0; j < 16; ++j) v[j] *= gain[k0 + j];
            }
        } else {
#pragma unroll
            for (int j = 0; j < 16; ++j) v[j] = (f32x4){0.f, 0.f, 0.f, 0.f};
        }
#pragma unroll
        for (int i = 0; i < 4; ++i) {
            uint4 o0, o1;
            o0.x = pk2(v[0][i], v[1][i]); o0.y = pk2(v[2][i], v[3][i]); o0.z = pk2(v[4][i], v[5][i]); o0.w = pk2(v[6][i], v[7][i]);
            o1.x = pk2(v[8][i], v[9][i]); o1.y = pk2(v[10][i], v[11][i]); o1.z = pk2(v[12][i], v[13][i]); o1.w = pk2(v[14][i], v[15][i]);
            bf16_t* dp = dst + (size_t)(n + i) * Kdst + k0;
            *(uint4*)dp = o0; *(uint4*)(dp + 8) = o1;
        }
    }
}

template <int MAP>
DEVI void conv_rowblock(const Ctx& c, const float* __restrict__ src, const float* __restrict__ src2, int src_ld, int Ksrc, const float* __restrict__ gain, bf16_t* __restrict__ dst, int Kdst, int rb) {
    const int nkb = Kdst / 16;
    for (int kb = c.wid; kb < nkb; kb += 8) {
        const int n = rb * 256 + 4 * c.lane, k0 = kb * 16;
        const float* sp = src; int col = n;
        if (MAP == MAP_WIN) col = n < 1024 ? n : n < 1792 ? 1184 + (n - 1024) : n < 1920 ? 1024 + (n - 1792) : n < 1952 ? 1152 + (n - 1920) : -1;
        if (MAP == MAP_KV) { const int h = n / 160, o = n % 160; col = o < 64 ? 128 * h + o : o < 96 ? -1 : 128 * h + 64 + (o - 96); }
        if (MAP == MAP_GU) { const int t = n >> 8, r = n & 255; sp = (r >> 7) ? src2 : src; col = 128 * t + (r & 127); }
        const bool live = (col >= 0) && (k0 < Ksrc);
        f32x4 v[16];
        if (live) {
            sp += col;
#pragma unroll
            for (int j = 0; j < 16; ++j) v[j] = __builtin_nontemporal_load((const f32x4*)(sp + (size_t)(k0 + j) * src_ld));
            if (gain) {
#pragma unroll
                for (int j = 0; j < 16; ++j) v[j] *= gain[k0 + j];
            }
        } else {
#pragma unroll
            for (int j = 0; j < 16; ++j) v[j] = (f32x4){0.f, 0.f, 0.f, 0.f};
        }
#pragma unroll
        for (int i = 0; i < 4; ++i) {
            uint4 o0, o1;
            o0.x = pk2(v[0][i], v[1][i]); o0.y = pk2(v[2][i], v[3][i]); o0.z = pk2(v[4][i], v[5][i]); o0.w = pk2(v[6][i], v[7][i]);
            o1.x = pk2(v[8][i], v[9][i]); o1.y = pk2(v[10][i], v[11][i]); o1.z = pk2(v[12][i], v[13][i]); o1.w = pk2(v[14][i], v[15][i]);
            bf16_t* dp = dst + (size_t)(n + i) * Kdst + k0;
            *(uint4*)dp = o0; *(uint4*)(dp + 8) = o1;
        }
    }
}

#ifndef MOE_CONV_IN_ATT
#define MOE_CONV_IN_ATT 1
#endif
#ifndef PRO_SKIP
#define PRO_SKIP 0
#endif
DEVI void phase_prologue(const Ctx& c, const Params& p, int repi = 0) {
    unsigned char* ws = p.ws;
    const int skip = repi ? PRO_SKIP : 0;
    if (!(skip & 1))
    {
        LAS float* sc = (LAS float*)c.ring;
        float* part = c.sm;
        float* mod = (float*)(ws + WS_MOD);
        for (int e = c.tid; e < 8 * 1024; e += 512) { const float v = p.in[I_C][e]; sc[e] = v / (1.f + __expf(-v)); }
        __syncthreads();
        const int col_l = c.tid % 48, ks = c.tid / 48;
        for (int it = c.bid; it < 256; it += c.nblk) {
            const int gcol = it * 48 + col_l, l = gcol / 6144, col = gcol % 6144;
            if (ks < 8) {
                const float* w = p.in[I_ADAW] + (size_t)l * 1024 * 6144 + (size_t)(ks * 128) * 6144 + col;
                float acc[8];
#pragma unroll
                for (int b = 0; b < 8; ++b) acc[b] = 0.f;
#pragma unroll 1
                for (int k0 = 0; k0 < 128; k0 += 32) {
                    float wv[32];
#pragma unroll
                    for (int j = 0; j < 32; ++j) wv[j] = __builtin_nontemporal_load(w + (size_t)(k0 + j) * 6144);
#pragma unroll
                    for (int j = 0; j < 32; ++j)
#pragma unroll
                        for (int b = 0; b < 8; ++b) acc[b] += sc[b * 1024 + ks * 128 + k0 + j] * wv[j];
                }
#pragma unroll
                for (int b = 0; b < 8; ++b) part[(ks * 8 + b) * 48 + col_l] = acc[b];
            }
            __syncthreads();
            if (c.tid < 384) { const int b = c.tid / 48, cl = c.tid % 48;
              const int gc = it * 48 + cl, l2 = gc / 6144, c2 = gc % 6144;
              float a = 0.f;
#pragma unroll
              for (int k2 = 0; k2 < 8; ++k2) a += part[(k2 * 8 + b) * 48 + cl];
              mod[(l2 * 8 + b) * 6144 + c2] = a + p.in[I_ADAB][l2 * 6144 + c2]; }
            __syncthreads();
        }
        __syncthreads();
    }
    if (!(skip & 2)) {
        float* cs = (float*)(ws + WS_COS); float* sn = (float*)(ws + WS_SIN);
        const int* pos = (const int*)p.in[I_POS];
        for (int e = c.bid * 512 + c.tid; e < MTOK * 16; e += c.nblk * 512) {
            const int m = e >> 4, i = e & 15;
            const float inv_freq = powf(10000.0f, -(float)(2 * i) / 32.0f);
            const float ang = (float)pos[m] * inv_freq;
            cs[e] = cosf(ang); sn[e] = sinf(ang);
        }
    }
    if (c.bid == 0 && c.wid == 0) {
        float* bnd = (float*)(ws + WS_CTL) + WS_BND_WORD;
        for (int l = 0; l < 2; ++l) {
            const float* gq = p.in[I_QQK] + l * 96; const float* gk = p.in[I_KQK] + l * 96;
            float g = fabsf(gq[c.lane] * gk[c.lane]); if (c.lane < 32) g = fmaxf(g, fabsf(gq[64 + c.lane] * gk[64 + c.lane]));
            const float* gcq = p.in[I_CKQN] + l * 64; const float* gck = p.in[I_CKKN] + l * 64;
            float gc = fabsf(gcq[c.lane] * gck[c.lane]);
#pragma unroll
            for (int o = 32; o; o >>= 1) { g = fmaxf(g, __shfl_xor(g, o, 64)); gc = fmaxf(gc, __shfl_xor(gc, o, 64)); }
            if (c.lane == 0) bnd[l * 8] = 9.797958971132712f * att_L2E * g * 1.02f + 0.5f;
            for (int h = 0; h < 4; ++h) {
                const float* rb = p.in[I_RELB] + (l * 4 + h) * 257; float b = 0.f;
                for (int i = c.lane; i < 257; i += 64) b = fmaxf(b, fabsf(rb[i]));
#pragma unroll
                for (int o = 32; o; o >>= 1) b = fmaxf(b, __shfl_xor(b, o, 64));
                if (c.lane == 0) bnd[l * 8 + 1 + h] = att_L2E * (8.f * gc + b) * 1.02f + 0.5f;
            }
        }
    }
    if (!(skip & 8)) for (int l = 0; l < 2; ++l) {
        conv_job3<MAP_WIN>(c, p.in[I_WIN] + (size_t)l * 1024 * INC, nullptr, INC, 1024, nullptr, (bf16_t*)(ws + WS_WIN) + (size_t)l * 2048 * 1024, 1024, 2048);
        conv_job2<MAP_Q>(c, p.in[I_WQUP] + (size_t)l * 256 * 768, nullptr, 768, 256, p.in[I_QNORM] + l * 256, (bf16_t*)(ws + WS_WQ) + (size_t)l * 768 * 256, 256, 768);
        conv_job3<MAP_KV>(c, p.in[I_WKVUP] + (size_t)l * 128 * 1024, nullptr, 1024, 128, p.in[I_KVNORM] + l * 128, (bf16_t*)(ws + WS_WKV) + (size_t)l * 1280 * 256, 256, 1280);
        conv_job3<MAP_ID>(c, p.in[I_WOUT] + (size_t)l * 1024 * 1024, nullptr, 1024, 1024, p.in[I_GON] + l * 1024, (bf16_t*)(ws + WS_WOUT) + (size_t)l * 1024 * 1024, 1024, 1024);
    }
    if (!(skip & 8)) conv_job3<MAP_GU>(c, p.in[I_FG], p.in[I_FU], DFF, 1024, nullptr, (bf16_t*)(ws + WS_FGU), 1024, 5632);
    if (!(skip & 8)) conv_job3<MAP_ID>(c, p.in[I_FD], nullptr, 1024, DFF, nullptr, (bf16_t*)(ws + WS_FD), DFF, 1024);
    if (!(skip & 4) && !MOE_CONV_IN_ATT) for (int e = 0; e < NEXP; ++e) {
        conv_job3<MAP_GU>(c, p.in[I_MG] + (size_t)e * 1024 * DFF, p.in[I_MU] + (size_t)e * 1024 * DFF, DFF, 1024, nullptr, (bf16_t*)(ws + WS_MGU) + (size_t)e * 5632 * 1024, 1024, 5632);
        conv_job3<MAP_ID>(c, p.in[I_MD] + (size_t)e * DFF * 1024, nullptr, 1024, DFF, nullptr, (bf16_t*)(ws + WS_MD) + (size_t)e * 1024 * DFF, DFF, 1024);
    }
}

template <bool BF> DEVI f32x4 pg8_ld4(const void* base, size_t idx) {
    if constexpr (BF) { const uint2 v = *(const uint2*)((const bf16_t*)base + idx); return (f32x4){lo16(v.x), hi16(v.x), lo16(v.y), hi16(v.y)}; }
    else return *(const f32x4*)((const float*)base + idx);
}
DEVI float reduce8(const float (&lg)[8], int lane) {
    float t[4], u[2], v;
    const bool b5 = lane & 32, b4 = lane & 16, b3 = lane & 8;
#pragma unroll
    for (int e = 0; e < 4; ++e) { const float keep = b5 ? lg[e + 4] : lg[e], send = b5 ? lg[e] : lg[e + 4]; t[e] = keep + __shfl_xor(send, 32, 64); }
#pragma unroll
    for (int e = 0; e < 2; ++e) { const float keep = b4 ? t[e + 2] : t[e], send = b4 ? t[e] : t[e + 2]; u[e] = keep + __shfl_xor(send, 16, 64); }
    { const float keep = b3 ? u[1] : u[0], send = b3 ? u[0] : u[1]; v = keep + __shfl_xor(send, 8, 64); }
    v += __shfl_xor(v, 4, 64); v += __shfl_xor(v, 2, 64); v += __shfl_xor(v, 1, 64);
    return v;
}
template <bool ROUTER, bool XBF>
DEVI void phase_norm(const Ctx& c, const Params& p, const void* __restrict__ x, const float* __restrict__ gain, const float* __restrict__ sh, const float* __restrict__ sc  ) {
    bf16_t* __restrict__ h = (bf16_t*)(p.ws + WS_H);
    int* sm_e = (int*)c.sm;
    constexpr int NR = 2;
    LAS f32x4* wl = (LAS f32x4*)c.ring;
    if (ROUTER) {
        for (int e4 = c.tid; e4 < 2048; e4 += 512) {
            const int col = e4 >> 1, half = e4 & 1, ln = (col >> 2) & 63, i = col >> 8, j = col & 3;
            wl[((i * 4 + j) * 2 + half) * 64 + ln] = *(const f32x4*)(p.in[I_ROUTER] + (size_t)col * 8 + 4 * half);
        }
        __syncthreads();
    }
#pragma unroll 1
    for (int ch = c.bid; ch < MTOK / 128; ch += c.nblk) {
#pragma unroll 1
        for (int rr = 0; rr < 16; rr += NR) {
            if (ROUTER) asm volatile("" ::: "memory");
            const int rloc = c.wid * 16 + rr, row = ch * 128 + rloc, b = row / SEQ;
            f32x4 v[NR][4]; float ss[NR];
#pragma unroll
            for (int q = 0; q < NR; ++q)
#pragma unroll
                for (int i = 0; i < 4; ++i) v[q][i] = pg8_ld4<XBF>(x, (size_t)(row + q) * DM + 4 * (c.lane + 64 * i));
#pragma unroll
            for (int q = 0; q < NR; ++q) { float a = 0.f;
#pragma unroll
                for (int i = 0; i < 4; ++i) a += v[q][i][0] * v[q][i][0] + v[q][i][1] * v[q][i][1] + v[q][i][2] * v[q][i][2] + v[q][i][3] * v[q][i][3];
                ss[q] = a; }
            float rstdv[NR];
#pragma unroll
            for (int q = 0; q < NR; ++q) rstdv[q] = rsqrtf(wave_sum(ss[q]) * (1.f / DM) + EPS);
            float lg[NR][8];
#pragma unroll
            for (int q = 0; q < NR; ++q)
#pragma unroll
                for (int e = 0; e < 8; ++e) lg[q][e] = 0.f;
#pragma unroll
            for (int i = 0; i < 4; ++i) {
                const int col = 4 * (c.lane + 64 * i);
                const f32x4 g = *(const f32x4*)(gain + col), s1 = *(const f32x4*)(sc + b * 6144 + col), s0 = *(const f32x4*)(sh + b * 6144 + col);
                f32x4 o[NR];
#pragma unroll
                for (int q = 0; q < NR; ++q) {
#pragma unroll
                    for (int j = 0; j < 4; ++j) o[q][j] = v[q][i][j] * rstdv[q] * g[j] * (1.f + s1[j]) + s0[j];
                    uint2 pk; pk.x = pk2(o[q][0], o[q][1]); pk.y = pk2(o[q][2], o[q][3]);
                    *(uint2*)(h + (size_t)(row + q) * DM + col) = pk;
                }
                if (ROUTER) {
                    asm volatile("" ::: "memory");
#pragma unroll
                    for (int j = 0; j < 4; ++j) {
                        const f32x4 w0 = wl[((i * 4 + j) * 2) * 64 + c.lane], w1 = wl[((i * 4 + j) * 2 + 1) * 64 + c.lane];
#pragma unroll
                        for (int q = 0; q < NR; ++q) {
                            lg[q][0] += o[q][j] * w0[0]; lg[q][1] += o[q][j] * w0[1]; lg[q][2] += o[q][j] * w0[2]; lg[q][3] += o[q][j] * w0[3];
                            lg[q][4] += o[q][j] * w1[0]; lg[q][5] += o[q][j] * w1[1]; lg[q][6] += o[q][j] * w1[2]; lg[q][7] += o[q][j] * w1[3];
                        }
                    }
                }
            }
            if (ROUTER) {
#pragma unroll
                for (int q = 0; q < NR; ++q) {
                    const float mine = reduce8(lg[q], c.lane);
                    float l8[8];
#pragma unroll
                    for (int e = 0; e < 8; ++e) l8[e] = __builtin_bit_cast(float, __builtin_amdgcn_readlane(__builtin_bit_cast(int, mine), 8 * e));
                    int e0 = 0; float v0 = l8[0];
#pragma unroll
                    for (int e = 1; e < 8; ++e) if (l8[e] > v0) { v0 = l8[e]; e0 = e; }
                    int e1 = -1; float v1 = -3.0e38f;
#pragma unroll
                    for (int e = 0; e < 8; ++e) if (e != e0 && l8[e] > v1) { v1 = l8[e]; e1 = e; }
                    const float t = __expf(v1 - v0), w0 = 1.f / (1.f + t), w1 = t / (1.f + t);
                    if (c.lane == 0) {
                        int* te = (int*)(p.ws + WS_TOKE); float* tw = (float*)(p.ws + WS_TOKW);
                        te[(row + q) * 2] = e0; te[(row + q) * 2 + 1] = e1; tw[(row + q) * 2] = w0; tw[(row + q) * 2 + 1] = w1;
                        sm_e[rloc + q] = e0; sm_e[128 + rloc + q] = e1;
                    }
                }
            }
        }
        if (ROUTER) {
            __syncthreads();
            if (c.tid < 16) { const int s = c.tid >> 3, e = c.tid & 7; int n = 0; for (int i = 0; i < 128; ++i) n += (sm_e[s * 128 + i] == e); ((int*)(p.ws + WS_CNT))[ch * 16 + c.tid] = n; }
            __syncthreads();
        }
    }
}

struct GemmDesc {
    const bf16_t* A; int lda; const bf16_t* Bt; int ldb; int M, N, K;
    const int* rowidx;
    const int* tile_expert;
    size_t expert_stride;
    const int* ntiles;
};
template <bool DUAL, class Epi>
DEVI void gemm_simple(const Ctx& c, const GemmDesc& g, const Epi& epi) {
    const int fr = c.lane & 15, fq = c.lane >> 4;
    const int Mrows = g.ntiles ? (*g.ntiles) * 256 : g.M;
    const int ntn = DUAL ? (g.N / 256) * 4 : g.N / 64, ntm = Mrows / 32;
    const long total = (long)ntm * ntn;
    for (long u = (long)c.bid * 8 + c.wid; u < total; u += (long)c.nblk * 8) {
        const int mt = (int)(u / ntn), nt = (int)(u % ntn), row0 = mt * 32;
        const bf16_t* Bt = g.Bt;
        if (g.tile_expert) Bt += (size_t)g.tile_expert[row0 >> 8] * g.expert_stride;
        int colb[4];
        if (DUAL) { const int t = nt >> 2, s = nt & 3; colb[0] = 256 * t + 32 * s; colb[1] = colb[0] + 16; colb[2] = colb[0] + 128; colb[3] = colb[2] + 16; }
        else {
#pragma unroll
            for (int i = 0; i < 4; ++i) colb[i] = nt * 64 + 16 * i;
        }
        int r0 = row0 + fr, r1 = row0 + 16 + fr;
        if (g.rowidx) { r0 = g.rowidx[r0]; r1 = g.rowidx[r1]; r0 = r0 < 0 ? 0 : r0; r1 = r1 < 0 ? 0 : r1; }
        const bf16_t* a0 = g.A + (size_t)r0 * g.lda + fq * 8; const bf16_t* a1 = g.A + (size_t)r1 * g.lda + fq * 8;
        const bf16_t* b0 = Bt + (size_t)(colb[0] + fr) * g.ldb + fq * 8; const bf16_t* b1 = Bt + (size_t)(colb[1] + fr) * g.ldb + fq * 8;
        const bf16_t* b2 = Bt + (size_t)(colb[2] + fr) * g.ldb + fq * 8; const bf16_t* b3 = Bt + (size_t)(colb[3] + fr) * g.ldb + fq * 8;
        f32x4 acc[2][4];
#pragma unroll
        for (int m = 0; m < 2; ++m)
#pragma unroll
            for (int i = 0; i < 4; ++i) acc[m][i] = (f32x4){0.f, 0.f, 0.f, 0.f};
        for (int k = 0; k < g.K; k += 32) {
            const bf16x8 af0 = *(const bf16x8*)(a0 + k), af1 = *(const bf16x8*)(a1 + k);
            const bf16x8 bf0 = *(const bf16x8*)(b0 + k), bf1 = *(const bf16x8*)(b1 + k), bf2 = *(const bf16x8*)(b2 + k), bf3 = *(const bf16x8*)(b3 + k);
            acc[0][0] = __builtin_amdgcn_mfma_f32_16x16x32_bf16(af0, bf0, acc[0][0], 0, 0, 0);
            acc[0][1] = __builtin_amdgcn_mfma_f32_16x16x32_bf16(af0, bf1, acc[0][1], 0, 0, 0);
            acc[0][2] = __builtin_amdgcn_mfma_f32_16x16x32_bf16(af0, bf2, acc[0][2], 0, 0, 0);
            acc[0][3] = __builtin_amdgcn_mfma_f32_16x16x32_bf16(af0, bf3, acc[0][3], 0, 0, 0);
            acc[1][0] = __builtin_amdgcn_mfma_f32_16x16x32_bf16(af1, bf0, acc[1][0], 0, 0, 0);
            acc[1][1] = __builtin_amdgcn_mfma_f32_16x16x32_bf16(af1, bf1, acc[1][1], 0, 0, 0);
            acc[1][2] = __builtin_amdgcn_mfma_f32_16x16x32_bf16(af1, bf2, acc[1][2], 0, 0, 0);
            acc[1][3] = __builtin_amdgcn_mfma_f32_16x16x32_bf16(af1, bf3, acc[1][3], 0, 0, 0);
        }
#pragma unroll
        for (int m = 0; m < 2; ++m)
#pragma unroll
            for (int r = 0; r < 4; ++r) {
                const int row = row0 + 16 * m + 4 * fq + r;
                if (DUAL) {
                    const int t = nt >> 2, s = nt & 3, j0 = 128 * t + 32 * s + fr;
                    epi(row, j0, acc[m][0][r], acc[m][2][r]);
                    epi(row, j0 + 16, acc[m][1][r], acc[m][3][r]);
                } else {
#pragma unroll
                    for (int i = 0; i < 4; ++i) epi(row, colb[i] + fr, acc[m][i][r], 0.f);
                }
            }
    }
}

struct EpiStoreBf16 { bf16_t* O; int ldo; DEVI void operator()(int row, int col, float v, float) const { O[(size_t)row * ldo + col] = f2bf(v); } };
struct EpiResid {
    const float* xin; float* out; const float* gate;
    DEVI void operator()(int row, int col, float v, float) const { const int b = row / SEQ; out[(size_t)row * DM + col] = xin[(size_t)row * DM + col] + gate[b * 6144 + col] * v; }
};
struct EpiSwiglu { bf16_t* H; DEVI void operator()(int row, int j, float g, float u) const { H[(size_t)row * DFF + j] = f2bf(g / (1.f + __expf(-g)) * u); } };
struct EpiMoeDown {
    float* out; const float* gate; const int* perm; const float* permw;
    DEVI void operator()(int pos, int col, float v, float) const {
        const int tok = perm[pos]; if (tok < 0) return;
        const int b = tok / SEQ; out[(size_t)tok * DM + col] += gate[b * 6144 + col] * permw[pos] * v;
    }
};


namespace pg8 {
typedef unsigned u32x4 __attribute__((ext_vector_type(4)));
constexpr int BM = 256, BK = 64, HALF = 128, HTB = HALF * BK * 2, STAGE_BYTES = 8 * HTB, NXCD = 8, WGM = 8;
__host__ __device__ __forceinline__ int lds_byte(int r, int c) { const int st = (r >> 4) * 2 + (c >> 5), rr = r & 15, cc = c & 31, ob = rr * 64 + cc * 2; return st * 1024 + (ob ^ (((ob >> 9) & 1) << 5)); }
__host__ __device__ __forceinline__ void stage_rc(int b, int& R, int& C) { const int st = b / 1024, sb = b % 1024, swz = sb ^ (((sb >> 9) & 1) << 5); R = (st >> 1) * 16 + swz / 64; C = (st & 1) * 32 + (swz % 64) / 2; }
__host__ __device__ __forceinline__ int perm32(int rho) { const int n = rho >> 4, i = rho & 15; return 8 * (i >> 2) + 4 * n + (i & 3); }
struct Unit { int pm, pn, ks; };
struct StaticOrder {
    int nM, nN, nwg, G, c;
    __device__ void init(int nM_, int nN_, int G_, int c_) { nM = nM_; nN = nN_; nwg = nM * nN; G = G_; c = c_; }
    __device__ bool next(int i, Unit& u) const { return unit_of((long)i * G + c, u); }
    __device__ bool unit_of(long L, Unit& u) const {
        if (L >= nwg) return false;
        int wgid = (int)L; { const int q = nwg / NXCD, r = nwg % NXCD, xcd = wgid % NXCD, off = wgid / NXCD; wgid = (xcd < r ? xcd * (q + 1) : r * (q + 1) + (xcd - r) * q) + off; }
        const int nig = WGM * nN, gid = wgid / nig, fm = gid * WGM, gsz = (nM - fm) < WGM ? (nM - fm) : WGM;
        u.pm = fm + ((wgid % nig) % gsz); u.pn = (wgid % nig) / gsz; u.ks = 0; return true;
    }
};
DEVI unsigned cvt_pk_bf16(float lo, float hi) { unsigned r; asm volatile("v_cvt_pk_bf16_f32 %0, %1, %2" : "=v"(r) : "v"(lo), "v"(hi)); return r; }

struct NoRowScale { static constexpr bool ON = false; DEVI void load(int, int, int, int, float (&)[8]) const {} };
struct GroupRowScale {
    static constexpr bool ON = true; const float* rat;
    DEVI void load(int pm, int wr, int fr, int sel, float (&f)[8]) const {
#pragma unroll
        for (int ai = 0; ai < 2; ++ai)
#pragma unroll
            for (int m = 0; m < 4; ++m) f[ai * 4 + m] = rat[(unsigned)((pm * BM + ai * HALF + wr * 64 + m * 16 + fr) * 4 + sel)];
    }
};
template <class Epi, class Prob, bool GATHER = false, bool ALIGN_EPI = true, class RS = NoRowScale>
DEVI void gemm_phase(LAS unsigned char* lds, const Prob& P, const Epi& E, int tid_in, const RS& rs = RS()) {
    const int tid = tid_in, wid = __builtin_amdgcn_readfirstlane(tid >> 6), lane = tid & 63, wr = wid >> 2, wc = wid & 3, fr = lane & 15, fq = lane >> 4;
    int nt = P.nt_of_first();
    int RA[2], CA[2];
    unsigned voffA[2], voffB[2];
#pragma unroll
    for (int i = 0; i < 2; ++i) { int R, C; stage_rc(tid * 16 + i * 8192, R, C); const int Rb = Epi::PERM ? ((R & ~31) + perm32(R & 31)) : R;
        RA[i] = R; CA[i] = C; voffA[i] = (unsigned)(R * P.lda + C) * 2u; voffB[i] = (unsigned)(Rb * P.ldb + C) * 2u; }
    const size_t kstep = (size_t)(BK * 2);
    const size_t hstepA = (size_t)HALF * P.lda * 2, hstepB = (size_t)HALF * P.ldb * 2;
    const unsigned ldsw = (unsigned)wid * 1024u;
    const int aoff = lds_byte(wr * 64 + fr, fq * 8), boff = lds_byte(wc * 32 + fr, fq * 8);
#define PG8_SA(b, h) (((b) * 2 + (h)) * HTB)
#define PG8_SB(b, h) ((4 + (b) * 2 + (h)) * HTB)
#define PG8_STAGE(bufoff, gbase, voff) do { _Pragma("unroll") for (int _i = 0; _i < 2; ++_i) \
        __builtin_amdgcn_global_load_lds((const unsigned*)((const char*)(gbase) + (voff)[_i]), (LAS unsigned*)(lds + (bufoff) + ldsw + _i * 8192), 16, 0, 0); } while (0)
#define PG8_LDA(dst, b, h) do { _Pragma("unroll") for (int m = 0; m < 4; ++m) _Pragma("unroll") for (int k = 0; k < 2; ++k) dst[m][k] = *(const LAS bf16x8*)(lds + PG8_SA(b, h) + aoff + m * 2048 + k * 1024); } while (0)
#define PG8_LDB(dst, b, h) do { _Pragma("unroll") for (int n = 0; n < 2; ++n) _Pragma("unroll") for (int k = 0; k < 2; ++k) dst[n][k] = *(const LAS bf16x8*)(lds + PG8_SB(b, h) + boff + n * 2048 + k * 1024); } while (0)
#define PG8_MMA(ai, bj, At, Bt) do { __builtin_amdgcn_s_setprio(1); _Pragma("unroll") for (int m = 0; m < 4; ++m) _Pragma("unroll") for (int n = 0; n < 2; ++n) _Pragma("unroll") for (int k = 0; k < 2; ++k) \
        acc[ai][bj][m][n] = __builtin_amdgcn_mfma_f32_16x16x32_bf16(Bt[n][k], At[m][k], acc[ai][bj][m][n], 0, 0, 0); __builtin_amdgcn_s_setprio(0); } while (0)
#define PG8_WAIT_V(n) asm volatile("s_waitcnt vmcnt(" #n ")" ::: "memory")
#define PG8_WAIT_L(n) asm volatile("s_waitcnt lgkmcnt(" #n ")" ::: "memory")
#define PG8_BAR __builtin_amdgcn_s_barrier()
#define PG8_SCHED __builtin_amdgcn_sched_barrier(0)
#define PG8_STAGE_A(bufoff, ptr, h, vG) do { if constexpr (GATHER) PG8_STAGE(bufoff, ptr, vG[h]); else PG8_STAGE(bufoff, (ptr) + (h) * hstepA, voffA); } while (0)
    Unit cur, nxt; int ui = 0;
    if (!P.next(0, cur)) return;
    f32x4 acc[2][2][4][2];
#pragma unroll
    for (int a = 0; a < 2; ++a)
#pragma unroll
        for (int b = 0; b < 2; ++b)
#pragma unroll
            for (int m = 0; m < 4; ++m)
#pragma unroll
                for (int n = 0; n < 2; ++n) acc[a][b][m][n] = (f32x4){0.f, 0.f, 0.f, 0.f};
    bf16x8 At[4][2], B0[2][2], B1[2][2];
    unsigned vAc[2][2] = {{0u, 0u}, {0u, 0u}}, vAn[2][2] = {{0u, 0u}, {0u, 0u}};
#define PG8_RSCALE(arr) do { _Pragma("unroll") for (int a_ = 0; a_ < 2; ++a_) _Pragma("unroll") for (int m_ = 0; m_ < 4; ++m_) _Pragma("unroll") for (int b_ = 0; b_ < 2; ++b_) _Pragma("unroll") for (int n_ = 0; n_ < 2; ++n_) acc[a_][b_][m_][n_] *= arr[a_ * 4 + m_]; } while (0)
    const char* cA; const char* cB = P.b_tile(cur);
    if constexpr (GATHER) { cA = P.a_base();
#pragma unroll
        for (int h = 0; h < 2; ++h)
#pragma unroll
            for (int i = 0; i < 2; ++i) vAc[h][i] = P.a_rowoff(0, h * HALF + RA[i]) + (unsigned)CA[i] * 2u;
    } else { cA = P.a_tile(cur); }
    PG8_STAGE(PG8_SB(0, 0), cB, voffB); PG8_STAGE(PG8_SB(0, 1), cB + hstepB, voffB); PG8_STAGE_A(PG8_SA(0, 0), cA, 0, vAc); PG8_STAGE_A(PG8_SA(0, 1), cA, 1, vAc);
    if (wr == 1) PG8_BAR;
    PG8_WAIT_V(2); PG8_BAR;
    PG8_STAGE(PG8_SB(1, 0), cB + kstep, voffB); PG8_STAGE_A(PG8_SA(1, 0), cA + kstep, 0, vAc); PG8_STAGE(PG8_SB(1, 1), cB + hstepB + kstep, voffB);
    PG8_WAIT_V(6); PG8_BAR;
    for (;;) {
        const bool has_next = P.next(ui + 1, nxt);
        nt = P.nt_of(cur);
        const char* nA; const char* nB = has_next ? P.b_tile(nxt) : cB;
        if constexpr (GATHER) { nA = cA;
#pragma unroll
            for (int h = 0; h < 2; ++h)
#pragma unroll
                for (int i = 0; i < 2; ++i) vAn[h][i] = has_next ? P.a_rowoff(ui + 1, h * HALF + RA[i]) + (unsigned)CA[i] * 2u : vAc[h][i];
        } else { nA = has_next ? P.a_tile(nxt) : cA; }
        for (int t = 0; t < nt; t += 2) {
            const bool last = (t == nt - 2);
            if constexpr (RS::ON) { if (t == 4 || t == 12) { float rsf[8]; rs.load(cur.pm, wr, fr, t == 4 ? 0 : 1, rsf); PG8_RSCALE(rsf); } }
            const char* a1 = cA + (size_t)(t + 1) * kstep;
            const char* a2 = last ? nA : cA + (size_t)(t + 2) * kstep; const char* b2 = last ? nB : cB + (size_t)(t + 2) * kstep;
            const char* a3 = a2 + kstep; const char* b3 = b2 + kstep;
            unsigned vA2[2][2];
#pragma unroll
            for (int h = 0; h < 2; ++h)
#pragma unroll
                for (int i = 0; i < 2; ++i) vA2[h][i] = (GATHER && last) ? vAn[h][i] : vAc[h][i];
            PG8_LDB(B0, 0, 0); PG8_LDB(B1, 0, 1); PG8_SCHED; PG8_LDA(At, 0, 0); PG8_STAGE_A(PG8_SA(1, 1), a1, 1, vAc);
            PG8_WAIT_V(8); PG8_WAIT_L(0); PG8_BAR; PG8_MMA(0, 0, At, B0); PG8_MMA(0, 1, At, B1); PG8_BAR; PG8_SCHED;
            PG8_LDA(At, 0, 1); PG8_STAGE(PG8_SB(0, 0), b2, voffB); PG8_STAGE(PG8_SB(0, 1), b2 + hstepB, voffB); PG8_STAGE_A(PG8_SA(0, 0), a2, 0, vA2);
            PG8_WAIT_V(8); PG8_WAIT_L(0); PG8_BAR; PG8_MMA(1, 0, At, B0); PG8_MMA(1, 1, At, B1); PG8_BAR; PG8_SCHED;
            PG8_LDB(B0, 1, 0); PG8_LDB(B1, 1, 1); PG8_SCHED; PG8_LDA(At, 1, 0); PG8_STAGE_A(PG8_SA(0, 1), a2, 1, vA2);
            PG8_WAIT_V(8); PG8_WAIT_L(0); PG8_BAR; PG8_MMA(0, 0, At, B0); PG8_MMA(0, 1, At, B1); PG8_BAR; PG8_SCHED;
            PG8_LDA(At, 1, 1); PG8_STAGE(PG8_SB(1, 0), b3, voffB); PG8_STAGE(PG8_SB(1, 1), b3 + hstepB, voffB); PG8_STAGE_A(PG8_SA(1, 0), a3, 0, vA2);
            PG8_WAIT_V(8); PG8_WAIT_L(0); PG8_BAR; PG8_MMA(1, 0, At, B0); PG8_MMA(1, 1, At, B1); PG8_BAR; PG8_SCHED;
        }
        if constexpr (ALIGN_EPI) { if (wr == 0) PG8_BAR; }
        if constexpr (RS::ON) { float rsf[8]; rs.load(cur.pm, wr, fr, 2, rsf); PG8_RSCALE(rsf); }
        E(acc, cur, wr, wc, fr, fq);
        if (!has_next) break;
#pragma unroll
        for (int a = 0; a < 2; ++a)
#pragma unroll
            for (int b = 0; b < 2; ++b)
#pragma unroll
                for (int m = 0; m < 4; ++m)
#pragma unroll
                    for (int n = 0; n < 2; ++n) acc[a][b][m][n] = (f32x4){0.f, 0.f, 0.f, 0.f};
        cur = nxt; cA = nA; cB = nB; ++ui;
        if constexpr (GATHER) {
#pragma unroll
            for (int h = 0; h < 2; ++h)
#pragma unroll
                for (int i = 0; i < 2; ++i) vAc[h][i] = vAn[h][i];
        }
        if constexpr (ALIGN_EPI) { if (wr == 1) PG8_BAR; }
    }
    PG8_WAIT_V(0);
    if constexpr (!ALIGN_EPI) { if (wr == 0) PG8_BAR; }
    PG8_BAR;
#undef PG8_SA
#undef PG8_RSCALE
#undef PG8_SB
#undef PG8_STAGE
#undef PG8_STAGE_A
#undef PG8_LDA
#undef PG8_LDB
#undef PG8_MMA
#undef PG8_WAIT_V
#undef PG8_WAIT_L
#undef PG8_BAR
#undef PG8_SCHED
}

typedef f32x4 Acc[2][2][4][2];
struct EpiStoreT {
    static constexpr bool PERM = true;
    bf16_t* O; int ldc; bf16_t* O2; int ldc2; int split_pn;
    DEVI void operator()(const Acc& acc, const Unit& u, int wr, int wc, int fr, int fq) const {
        const int row0 = u.pm * BM + wr * 64 + fr;
        bf16_t* base = O; int ld = ldc, pn = u.pn;
        if (pn >= split_pn) { base = O2; ld = ldc2; pn -= split_pn; }
        const int col0 = pn * BM + wc * 32 + 8 * fq;
#pragma unroll
        for (int ai = 0; ai < 2; ++ai)
#pragma unroll
            for (int m = 0; m < 4; ++m) { bf16_t* rowp = base + (size_t)(row0 + ai * HALF + m * 16) * ld + col0;
#pragma unroll
                for (int bj = 0; bj < 2; ++bj) { const f32x4 v0 = acc[ai][bj][m][0], v1 = acc[ai][bj][m][1];
                    u32x4 w; w.x = cvt_pk_bf16(v0[0], v0[1]); w.y = cvt_pk_bf16(v0[2], v0[3]); w.z = cvt_pk_bf16(v1[0], v1[1]); w.w = cvt_pk_bf16(v1[2], v1[3]);
                    *(u32x4*)(rowp + bj * HALF) = w; } }
    }
};
struct F8 { f32x4 lo, hi; };
template <bool BF> DEVI F8 ld8(const void* base, size_t idx) {
    F8 r;
    if constexpr (BF) { const u32x4 v = *(const u32x4*)((const bf16_t*)base + idx); r.lo = (f32x4){lo16(v.x), hi16(v.x), lo16(v.y), hi16(v.y)}; r.hi = (f32x4){lo16(v.z), hi16(v.z), lo16(v.w), hi16(v.w)}; }
    else { r.lo = *(const f32x4*)((const float*)base + idx); r.hi = *(const f32x4*)((const float*)base + idx + 4); }
    return r;
}
template <bool BF> DEVI void st8(void* base, size_t idx, const f32x4& lo, const f32x4& hi) {
    if constexpr (BF) { u32x4 o; o.x = cvt_pk_bf16(lo[0], lo[1]); o.y = cvt_pk_bf16(lo[2], lo[3]); o.z = cvt_pk_bf16(hi[0], hi[1]); o.w = cvt_pk_bf16(hi[2], hi[3]); *(u32x4*)((bf16_t*)base + idx) = o; }
    else { *(f32x4*)((float*)base + idx) = lo; *(f32x4*)((float*)base + idx + 4) = hi; }
}
template <bool XBF, bool OBF>
struct EpiResidT {
    static constexpr bool PERM = true;
    const void* xin; void* out; const float* gate;
    DEVI void operator()(const Acc& acc, const Unit& u, int wr, int wc, int fr, int fq) const {
        const int row0 = u.pm * BM + wr * 64 + fr, col0 = u.pn * BM + wc * 32 + 8 * fq, b = (u.pm * BM) / SEQ;
        const float* gp = gate + b * 6144 + col0;
#pragma unroll
        for (int bj = 0; bj < 2; ++bj) {
            const f32x4 g0 = *(const f32x4*)(gp + bj * HALF), g1 = *(const f32x4*)(gp + bj * HALF + 4);
            constexpr int RB = XBF ? 4 : 2;
#pragma unroll
            for (int ai = 0; ai < 2; ++ai)
#pragma unroll
                for (int m0 = 0; m0 < 4; m0 += RB) {
                    F8 xv[RB];
#pragma unroll
                    for (int m = 0; m < RB; ++m) xv[m] = ld8<XBF>(xin, (size_t)(row0 + ai * HALF + (m0 + m) * 16) * DM + col0 + bj * HALF);
                    asm volatile("" ::: "memory");
#pragma unroll
                    for (int m = 0; m < RB; ++m) st8<OBF>(out, (size_t)(row0 + ai * HALF + (m0 + m) * 16) * DM + col0 + bj * HALF, xv[m].lo + g0 * acc[ai][bj][m0 + m][0], xv[m].hi + g1 * acc[ai][bj][m0 + m][1]);
                    asm volatile("" ::: "memory");
                }
        }
    }
};
struct EpiSwigluT {
    static constexpr bool PERM = true;
    bf16_t* H; int pm_wrap = 1 << 30, pm_shift = 0;
    DEVI void operator()(const Acc& acc, const Unit& u, int wr, int wc, int fr, int fq) const {
        const int row0 = (u.pm >= pm_wrap ? u.pm + pm_shift : u.pm) * BM + wr * 64 + fr, j0 = u.pn * HALF + wc * 32 + 8 * fq;
#pragma unroll
        for (int ai = 0; ai < 2; ++ai)
#pragma unroll
            for (int m = 0; m < 4; ++m) {
                float hv[8];
#pragma unroll
                for (int n = 0; n < 2; ++n)
#pragma unroll
                    for (int i = 0; i < 4; ++i) { const float g = acc[ai][0][m][n][i], up = acc[ai][1][m][n][i]; hv[4 * n + i] = g * __builtin_amdgcn_rcpf(1.f + __expf(-g)) * up; }
                u32x4 w; w.x = cvt_pk_bf16(hv[0], hv[1]); w.y = cvt_pk_bf16(hv[2], hv[3]); w.z = cvt_pk_bf16(hv[4], hv[5]); w.w = cvt_pk_bf16(hv[6], hv[7]);
                *(u32x4*)(H + (size_t)(row0 + ai * HALF + m * 16) * DFF + j0) = w;
            }
    }
};
template <bool OBF>
struct EpiMoeDownT {
    static constexpr bool PERM = true;
    const void* xin; void* out; const float* gate; const int* perm; const float* permw;
    DEVI void operator()(const Acc& acc, const Unit& u, int wr, int wc, int fr, int fq) const {
        const int pos0 = u.pm * BM + wr * 64 + fr, col0 = u.pn * BM + wc * 32 + 8 * fq;
        int tk[8]; float wv[8];
#pragma unroll
        for (int r = 0; r < 8; ++r) { const int pos = pos0 + (r >> 2) * HALF + (r & 3) * 16; tk[r] = perm[pos]; wv[r] = permw[pos]; }
#pragma unroll
        for (int r = 0; r < 8; ++r) {
            const int tok = tk[r];
            if (tok >= 0) { const float w = wv[r]; const float* gp = gate + (tok / SEQ) * 6144 + col0; const size_t ro = (size_t)tok * DM + col0;
                F8 xv[2]; f32x4 gv[2][2];
#pragma unroll
                for (int bj = 0; bj < 2; ++bj) { xv[bj] = ld8<true>(xin, ro + bj * HALF); gv[bj][0] = *(const f32x4*)(gp + bj * HALF); gv[bj][1] = *(const f32x4*)(gp + bj * HALF + 4); }
                asm volatile("" ::: "memory");
#pragma unroll
                for (int bj = 0; bj < 2; ++bj) st8<OBF>(out, ro + bj * HALF, xv[bj].lo + gv[bj][0] * w * acc[r >> 2][bj][r & 3][0], xv[bj].hi + gv[bj][1] * w * acc[r >> 2][bj][r & 3][1]);
            }
        }
    }
};

struct ProbPlain {
    static constexpr bool dummy = false;
    const bf16_t* A; const bf16_t* Bt; int lda, ldb, K; StaticOrder S;
    DEVI int nt_of(const Unit&) const { return K / BK; }
    DEVI int nt_of_first() const { return K / BK; }
    DEVI bool next(int i, Unit& u) const { return S.next(i, u); }
    DEVI const char* a_tile(const Unit& u) const { return (const char*)(A + (size_t)u.pm * BM * lda); }
    DEVI const char* b_tile(const Unit& u) const { return (const char*)(Bt + (size_t)u.pn * BM * ldb); }
    DEVI const char* a_base() const { return (const char*)A; }
    DEVI unsigned a_rowoff(int, int) const { return 0u; }
};
struct ProbUp {
    const bf16_t* A1; const bf16_t* A2; const bf16_t* B1; const bf16_t* B2; int lda, ldb, K; StaticOrder S;
    DEVI int nt_of(const Unit& u) const { return u.pn < 3 ? 4 : 2; }
    DEVI int nt_of_first() const { return 4; }
    DEVI bool next(int i, Unit& u) const { return S.next(i, u); }
    DEVI const char* a_tile(const Unit& u) const { return (const char*)((u.pn < 3 ? A1 : A2) + (size_t)u.pm * BM * lda); }
    DEVI const char* b_tile(const Unit& u) const { return (const char*)(u.pn < 3 ? B1 + (size_t)u.pn * BM * ldb : B2 + (size_t)(u.pn - 3) * BM * ldb); }
    DEVI const char* a_base() const { return (const char*)A1; }
    DEVI unsigned a_rowoff(int, int) const { return 0u; }
};
struct SkipOrder {
    StaticOrder base; int nskip, R, m, pmx0;
    DEVI bool next(int i, Unit& u) const {
        const int c = base.c, G = base.G, Gs = G - nskip; const bool lo = c >= Gs; const int round = i + (lo ? R : 0);
        const long L = (round < R) ? (long)round * Gs + c : (long)R * Gs + (long)(round - R) * G + c;
        if (base.unit_of(L, u)) return true;
        const int rounds = (base.nwg + G - 1) / G, x = c - (base.nwg - (rounds - 1) * G);
        if (i != rounds - 1 || x < 0 || x >= 22 * m) return false;
        u.pm = pmx0 + x % m; u.pn = x / m; u.ks = 0; return true;
    }
};
struct OneUnit { int pm, pn; DEVI bool next(int i, Unit& u) const { if (i != 0) return false; u.pm = pm; u.pn = pn; u.ks = 0; return true; } };
template <class Ord>
struct ProbMoeT {
    const bf16_t* A; const bf16_t* Bt; int lda, ldb, K; Ord S; const int* texp; size_t estride; const LAS unsigned* tab; int pm_off;
    DEVI int nt_of(const Unit&) const { return K / BK; }
    DEVI int nt_of_first() const { return K / BK; }
    DEVI bool next(int i, Unit& u) const { if (!S.next(i, u)) return false; u.pm += pm_off; return true; }
    DEVI const char* a_tile(const Unit& u) const { return (const char*)(A + (size_t)u.pm * BM * lda); }
    DEVI const char* b_tile(const Unit& u) const { return (const char*)(Bt + (size_t)texp[u.pm] * estride + (size_t)u.pn * BM * ldb); }
    DEVI const char* a_base() const { return (const char*)A; }
    DEVI unsigned a_rowoff(int ui, int r) const { return tab[ui * 256 + r]; }
};

struct ProbSplitK4 {
    const bf16_t* A; const bf16_t* Bt; int lda, ldb, K; const int* texp; size_t estride; int nsub, G, c;
    DEVI int nt_of(const Unit& u) const { return u.ks < 2 ? 12 : 10; }
    DEVI int nt_of_first() const { return 12; }
    DEVI static int k0_of(int ks) { return 64 * (ks < 2 ? 12 * ks : 24 + 10 * (ks - 2)); }
    DEVI bool next(int i, Unit& u) const { const long L = (long)i * G + c; if (L >= nsub) return false; const int l = (int)L; u.ks = l & 3; u.pn = (l >> 2) & 3; u.pm = l >> 4; return true; }
    DEVI const char* a_tile(const Unit& u) const { return (const char*)(A + (size_t)u.pm * BM * lda + k0_of(u.ks)); }
    DEVI const char* b_tile(const Unit& u) const { return (const char*)(Bt + (size_t)texp[u.pm] * estride + (size_t)u.pn * BM * ldb + k0_of(u.ks)); }
    DEVI const char* a_base() const { return (const char*)A; }
    DEVI unsigned a_rowoff(int, int) const { return 0u; }
};
struct EpiPartialT {
    static constexpr bool PERM = true;
    float* part; int rows;
    DEVI void operator()(const Acc& acc, const Unit& u, int wr, int wc, int fr, int fq) const {
        const int pos0 = u.pm * BM + wr * 64 + fr, col0 = u.pn * BM + wc * 32 + 8 * fq;
        float* base = part + (size_t)u.ks * rows * DM;
#pragma unroll
        for (int ai = 0; ai < 2; ++ai)
#pragma unroll
            for (int m = 0; m < 4; ++m)
#pragma unroll
                for (int bj = 0; bj < 2; ++bj) st8<false>(base, (size_t)(pos0 + ai * HALF + m * 16) * DM + col0 + bj * HALF, acc[ai][bj][m][0], acc[ai][bj][m][1]);
    }
};
}


namespace att {
#define ATT_WRITE_SS (!(PF & 16))
typedef float f32x16 __attribute__((ext_vector_type(16)));
typedef short s16x4 __attribute__((ext_vector_type(4)));
constexpr int LK0 = 0, LK1 = 13312, LV0 = 26624, LV1 = 34816, LBIAS = 43008, LFLAG = 44544, LUNIT = 44672  ;
constexpr float L2E = 1.4426950408889634f;
enum { T_MLA = 0, T_SB = 1, T_CK = 2 };

template <int DK> struct TileRegs { pg8::u32x4 k0, k1, v; };
template <int DK> DEVI void tile_load(TileRegs<DK>& r, const bf16_t* Kg, int pitchK, const bf16_t* Vg, int pitchV, int key0, int tid) {
    constexpr int CPR = DK / 8;
    { const int row = tid / CPR, cc = tid % CPR; r.k0 = *(const pg8::u32x4*)(Kg + (size_t)(key0 + row) * pitchK + cc * 8); }
    if (DK == 96 && tid < 256) { const int ch = tid + 512, row = ch / CPR, cc = ch % CPR; r.k1 = *(const pg8::u32x4*)(Kg + (size_t)(key0 + row) * pitchK + cc * 8); }
    { const int row = tid >> 3, cc = tid & 7; r.v = *(const pg8::u32x4*)(Vg + (size_t)(key0 + row) * pitchV + cc * 8); }
}
template <int DK> DEVI void tile_store(const TileRegs<DK>& r, LAS unsigned char* kb, LAS unsigned char* vb, int tid) {
    constexpr int CPR = DK / 8, PITCH = DK * 2 + 16;
    { const int row = tid / CPR, cc = tid % CPR; *(LAS pg8::u32x4*)(kb + row * PITCH + cc * 16) = r.k0; }
    if (DK == 96 && tid < 256) { const int ch = tid + 512, row = ch / CPR, cc = ch % CPR; *(LAS pg8::u32x4*)(kb + row * PITCH + cc * 16) = r.k1; }
    { const int row = tid >> 3, cc = tid & 7; *(LAS pg8::u32x4*)(vb + (cc >> 2) * 4096 + row * 64 + (cc & 3) * 16) = r.v; }
}
template <int DK> DEVI void loadK(TileRegs<DK>& r, const bf16_t* Kg, int pitchK, int key0, int tid) {
    constexpr int CPR = DK / 8;
    { const int row = tid / CPR, cc = tid % CPR; r.k0 = *(const pg8::u32x4*)(Kg + (size_t)(key0 + row) * pitchK + cc * 8); }
    if (DK == 96 && tid < 256) { const int ch = tid + 512, row = ch / CPR, cc = ch % CPR; r.k1 = *(const pg8::u32x4*)(Kg + (size_t)(key0 + row) * pitchK + cc * 8); }
}
template <int DK> DEVI void loadV(TileRegs<DK>& r, const bf16_t* Vg, int pitchV, int key0, int tid) {
    const int row = tid >> 3, cc = tid & 7; r.v = *(const pg8::u32x4*)(Vg + (size_t)(key0 + row) * pitchV + cc * 8);
}
template <int DK> DEVI void storeK(const TileRegs<DK>& r, LAS unsigned char* kb, int tid) {
    constexpr int CPR = DK / 8, PITCH = DK * 2 + 16;
    { const int row = tid / CPR, cc = tid % CPR; *(LAS pg8::u32x4*)(kb + row * PITCH + cc * 16) = r.k0; }
    if (DK == 96 && tid < 256) { const int ch = tid + 512, row = ch / CPR, cc = ch % CPR; *(LAS pg8::u32x4*)(kb + row * PITCH + cc * 16) = r.k1; }
}
template <int DK> DEVI void storeV(const TileRegs<DK>& r, LAS unsigned char* vb, int tid) {
    const int row = tid >> 3, cc = tid & 7; *(LAS pg8::u32x4*)(vb + (cc >> 2) * 4096 + row * 64 + (cc & 3) * 16) = r.v;
}
DEVI void xswap32(unsigned& a, unsigned& b) { asm volatile("s_nop 1\n\tv_permlane32_swap_b32 %0, %1" : "+v"(a), "+v"(b)); }
DEVI float xhalf_max(float v) { unsigned a = __builtin_bit_cast(unsigned, v), b = a; xswap32(a, b); return fmaxf(__builtin_bit_cast(float, a), __builtin_bit_cast(float, b)); }
DEVI float xhalf_sum(float v) { unsigned a = __builtin_bit_cast(unsigned, v), b = a; xswap32(a, b); return __builtin_bit_cast(float, a) + __builtin_bit_cast(float, b); }
template <int DK> DEVI void qk_tile(f32x16& s0, f32x16& s1, const LAS unsigned char* kb, const bf16x8 (&qf)[DK / 16], int r32, int h) {
    constexpr int PITCH = DK * 2 + 16, NS = DK / 16;
    const LAS unsigned char* k0 = kb + r32 * PITCH + h * 16;
    bf16x8 a0[NS], a1[NS];
#pragma unroll
    for (int st = 0; st < NS; ++st) { a0[st] = *(const LAS bf16x8*)(k0 + st * 32); a1[st] = *(const LAS bf16x8*)(k0 + 32 * PITCH + st * 32); }
#pragma unroll
    for (int i = 0; i < 16; ++i) { s0[i] = 0.f; s1[i] = 0.f; }
    __builtin_amdgcn_sched_barrier(0);
#pragma unroll
    for (int st = 0; st < NS; ++st) {
        s0 = __builtin_amdgcn_mfma_f32_32x32x16_bf16(a0[st], qf[st], s0, 0, 0, 0);
        s1 = __builtin_amdgcn_mfma_f32_32x32x16_bf16(a1[st], qf[st], s1, 0, 0, 0);
    }
    __builtin_amdgcn_sched_barrier(0);
}
DEVI s16x4 vtr(const LAS unsigned char* p) { return __builtin_bit_cast(s16x4, __builtin_amdgcn_ds_read_tr16_b64_v4i16((LAS s16x4*)p)); }
DEVI void pv_tile(f32x16 (&o)[2], const LAS unsigned char* vlane, const bf16x8 (&pf)[4]) {
#pragma unroll
    for (int db = 0; db < 2; ++db) {
        s16x4 lo[4], hi[4];
#pragma unroll
        for (int ks = 0; ks < 4; ++ks) { lo[ks] = vtr(vlane + db * 4096 + ks * 1024); hi[ks] = vtr(vlane + db * 4096 + ks * 1024 + 512); }
        __builtin_amdgcn_sched_barrier(0);
#pragma unroll
        for (int ks = 0; ks < 4; ++ks) {
            const bf16x8 a = (bf16x8){lo[ks][0], lo[ks][1], lo[ks][2], lo[ks][3], hi[ks][0], hi[ks][1], hi[ks][2], hi[ks][3]};
            o[db] = __builtin_amdgcn_mfma_f32_32x32x16_bf16(a, pf[ks], o[db], 0, 0, 0);
        }
        __builtin_amdgcn_sched_barrier(0);
    }
}

template <int DK> DEVI void seg1_fused(f32x16& s0, f32x16& s1, f32x16 (&o)[2], const LAS unsigned char* kb, const LAS unsigned char* vlane, const bf16x8 (&qf)[DK / 16], const bf16x8 (&pf)[4], int r32, int h) {
    constexpr int PITCH = DK * 2 + 16, NS = DK / 16, NH = NS / 2;
    const LAS unsigned char* k0 = kb + r32 * PITCH + h * 16;
    s16x4 lo0[4], hi0[4], lo1[4], hi1[4];
    bf16x8 ka0[NH], ka1[NH], kb0[NH], kb1[NH];
#pragma unroll
    for (int ks = 0; ks < 4; ++ks) { lo0[ks] = vtr(vlane + ks * 1024); hi0[ks] = vtr(vlane + ks * 1024 + 512); }
#pragma unroll
    for (int st = 0; st < NH; ++st) { ka0[st] = *(const LAS bf16x8*)(k0 + st * 32); ka1[st] = *(const LAS bf16x8*)(k0 + 32 * PITCH + st * 32); }
#pragma unroll
    for (int i = 0; i < 16; ++i) { s0[i] = 0.f; s1[i] = 0.f; }
    __builtin_amdgcn_sched_barrier(0);
#pragma unroll
    for (int ks = 0; ks < 4; ++ks) {
        const bf16x8 a = (bf16x8){lo0[ks][0], lo0[ks][1], lo0[ks][2], lo0[ks][3], hi0[ks][0], hi0[ks][1], hi0[ks][2], hi0[ks][3]};
        o[0] = __builtin_amdgcn_mfma_f32_32x32x16_bf16(a, pf[ks], o[0], 0, 0, 0);
    }
#pragma unroll
    for (int ks = 0; ks < 4; ++ks) { lo1[ks] = vtr(vlane + 4096 + ks * 1024); hi1[ks] = vtr(vlane + 4096 + ks * 1024 + 512); }
    __builtin_amdgcn_sched_barrier(0);
#pragma unroll
    for (int st = 0; st < NH; ++st) {
        s0 = __builtin_amdgcn_mfma_f32_32x32x16_bf16(ka0[st], qf[st], s0, 0, 0, 0);
        s1 = __builtin_amdgcn_mfma_f32_32x32x16_bf16(ka1[st], qf[st], s1, 0, 0, 0);
    }
#pragma unroll
    for (int st = 0; st < NH; ++st) { kb0[st] = *(const LAS bf16x8*)(k0 + (NH + st) * 32); kb1[st] = *(const LAS bf16x8*)(k0 + 32 * PITCH + (NH + st) * 32); }
    __builtin_amdgcn_sched_barrier(0);
#pragma unroll
    for (int ks = 0; ks < 4; ++ks) {
        const bf16x8 a = (bf16x8){lo1[ks][0], lo1[ks][1], lo1[ks][2], lo1[ks][3], hi1[ks][0], hi1[ks][1], hi1[ks][2], hi1[ks][3]};
        o[1] = __builtin_amdgcn_mfma_f32_32x32x16_bf16(a, pf[ks], o[1], 0, 0, 0);
    }
    __builtin_amdgcn_sched_barrier(0);
#pragma unroll
    for (int st = 0; st < NH; ++st) {
        s0 = __builtin_amdgcn_mfma_f32_32x32x16_bf16(kb0[st], qf[NH + st], s0, 0, 0, 0);
        s1 = __builtin_amdgcn_mfma_f32_32x32x16_bf16(kb1[st], qf[NH + st], s1, 0, 0, 0);
    }
    __builtin_amdgcn_sched_barrier(0);
}
DEVI void pack_p(bf16x8 (&pf)[4], const f32x16& s0, const f32x16& s1) {
#pragma unroll
    for (int st = 0; st < 2; ++st) {
        unsigned a[4], b[4];
#pragma unroll
        for (int i = 0; i < 4; ++i) { a[i] = pg8::cvt_pk_bf16(s0[8 * st + 2 * i], s0[8 * st + 2 * i + 1]); b[i] = pg8::cvt_pk_bf16(s1[8 * st + 2 * i], s1[8 * st + 2 * i + 1]); }
        pf[st] = __builtin_bit_cast(bf16x8, (pg8::u32x4){a[0], a[1], a[2], a[3]});
        pf[2 + st] = __builtin_bit_cast(bf16x8, (pg8::u32x4){b[0], b[1], b[2], b[3]});
    }
}
typedef float f32x2 __attribute__((ext_vector_type(2)));
DEVI void softmax_tile(f32x16& s0, f32x16& s1, float& m_run, float& l_run, f32x16 (&o)[2], bf16x8 (&pf)[4]) {
    float mx = fmaxf(s0[0], s1[0]);
#pragma unroll
    for (int i = 1; i < 16; ++i) mx = fmaxf(fmaxf(mx, s0[i]), s1[i]);
    mx = xhalf_max(mx);
    const float mn = fmaxf(m_run, mx);
    const f32x2 mn2 = (f32x2){mn, mn};
    f32x2 sum2 = (f32x2){0.f, 0.f};
#pragma unroll
    for (int i = 0; i < 16; i += 2) {
        f32x2 a = (f32x2){s0[i], s0[i + 1]} - mn2, b = (f32x2){s1[i], s1[i + 1]} - mn2;
        a.x = __builtin_amdgcn_exp2f(a.x); a.y = __builtin_amdgcn_exp2f(a.y); b.x = __builtin_amdgcn_exp2f(b.x); b.y = __builtin_amdgcn_exp2f(b.y);
        s0[i] = a.x; s0[i + 1] = a.y; s1[i] = b.x; s1[i + 1] = b.y;
        sum2 += a + b;
    }
    if (__any(mn != m_run)) {
        const float corr = __builtin_amdgcn_exp2f(m_run - mn);
        const f32x2 c2 = (f32x2){corr, corr};
        l_run *= corr;
#pragma unroll
        for (int i = 0; i < 16; i += 2) {
            f32x2 a = (f32x2){o[0][i], o[0][i + 1]} * c2, b = (f32x2){o[1][i], o[1][i + 1]} * c2;
            o[0][i] = a.x; o[0][i + 1] = a.y; o[1][i] = b.x; o[1][i + 1] = b.y;
        }
        m_run = mn;
    }
    l_run += sum2.x + sum2.y;
    pack_p(pf, s0, s1);
}
template <bool MASKED>
DEVI void sb_tile(f32x16& s0, f32x16& s1, float& carry, bf16x8 (&pf)[4], int h, int t_rel  ) {
    constexpr float ZS = 0.125f * 1.4426950408889634f;
    f32x16 L0, L1;
    float G[2][4], Gp[2][4];
#pragma unroll
    for (int x = 0; x < 2; ++x)
#pragma unroll
        for (int g = 0; g < 4; ++g) {
            float gs = 0.f;
#pragma unroll
            for (int i = 0; i < 4; ++i) {
                const int rr = 4 * g + i;
                const float z = (x ? s1[rr] : s0[rr]) * ZS;
                const float e = __builtin_amdgcn_exp2f(-fabsf(z));
                const float sp = fmaxf(z, 0.f) + __builtin_amdgcn_logf(1.f + e);
                float L = -sp, ls = z - sp;
                if (MASKED) { const bool valid = (32 * x + 8 * g + 4 * h + i) < t_rel; L = valid ? L : 0.f; ls = valid ? ls : -1.0e30f; }
                gs += L;
                if (x) { s1[rr] = ls; L1[rr] = L; } else { s0[rr] = ls; L0[rr] = L; }
            }
            G[x][g] = gs;
        }
#pragma unroll
    for (int x = 0; x < 2; ++x)
#pragma unroll
        for (int g = 0; g < 4; ++g) Gp[x][g] = xhalf_sum(G[x][g]) - G[x][g];
    float T[2][4]; float run = 0.f;
#pragma unroll
    for (int x = 1; x >= 0; --x)
#pragma unroll
        for (int g = 3; g >= 0; --g) { T[x][g] = run; run += G[x][g] + Gp[x][g]; }
#pragma unroll
    for (int x = 0; x < 2; ++x)
#pragma unroll
        for (int g = 0; g < 4; ++g) {
            float tl = carry + T[x][g] + (h == 0 ? Gp[x][g] : 0.f);
#pragma unroll
            for (int i = 3; i >= 0; --i) {
                const int rr = 4 * g + i;
                if (x) { const float w = __builtin_amdgcn_exp2f(s1[rr] + tl); tl += L1[rr]; s1[rr] = w; }
                else   { const float w = __builtin_amdgcn_exp2f(s0[rr] + tl); tl += L0[rr]; s0[rr] = w; }
            }
        }
    carry += run;
    pack_p(pf, s0, s1);
}


DEVI void unpack8(const bf16x8& f, float* q) {
#pragma unroll
    for (int j = 0; j < 8; ++j) q[j] = __builtin_bit_cast(float, (unsigned)(unsigned short)f[j] << 16);
}
DEVI bf16x8 pack8(const float* q, float sc) {
    pg8::u32x4 w; w.x = pg8::cvt_pk_bf16(q[0] * sc, q[1] * sc); w.y = pg8::cvt_pk_bf16(q[2] * sc, q[3] * sc); w.z = pg8::cvt_pk_bf16(q[4] * sc, q[5] * sc); w.w = pg8::cvt_pk_bf16(q[6] * sc, q[7] * sc);
    return __builtin_bit_cast(bf16x8, w);
}
DEVI void qprep_mla(bf16x8 (&qf)[6], const Params& p, size_t grow, int h) {
    float q[48];
#pragma unroll
    for (int st = 0; st < 6; ++st) unpack8(qf[st], q + 8 * st);
    const float* cs = (const float*)(p.ws + WS_COS) + grow * 16; const float* sn = (const float*)(p.ws + WS_SIN) + grow * 16;
    const f32x4 c0 = *(const f32x4*)(cs + 4 * h), c1 = *(const f32x4*)(cs + 8 + 4 * h), s0 = *(const f32x4*)(sn + 4 * h), s1 = *(const f32x4*)(sn + 8 + 4 * h);
    float ss = 0.f;
#pragma unroll
    for (int i = 0; i < 48; ++i) ss += q[i] * q[i];
    ss = xhalf_sum(ss);
#pragma unroll
    for (int m = 0; m < 4; ++m) {
        { const float a = q[32 + 2 * m], b = q[33 + 2 * m]; q[32 + 2 * m] = a * c0[m] - b * s0[m]; q[33 + 2 * m] = b * c0[m] + a * s0[m]; }
        { const float a = q[40 + 2 * m], b = q[41 + 2 * m]; q[40 + 2 * m] = a * c1[m] - b * s1[m]; q[41 + 2 * m] = b * c1[m] + a * s1[m]; }
    }
    const float alpha = ((const float*)(p.ws + WS_ALPHA))[grow];
    const float rq = rsqrtf(alpha * alpha * ss * (1.f / 96.f) + EPS) * alpha * (0.10206207261596577f * L2E);
#pragma unroll
    for (int st = 0; st < 6; ++st) qf[st] = pack8(q + 8 * st, rq);
}
DEVI void qprep_ck(bf16x8 (&qf)[4]) {
    float q[32];
#pragma unroll
    for (int st = 0; st < 4; ++st) unpack8(qf[st], q + 8 * st);
    float ss = 0.f;
#pragma unroll
    for (int i = 0; i < 32; ++i) ss += q[i] * q[i];
    ss = xhalf_sum(ss);
    const float r = rsqrtf(ss * (1.f / 64.f) + EPS) * (0.125f * L2E);
#pragma unroll
    for (int st = 0; st < 4; ++st) qf[st] = pack8(q + 8 * st, r);
}

template <int TYPE, int PF = 0>
DEVI void unit(const Ctx& cin, const Params& p, int l, int b, int hh, int qt) {
    constexpr int DK = (TYPE == T_MLA) ? 96 : 64;
    Ctx c = cin; { int ln = cin.lane; asm volatile("" : "+v"(ln)); c.lane = ln; c.tid = cin.wid * 64 + ln; }
    const bf16_t* proj = (const bf16_t*)(p.ws + WS_PROJ); const bf16_t* qb = (const bf16_t*)(p.ws + WS_Q); const bf16_t* kvb = (const bf16_t*)(p.ws + WS_KV);
    bf16_t* O = (bf16_t*)(p.ws + WS_H);
    const size_t rowb = (size_t)b * SEQ;
    const bf16_t *Qg, *Kg, *Vg; int pitchQ, pitchKV, ocol;
    if (TYPE == T_MLA) { Qg = qb + rowb * QLD + hh * 96; pitchQ = QLD; Kg = kvb + rowb * KVLD + hh * 160; Vg = Kg + 96; pitchKV = KVLD; ocol = 256 + hh * 64; }
    else if (TYPE == T_SB) { Qg = proj + rowb * PROJ_LD + PC_SBQ + hh * 64; pitchQ = PROJ_LD; Kg = proj + rowb * PROJ_LD + PC_SBK + hh * 64; Vg = proj + rowb * PROJ_LD + PC_SBV + hh * 64; pitchKV = PROJ_LD; ocol = hh * 64; }
    else { Qg = proj + rowb * PROJ_LD + PC_CKQ + hh * 64; pitchQ = PROJ_LD; Kg = proj + rowb * PROJ_LD + PC_CKK + hh * 64; Vg = proj + rowb * PROJ_LD + PC_CKV + hh * 64; pitchKV = PROJ_LD; ocol = 768 + hh * 64; }
    LAS unsigned char* ring = c.ring;
    const int w = c.wid, r32 = c.lane & 31, h = c.lane >> 5, q0 = qt * 256, trow = q0 + 32 * w + r32;
    int jlo, jhi;
    if (TYPE == T_MLA) { jlo = 0; jhi = 4 * qt + 3; }
    else if (TYPE == T_SB) { jlo = 0; jhi = 4 * qt + 3; }
    else { jlo = 4 * qt - 8 < 0 ? 0 : 4 * qt - 8; jhi = 4 * qt + 3; }
    const int cw = 4 * qt + (w >> 1);
    bf16x8 qf[DK / 16];
#pragma unroll
    for (int st = 0; st < DK / 16; ++st) qf[st] = *(const bf16x8*)(Qg + (size_t)trow * pitchQ + st * 16 + h * 8);
    if constexpr (TYPE == T_MLA) qprep_mla(qf, p, rowb + trow, h);
    if constexpr (TYPE == T_CK) qprep_ck(qf);
    if (TYPE == T_CK) { LAS float* bt = (LAS float*)(ring + LBIAS); const float* rb = p.in[I_RELB] + (l * 4 + hh) * 257; if (c.tid < 257) bt[c.tid] = rb[c.tid] * L2E; }
    if (TYPE == T_SB) { LAS unsigned* fl = (LAS unsigned*)(ring + LFLAG); if (c.tid < 16) fl[c.tid] = 0u; }
    f32x16 o[2];
#pragma unroll
    for (int i = 0; i < 16; ++i) { o[0][i] = 0.f; o[1][i] = 0.f; }
    float m_run = -1.0e30f, l_run = 0.f, carry = 0.f;
    bool wave_done = false;
    const int vlane = (4 * h + ((c.lane & 15) >> 2)) * 64 + (((c.lane >> 4) & 1) * 16 + 4 * (c.lane & 3)) * 2;
    const int ntile = jhi - jlo + 1;
    TileRegs<DK> tr;
    auto tile_of = [&](int it) { return (TYPE == T_SB) ? (jhi - it) : (jlo + it); };
    tile_load<DK>(tr, Kg, pitchKV, Vg, pitchKV, tile_of(0) * 64, c.tid);
    tile_store<DK>(tr, ring + LK0, ring + LV0, c.tid);
    __syncthreads();
    for (int it = 0; it < ntile; ++it) {
        const int j = tile_of(it), buf = it & 1;
        const bool more = (it + 1 < ntile);
        if (more) tile_load<DK>(tr, Kg, pitchKV, Vg, pitchKV, tile_of(it + 1) * 64, c.tid);
        const LAS unsigned char* kb = ring + (buf ? LK1 : LK0); const LAS unsigned char* vb = ring + (buf ? LV1 : LV0);
        bool active;
        if (TYPE == T_MLA) active = (j <= cw);
        else if (TYPE == T_SB) active = (j <= cw) && !wave_done;
        else active = (j <= cw) && (j >= cw - 8);
        if (active) {
            f32x16 s0, s1; bf16x8 pf[4];
            qk_tile<DK>(s0, s1, kb, qf, r32, h);
            if (TYPE == T_MLA) softmax_tile(s0, s1, m_run, l_run, o, pf);
            else if (TYPE == T_CK) {
                const int dlt = cw - j;
                const LAS float* bt = (const LAS float*)(ring + LBIAS);
                if (dlt >= 3) { const float bc = bt[256];
#pragma unroll
                    for (int i = 0; i < 16; ++i) { s0[i] += bc; s1[i] += bc; } }
                else { const int base = 64 * dlt + (32 * (w & 1) + r32) - 4 * h + 128;
#pragma unroll
                    for (int i = 0; i < 16; ++i) { int i0 = base - (8 * (i >> 2) + (i & 3)), i1 = i0 - 32; i0 = i0 > 256 ? 256 : i0; i1 = i1 > 256 ? 256 : i1; s0[i] += bt[i0]; s1[i] += bt[i1]; } }
                softmax_tile(s0, s1, m_run, l_run, o, pf);
            } else {
                if (j == cw) sb_tile<true>(s0, s1, carry, pf, h, trow - j * 64); else sb_tile<false>(s0, s1, carry, pf, h, 0);
                if (__all(carry <= -144.3f)) wave_done = true;
            }
            pv_tile(o, vb + vlane, pf);
        }
        if (TYPE == T_SB) { LAS unsigned* fl = (LAS unsigned*)(ring + LFLAG); if (c.lane == 0) fl[(it & 1) * 8 + w] = wave_done ? 0u : 1u; }
        if (more) tile_store<DK>(tr, ring + (buf ? LK0 : LK1), ring + (buf ? LV0 : LV1), c.tid);
        __syncthreads();
        if (TYPE == T_SB) {
            const LAS unsigned* fl = (const LAS unsigned*)(ring + LFLAG); unsigned any = 0u;
#pragma unroll
            for (int k = 0; k < 8; ++k) any |= fl[(it & 1) * 8 + k];
            if (any == 0u) break;
        }
    }
    float inv = 1.f;
    if (TYPE != T_SB) { const float lt = l_run + __shfl_xor(l_run, 32, 64); inv = 1.f / lt; }
    bf16_t* orow = O + (rowb + trow) * DM + ocol;
    float sq = 0.f;
#pragma unroll
    for (int db = 0; db < 2; ++db)
#pragma unroll
        for (int g = 0; g < 4; ++g) {
            const float v0 = o[db][4 * g] * inv, v1 = o[db][4 * g + 1] * inv, v2 = o[db][4 * g + 2] * inv, v3 = o[db][4 * g + 3] * inv;
            sq += (v0 * v0 + v1 * v1) + (v2 * v2 + v3 * v3);
            uint2 v; v.x = pg8::cvt_pk_bf16(v0, v1); v.y = pg8::cvt_pk_bf16(v2, v3);
            *(uint2*)(orow + 32 * db + 8 * g + 4 * h) = v;
        }
    sq = xhalf_sum(sq);
    if (h == 0 && ATT_WRITE_SS) ((float*)(p.ws + WS_SSH))[(rowb + trow) * 16 + (ocol >> 6)] = sq;
    __syncthreads();
}


#ifndef ATT_UNIT
#define ATT_UNIT unit2
#endif
#ifndef ATT_FUSED_SEG1
#define ATT_FUSED_SEG1 0
#define MLA64 1
#endif

template <int DK> DEVI void qk_tile_c(f32x16& s0, f32x16& s1, const f32x16& cin, const LAS unsigned char* kb, const bf16x8 (&qf)[DK / 16], int r32, int h) {
    constexpr int PITCH = DK * 2 + 16, NS = DK / 16;
    const LAS unsigned char* k0 = kb + r32 * PITCH + h * 16;
    bf16x8 a0[NS], a1[NS];
#pragma unroll
    for (int st = 0; st < NS; ++st) { a0[st] = *(const LAS bf16x8*)(k0 + st * 32); a1[st] = *(const LAS bf16x8*)(k0 + 32 * PITCH + st * 32); }
    __builtin_amdgcn_sched_barrier(0);
    s0 = __builtin_amdgcn_mfma_f32_32x32x16_bf16(a0[0], qf[0], cin, 0, 0, 0);
    s1 = __builtin_amdgcn_mfma_f32_32x32x16_bf16(a1[0], qf[0], cin, 0, 0, 0);
#pragma unroll
    for (int st = 1; st < NS; ++st) {
        s0 = __builtin_amdgcn_mfma_f32_32x32x16_bf16(a0[st], qf[st], s0, 0, 0, 0);
        s1 = __builtin_amdgcn_mfma_f32_32x32x16_bf16(a1[st], qf[st], s1, 0, 0, 0);
    }
    __builtin_amdgcn_sched_barrier(0);
}
constexpr float DEFER_THR = 6.0f;
DEVI void softmax_tile_defer(f32x16& s0, f32x16& s1, float& m_run, f32x16& negm, float& l_run, f32x16 (&o)[2], bf16x8 (&pf)[4], bool first, bool fixed) {
    if (!fixed) {
    float mx = fmaxf(s0[0], s1[0]);
#pragma unroll
    for (int i = 1; i < 16; ++i) mx = fmaxf(fmaxf(mx, s0[i]), s1[i]);
    mx = xhalf_max(mx);
    if (first || __any(mx > DEFER_THR)) {
        const float d = first ? mx : fmaxf(mx, 0.f);
        const float corr = __builtin_amdgcn_exp2f(-d);
        const f32x2 c2 = (f32x2){corr, corr}, d2 = (f32x2){d, d};
        l_run *= corr; m_run += d;
#pragma unroll
        for (int i = 0; i < 16; i += 2) {
            f32x2 a = (f32x2){o[0][i], o[0][i + 1]} * c2, b = (f32x2){o[1][i], o[1][i + 1]} * c2;
            o[0][i] = a.x; o[0][i + 1] = a.y; o[1][i] = b.x; o[1][i + 1] = b.y;
            f32x2 u = (f32x2){s0[i], s0[i + 1]} - d2, v = (f32x2){s1[i], s1[i + 1]} - d2;
            s0[i] = u.x; s0[i + 1] = u.y; s1[i] = v.x; s1[i + 1] = v.y;
        }
#pragma unroll
        for (int i = 0; i < 16; ++i) negm[i] = -m_run;
    }
    }
    float sum = 0.f;
#pragma unroll
    for (int i = 0; i < 16; ++i) {
        s0[i] = __builtin_amdgcn_exp2f(s0[i]); s1[i] = __builtin_amdgcn_exp2f(s1[i]);
        sum += s0[i]; sum += s1[i];
    }
    l_run += sum;
    pack_p(pf, s0, s1);
}

#define ATT_BAR() do { asm volatile("s_waitcnt lgkmcnt(0)" ::: "memory"); __builtin_amdgcn_s_barrier(); asm volatile("" ::: "memory"); } while (0)
template <int TYPE, int PF = 0>
DEVI void unit2(const Ctx& cin, const Params& p, int l, int b, int hh, int qt) {
    constexpr int DK = (TYPE == T_MLA) ? 96 : 64;
    Ctx c = cin; { int ln = cin.lane; asm volatile("" : "+v"(ln)); c.lane = ln; c.tid = cin.wid * 64 + ln; }
    const bf16_t* proj = (const bf16_t*)(p.ws + WS_PROJ); const bf16_t* qb = (const bf16_t*)(p.ws + WS_Q); const bf16_t* kvb = (const bf16_t*)(p.ws + WS_KV);
    bf16_t* O = (PF & 16) ? (bf16_t*)p.out : (bf16_t*)(p.ws + WS_H);
    const size_t rowb = (size_t)b * SEQ;
    const bf16_t *Qg, *Kg, *Vg; int pitchQ, pitchKV, ocol;
    if (TYPE == T_MLA) { Qg = qb + rowb * QLD + hh * 96; pitchQ = QLD; Kg = kvb + rowb * KVLD + hh * 160; Vg = Kg + 96; pitchKV = KVLD; ocol = 256 + hh * 64; }
    else if (TYPE == T_SB) { Qg = proj + rowb * PROJ_LD + PC_SBQ + hh * 64; pitchQ = PROJ_LD; Kg = proj + rowb * PROJ_LD + PC_SBK + hh * 64; Vg = proj + rowb * PROJ_LD + PC_SBV + hh * 64; pitchKV = PROJ_LD; ocol = hh * 64; }
    else { Qg = proj + rowb * PROJ_LD + PC_CKQ + hh * 64; pitchQ = PROJ_LD; Kg = proj + rowb * PROJ_LD + PC_CKK + hh * 64; Vg = proj + rowb * PROJ_LD + PC_CKV + hh * 64; pitchKV = PROJ_LD; ocol = 768 + hh * 64; }
    LAS unsigned char* ring = c.ring;
    const int w = c.wid, hb = w >> 2, r32 = c.lane & 31, h = c.lane >> 5, q0 = qt * 256, trow = q0 + 32 * w + r32;
    int jlo, jhi;
    if (TYPE == T_CK) { jlo = 4 * qt - 8 < 0 ? 0 : 4 * qt - 8; jhi = 4 * qt + 3; } else { jlo = 0; jhi = 4 * qt + 3; }
    const int cw = 4 * qt + (w >> 1);
    bf16x8 qf[DK / 16];
#pragma unroll
    for (int st = 0; st < DK / 16; ++st) qf[st] = *(const bf16x8*)(Qg + (size_t)trow * pitchQ + st * 16 + h * 8);
    if (TYPE == T_CK) { LAS float* bt = (LAS float*)(ring + LBIAS); const float* rb = p.in[I_RELB] + (l * 4 + hh) * 257; if (c.tid < 257) bt[c.tid] = rb[c.tid] * L2E; }
    if (TYPE == T_SB) { LAS unsigned* fl = (LAS unsigned*)(ring + LFLAG); if (c.tid < 32) fl[c.tid] = 1u; }
    f32x16 o[2];
#pragma unroll
    for (int i = 0; i < 16; ++i) { o[0][i] = 0.f; o[1][i] = 0.f; }
    float m_run = 0.f, l_run = 0.f, carry = 0.f;
    bool wave_done = false, first_tile = true, fixed = false;
    if (TYPE != T_SB) {
        const float b2 = __builtin_bit_cast(float, __builtin_amdgcn_readfirstlane(__builtin_bit_cast(int, ((const float*)(p.ws + WS_CTL))[WS_BND_WORD + l * 8 + (TYPE == T_MLA ? 0 : 1 + hh)])));
        fixed = b2 < 50.f; if (fixed) m_run = b2;
    }
    f32x16 negm;
#pragma unroll
    for (int i = 0; i < 16; ++i) negm[i] = -m_run;
    const int vlane = (4 * h + ((c.lane & 15) >> 2)) * 64 + (((c.lane >> 4) & 1) * 16 + 4 * (c.lane & 3)) * 2;
    const int nt = jhi - jlo + 1;
    TileRegs<DK> tr;
    auto tile_of = [&](int it) { return (TYPE == T_SB) ? (jhi - it) : (jlo + it); };
    {
        TileRegs<DK> tr1;
        loadK<DK>(tr, Kg, pitchKV, tile_of(0) * 64, c.tid); loadV<DK>(tr, Vg, pitchKV, tile_of(0) * 64, c.tid);
        if (nt > 1) loadK<DK>(tr1, Kg, pitchKV, tile_of(1) * 64, c.tid);
        if constexpr (TYPE == T_MLA) qprep_mla(qf, p, rowb + trow, h);
        if constexpr (TYPE == T_CK) qprep_ck(qf);
        storeK<DK>(tr, ring + LK0, c.tid); storeV<DK>(tr, ring + LV0, c.tid);
        if (nt > 1) storeK<DK>(tr1, ring + LK1, c.tid);
    }
    __syncthreads();
    if (hb == 1 && !(PF & 32)) ATT_BAR();
    f32x16 s0, s1; bf16x8 pf[4];
    bool act_prev = false;
    int it = 0;
    for (; it < nt; ++it) {
        const int j = tile_of(it);
        bool act_cur;
        if (TYPE == T_MLA) act_cur = (j <= cw);
        else if (TYPE == T_SB) act_cur = (j <= cw) && !wave_done;
        else act_cur = (j <= cw) && (j >= cw - 8);
        if (ATT_FUSED_SEG1 && act_cur && act_prev && !(PF & 12)) seg1_fused<DK>(s0, s1, o, ring + ((it & 1) ? LK1 : LK0), ring + (((it - 1) & 1) ? LV1 : LV0) + vlane, qf, pf, r32, h);
        else {
        if (act_cur) { if (!(PF & 8)) qk_tile_c<DK>(s0, s1, negm, ring + ((it & 1) ? LK1 : LK0), qf, r32, h); else {
#pragma unroll
            for (int i = 0; i < 16; ++i) { s0[i] = (float)i; s1[i] = (float)(i + it); } } }
        if (act_prev && !(PF & 4)) pv_tile(o, ring + (((it - 1) & 1) ? LV1 : LV0) + vlane, pf);
        }
        if (it >= 1 && !(PF & 2)) { if (it + 1 < nt) storeK<DK>(tr, ring + (((it + 1) & 1) ? LK1 : LK0), c.tid); storeV<DK>(tr, ring + ((it & 1) ? LV1 : LV0), c.tid); }
        if (!(PF & 32)) ATT_BAR();
        if (!(PF & 2)) { if (it + 2 < nt) loadK<DK>(tr, Kg, pitchKV, tile_of(it + 2) * 64, c.tid);
        if (it + 1 < nt) loadV<DK>(tr, Vg, pitchKV, tile_of(it + 1) * 64, c.tid); }
        if (act_cur) {
            if (PF & 1) { l_run += s0[3]; pack_p(pf, s0, s1); }
            else if (TYPE == T_MLA) { softmax_tile_defer(s0, s1, m_run, negm, l_run, o, pf, first_tile, fixed); first_tile = false; }
            else if (TYPE == T_CK) {
                const int dlt = cw - j;
                const LAS float* bt = (const LAS float*)(ring + LBIAS);
                if (dlt >= 3) { const float bc = bt[256];
#pragma unroll
                    for (int i = 0; i < 16; ++i) { s0[i] += bc; s1[i] += bc; } }
                else { const int base = 64 * dlt + (32 * (w & 1) + r32) - 4 * h + 128;
#pragma unroll
                    for (int i = 0; i < 16; ++i) { int i0 = base - (8 * (i >> 2) + (i & 3)), i1 = i0 - 32; i0 = i0 > 256 ? 256 : i0; i1 = i1 > 256 ? 256 : i1; s0[i] += bt[i0]; s1[i] += bt[i1]; } }
                softmax_tile_defer(s0, s1, m_run, negm, l_run, o, pf, first_tile, fixed); first_tile = false;
            } else {
                if (j == cw) sb_tile<true>(s0, s1, carry, pf, h, trow - j * 64); else sb_tile<false>(s0, s1, carry, pf, h, 0);
                if (__all(carry <= -144.3f)) wave_done = true;
            }
        }
        if (TYPE == T_SB) { LAS unsigned* fl = (LAS unsigned*)(ring + LFLAG); if (c.lane == 0) fl[(it & 3) * 8 + w] = wave_done ? 0u : 1u; }
        act_prev = act_cur;
        if (!(PF & 32)) ATT_BAR();
        if (TYPE == T_SB && it >= 1) {
            const LAS unsigned* fl = (const LAS unsigned*)(ring + LFLAG); unsigned any = 0u;
#pragma unroll
            for (int k = 0; k < 8; ++k) any |= fl[((it - 1) & 3) * 8 + k];
            if (any == 0u) { ++it; break; }
        }
    }
    if (act_prev && !(PF & 4)) pv_tile(o, ring + (((it - 1) & 1) ? LV1 : LV0) + vlane, pf);
    if (hb == 0 && !(PF & 32)) ATT_BAR();
    float inv = 1.f;
    if (TYPE != T_SB) { const float lt = xhalf_sum(l_run); inv = 1.f / lt; }
    bf16_t* orow = O + (rowb + trow) * DM + ocol;
    float sq = 0.f;
#pragma unroll
    for (int db = 0; db < 2; ++db)
#pragma unroll
        for (int gp = 0; gp < 2; ++gp) {
            unsigned w[2][2];
#pragma unroll
            for (int e = 0; e < 2; ++e) {
                const int g = 2 * gp + e;
                const float v0 = o[db][4 * g] * inv, v1 = o[db][4 * g + 1] * inv, v2 = o[db][4 * g + 2] * inv, v3 = o[db][4 * g + 3] * inv;
                sq += (v0 * v0 + v1 * v1) + (v2 * v2 + v3 * v3);
                w[e][0] = pg8::cvt_pk_bf16(v0, v1); w[e][1] = pg8::cvt_pk_bf16(v2, v3);
            }
            xswap32(w[0][0], w[1][0]); xswap32(w[0][1], w[1][1]);
            pg8::u32x4 v; v.x = w[0][0]; v.y = w[0][1]; v.z = w[1][0]; v.w = w[1][1];
            *(pg8::u32x4*)(orow + 32 * db + 8 * (2 * gp + h)) = v;
        }
    sq = xhalf_sum(sq);
    if (h == 0 && ATT_WRITE_SS) ((float*)(p.ws + WS_SSH))[(rowb + trow) * 16 + (ocol >> 6)] = sq;
    __syncthreads();
}


DEVI void softmax_rb(f32x16& s0, f32x16& s1, float& m_run, float& l_run, f32x16 (&o)[2], bf16x8 (&pf)[4], bool fixed) {
    if (!fixed) {
        float mx = fmaxf(s0[0], s1[0]);
#pragma unroll
        for (int i = 1; i < 16; ++i) mx = fmaxf(fmaxf(mx, s0[i]), s1[i]);
        mx = xhalf_max(mx);
        const float mn = fmaxf(m_run, mx);
        if (__any(mn != m_run)) {
            const float corr = __builtin_amdgcn_exp2f(m_run - mn);
            l_run *= corr;
#pragma unroll
            for (int i = 0; i < 16; ++i) { o[0][i] *= corr; o[1][i] *= corr; }
            m_run = mn;
        }
#pragma unroll
        for (int i = 0; i < 16; ++i) { s0[i] -= mn; s1[i] -= mn; }
    }
    float sum = 0.f;
#pragma unroll
    for (int i = 0; i < 16; ++i) { s0[i] = __builtin_amdgcn_exp2f(s0[i]); s1[i] = __builtin_amdgcn_exp2f(s1[i]); sum += s0[i]; sum += s1[i]; }
    l_run += sum;
    pack_p(pf, s0, s1);
}
DEVI void unit3(const Ctx& cin, const Params& p, int l, int b, int hh, int qt) {
    constexpr int DK = 96, PITCH = DK * 2 + 16;
    Ctx c = cin; { int ln = cin.lane; asm volatile("" : "+v"(ln)); c.lane = ln; c.tid = cin.wid * 64 + ln; }
    const bf16_t* qb = (const bf16_t*)(p.ws + WS_Q); const bf16_t* kvb = (const bf16_t*)(p.ws + WS_KV);
    bf16_t* O = (bf16_t*)(p.ws + WS_H);
    const size_t rowb = (size_t)b * SEQ;
    const bf16_t* Qg = qb + rowb * QLD + hh * 96; const bf16_t* Kg = kvb + rowb * KVLD + hh * 160; const bf16_t* Vg = Kg + 96; const int ocol = 256 + hh * 64;
    LAS unsigned char* ring = c.ring;
    const int w = c.wid, r32 = c.lane & 31, h = c.lane >> 5, q0 = qt * 512;
    const int cw = 8 * qt + w, nt = 8 * qt + 8;
    const float b2 = __builtin_bit_cast(float, __builtin_amdgcn_readfirstlane(__builtin_bit_cast(int, ((const float*)(p.ws + WS_CTL))[WS_BND_WORD + l * 8])));
    const bool fixed = b2 < 50.f;
    bf16x8 qf[2][6];
#pragma unroll
    for (int rb = 0; rb < 2; ++rb) {
        const int trow = q0 + 64 * w + 32 * rb + r32;
#pragma unroll
        for (int st = 0; st < 6; ++st) qf[rb][st] = *(const bf16x8*)(Qg + (size_t)trow * QLD + st * 16 + h * 8);
    }
    TileRegs<DK> tr;
    tile_load<DK>(tr, Kg, KVLD, Vg, KVLD, 0, c.tid);
#pragma unroll
    for (int rb = 0; rb < 2; ++rb) qprep_mla(qf[rb], p, rowb + q0 + 64 * w + 32 * rb + r32, h);
    f32x16 o[2][2];
#pragma unroll
    for (int i = 0; i < 16; ++i) { o[0][0][i] = 0.f; o[0][1][i] = 0.f; o[1][0][i] = 0.f; o[1][1][i] = 0.f; }
    float m_run[2] = {fixed ? 0.f : -1.0e30f, fixed ? 0.f : -1.0e30f}, l_run[2] = {0.f, 0.f};
    const int vlane = (4 * h + ((c.lane & 15) >> 2)) * 64 + (((c.lane >> 4) & 1) * 16 + 4 * (c.lane & 3)) * 2;
    tile_store<DK>(tr, ring + LK0, ring + LV0, c.tid);
    __syncthreads();
#pragma unroll 1
    for (int it = 0; it < nt; ++it) {
        const int buf = it & 1; const bool more = (it + 1 < nt);
        if (more) tile_load<DK>(tr, Kg, KVLD, Vg, KVLD, (it + 1) * 64, c.tid);
        const LAS unsigned char* kb = ring + (buf ? LK1 : LK0); const LAS unsigned char* vb = ring + (buf ? LV1 : LV0) + vlane;
        if (it <= cw) {
            f32x16 s[2][2]; bf16x8 pf[2][4];
            {
                const LAS unsigned char* k0 = kb + r32 * PITCH + h * 16;
                f32x16 z;
#pragma unroll
                for (int i = 0; i < 16; ++i) z[i] = 0.f;
#pragma unroll
                for (int hf = 0; hf < 2; ++hf) {
                    bf16x8 a0[3], a1[3];
#pragma unroll
                    for (int st = 0; st < 3; ++st) { a0[st] = *(const LAS bf16x8*)(k0 + (3 * hf + st) * 32); a1[st] = *(const LAS bf16x8*)(k0 + 32 * PITCH + (3 * hf + st) * 32); }
                    __builtin_amdgcn_sched_barrier(0);
#pragma unroll
                    for (int st = 0; st < 3; ++st)
#pragma unroll
                        for (int rb = 0; rb < 2; ++rb) {
                            s[rb][0] = __builtin_amdgcn_mfma_f32_32x32x16_bf16(a0[st], qf[rb][3 * hf + st], (hf == 0 && st == 0) ? z : s[rb][0], 0, 0, 0);
                            s[rb][1] = __builtin_amdgcn_mfma_f32_32x32x16_bf16(a1[st], qf[rb][3 * hf + st], (hf == 0 && st == 0) ? z : s[rb][1], 0, 0, 0);
                        }
                    __builtin_amdgcn_sched_barrier(0);
                }
            }
#pragma unroll
            for (int rb = 0; rb < 2; ++rb) softmax_rb(s[rb][0], s[rb][1], m_run[rb], l_run[rb], o[rb], pf[rb], fixed);
#pragma unroll
            for (int db = 0; db < 2; ++db) {
                s16x4 lo[4], hi[4];
#pragma unroll
                for (int ks = 0; ks < 4; ++ks) { lo[ks] = vtr(vb + db * 4096 + ks * 1024); hi[ks] = vtr(vb + db * 4096 + ks * 1024 + 512); }
                __builtin_amdgcn_sched_barrier(0);
#pragma unroll
                for (int ks = 0; ks < 4; ++ks) {
                    const bf16x8 a = (bf16x8){lo[ks][0], lo[ks][1], lo[ks][2], lo[ks][3], hi[ks][0], hi[ks][1], hi[ks][2], hi[ks][3]};
                    o[0][db] = __builtin_amdgcn_mfma_f32_32x32x16_bf16(a, pf[0][ks], o[0][db], 0, 0, 0);
                    o[1][db] = __builtin_amdgcn_mfma_f32_32x32x16_bf16(a, pf[1][ks], o[1][db], 0, 0, 0);
                }
                __builtin_amdgcn_sched_barrier(0);
            }
        }
        if (more) tile_store<DK>(tr, ring + (buf ? LK0 : LK1), ring + (buf ? LV0 : LV1), c.tid);
        __syncthreads();
    }
#pragma unroll
    for (int rb = 0; rb < 2; ++rb) {
        const int trow = q0 + 64 * w + 32 * rb + r32;
        const float inv = 1.f / xhalf_sum(l_run[rb]);
        bf16_t* orow = O + (rowb + trow) * DM + ocol;
        float sq = 0.f;
#pragma unroll
        for (int db = 0; db < 2; ++db)
#pragma unroll
            for (int gp = 0; gp < 2; ++gp) {
                unsigned wv[2][2];
#pragma unroll
                for (int e = 0; e < 2; ++e) {
                    const int g = 2 * gp + e;
                    const float v0 = o[rb][db][4 * g] * inv, v1 = o[rb][db][4 * g + 1] * inv, v2 = o[rb][db][4 * g + 2] * inv, v3 = o[rb][db][4 * g + 3] * inv;
                    sq += (v0 * v0 + v1 * v1) + (v2 * v2 + v3 * v3);
                    wv[e][0] = pg8::cvt_pk_bf16(v0, v1); wv[e][1] = pg8::cvt_pk_bf16(v2, v3);
                }
                xswap32(wv[0][0], wv[1][0]); xswap32(wv[0][1], wv[1][1]);
                pg8::u32x4 v; v.x = wv[0][0]; v.y = wv[0][1]; v.z = wv[1][0]; v.w = wv[1][1];
                *(pg8::u32x4*)(orow + 32 * db + 8 * (2 * gp + h)) = v;
            }
        sq = xhalf_sum(sq);
        if (h == 0) ((float*)(p.ws + WS_SSH))[(rowb + trow) * 16 + (ocol >> 6)] = sq;
    }
    __syncthreads();
}

DEVI void conv_unit(const Ctx& c, const Params& p, int cv) {
    unsigned char* ws = p.ws;
    if (cv < 176) { const int e = cv / 22, rb = cv % 22;
        conv_rowblock<MAP_GU>(c, p.in[I_MG] + (size_t)e * 1024 * DFF, p.in[I_MU] + (size_t)e * 1024 * DFF, DFF, 1024, nullptr, (bf16_t*)(ws + WS_MGU) + (size_t)e * 5632 * 1024, 1024, rb); }
    else { const int d = cv - 176, e = d >> 2, rb = d & 3;
        conv_rowblock<MAP_ID>(c, p.in[I_MD] + (size_t)e * DFF * 1024, nullptr, 1024, DFF, nullptr, (bf16_t*)(ws + WS_MD) + (size_t)e * 1024 * DFF, DFF, rb); }
    __syncthreads();
}
DEVI void run_unit(const Ctx& c, const Params& p, int l, int xq, int u, int ncv) {
    constexpr int NB = MLA64 ? 48 : 96;
    if (u >= NB && u < NB + ncv) { conv_unit(c, p, l == 0 ? xq * 22 + (u - NB) : 176 + xq * 4 + (u - NB)); return; }
    if (u >= NB + ncv) u -= ncv;
    if (u < NB) {
        if (MLA64) { const int g = u / 12, idx = u % 12, qt = 7 - (idx >> 1), bh = 8 * (2 * g + (idx & 1)) + xq; unit3(c, p, l, bh >> 3, bh & 7, qt); }
        else { const int g = u / 24, idx = u % 24, qt = 15 - (idx >> 1), bh = 8 * (2 * g + (idx & 1)) + xq; ATT_UNIT<T_MLA>(c, p, l, bh >> 3, bh & 7, qt); }
    }
    else if (u < NB + 64) { const int v = u - NB, qt = 15 - (v >> 2), bh = 8 * (v & 3) + xq; ATT_UNIT<T_CK>(c, p, l, bh >> 2, bh & 3, qt); }
    else if (u < NB + 128) { const int v = u - NB - 64, qt = 15 - (v >> 2), bh = 8 * (v & 3) + xq; ATT_UNIT<T_SB>(c, p, l, bh >> 2, bh & 3, qt); }
    else if (MLA64) { const int v = u - NB - 128, qt = 1 - (v >> 3), bh = 8 * (v & 7) + xq; unit3(c, p, l, bh >> 3, bh & 7, qt); }
    else { const int v = u - NB - 128, qt = 3 - (v >> 3), bh = 8 * (v & 7) + xq; ATT_UNIT<T_MLA>(c, p, l, bh >> 3, bh & 7, qt); }
}
DEVI void phase(const Ctx& c, const Params& p, int lq) {
    const int l = lq & 1;
    unsigned* qbase = (unsigned*)(p.ws + WS_CTL) + 8192 + 512 * lq;
    LAS int* s_unit = (LAS int*)(c.ring + LUNIT);
    const int x0 = (int)(xb_xcc_id() & 7u);
    const int ncv = !MOE_CONV_IN_ATT ? 0 : lq == 0 ? 22 : lq == 1 ? 4 : 0, nun = (MLA64 ? 192 : 256) + ncv;
    for (int k = 0; k < 8; ++k) {
        const int xq = (x0 + k) & 7;
        if (c.tid == 0) s_unit[0] = (int)__hip_atomic_fetch_add(qbase + 64 * xq, 1u, __ATOMIC_RELAXED, __HIP_MEMORY_SCOPE_AGENT);
        __syncthreads();
        for (int par = 0;; par ^= 1) {
            const int u = s_unit[par];
            if (u >= nun) break;
            int nxt = 0;
            if (c.tid == 0) {
                unsigned long long qa = (unsigned long long)(qbase + 64 * xq);
                asm volatile("" : "+v"(qa));
                nxt = (int)__hip_atomic_fetch_add((__attribute__((address_space(1))) unsigned*)qa, 1u, __ATOMIC_RELAXED, __HIP_MEMORY_SCOPE_AGENT);
            }
            run_unit(c, p, l, xq, u, ncv);
            if (c.tid == 0) s_unit[par ^ 1] = nxt;
            __syncthreads();
        }
        __syncthreads();
    }
}
#ifndef PROBE_PF
#define PROBE_PF 0
#endif
#ifndef PROBE_TYPES
#define PROBE_TYPES 0
#endif
DEVI void phase_probe(const Ctx& c, const Params& p, int l) {
    unsigned* qbase = (unsigned*)(p.ws + WS_CTL) + 8192 + 512 * 3;
    LAS int* s_unit = (LAS int*)(c.ring + LUNIT);
    const int x0 = (int)(xb_xcc_id() & 7u);
    for (int k = 0; k < 8; ++k) {
        const int xq = (x0 + k) & 7;
        for (;;) {
            if (c.tid == 0) *s_unit = (int)__hip_atomic_fetch_add(qbase + 64 * xq, 1u, __ATOMIC_RELAXED, __HIP_MEMORY_SCOPE_AGENT);
            __syncthreads();
            const int u = *s_unit;
            __syncthreads();
            if (u >= 256) break;
            if (u < 128) { if (PROBE_TYPES & 1) { const int g = u >> 5, idx = u & 31, qt = 15 - (idx >> 1), bh = 8 * (2 * g + (idx & 1)) + xq; unit2<T_MLA, (PROBE_PF | 16)>(c, p, l, bh >> 3, bh & 7, qt); } }
            else if (u < 192) { if (PROBE_TYPES & 2) { const int v = u - 128, qt = 15 - (v >> 2), bh = 8 * (v & 3) + xq; unit2<T_SB, (PROBE_PF | 16)>(c, p, l, bh >> 2, bh & 3, qt); } }
            else { if (PROBE_TYPES & 4) { const int v = u - 192, qt = v >> 2, bh = 8 * (v & 3) + xq; unit2<T_CK, (PROBE_PF | 16)>(c, p, l, bh >> 2, bh & 3, qt); } }
        }
    }
}
}

DEVI void phase_prep(const Ctx& c, const Params& p, int l) {
    bf16_t* proj = (bf16_t*)(p.ws + WS_PROJ);
    const float* cs = (const float*)(p.ws + WS_COS); const float* sn = (const float*)(p.ws + WS_SIN);
    const float* gq = p.in[I_CKQN] + l * 64; const float* gk = p.in[I_CKKN] + l * 64;
    for (int row = c.bid * 8 + c.wid; row < MTOK; row += c.nblk * 8) {
        bf16_t* pr = proj + (size_t)row * PROJ_LD;
        {
            uint2 v = *(const uint2*)(pr + PC_CQ + 4 * c.lane);
            float a0 = lo16(v.x), a1 = hi16(v.x), a2 = lo16(v.y), a3 = hi16(v.y);
            const float ss = wave_sum(a0 * a0 + a1 * a1 + a2 * a2 + a3 * a3), r = rsqrtf(ss * (1.f / 256.f) + EPS);
            v.x = pk2(a0 * r, a1 * r); v.y = pk2(a2 * r, a3 * r);
            *(uint2*)(pr + PC_CQ + 4 * c.lane) = v;
        }
        {
            unsigned v = *(const unsigned*)(pr + PC_LAT + 2 * c.lane);
            float a0 = lo16(v), a1 = hi16(v);
            const float ss = wave_sum(a0 * a0 + a1 * a1), r = rsqrtf(ss * (1.f / 128.f) + EPS);
            *(unsigned*)(pr + PC_LAT + 2 * c.lane) = pk2(a0 * r, a1 * r);
        }
        if (c.lane < 16) {
            const float x1 = bf2f(pr[PC_KPE + c.lane]), x2 = bf2f(pr[PC_KPE + 16 + c.lane]);
            const float co = cs[row * 16 + c.lane], si = sn[row * 16 + c.lane];
            pr[PC_KPE + c.lane] = f2bf(x1 * co - x2 * si); pr[PC_KPE + 16 + c.lane] = f2bf(x2 * co + x1 * si);
        }
        {
            uint2 v = *(const uint2*)(pr + PC_CKQ + 4 * c.lane);
            float a0 = lo16(v.x), a1 = hi16(v.x), a2 = lo16(v.y), a3 = hi16(v.y);
            const float ss = sum16(a0 * a0 + a1 * a1 + a2 * a2 + a3 * a3), r = rsqrtf(ss * (1.f / 64.f) + EPS) * (0.125f * 1.4426950408889634f);
            const int d = (4 * c.lane) & 63;
            v.x = pk2(a0 * r * gq[d], a1 * r * gq[d + 1]); v.y = pk2(a2 * r * gq[d + 2], a3 * r * gq[d + 3]);
            *(uint2*)(pr + PC_CKQ + 4 * c.lane) = v;
        }
        {
            uint2 v = *(const uint2*)(pr + PC_CKK + 4 * c.lane);
            float a0 = lo16(v.x), a1 = hi16(v.x), a2 = lo16(v.y), a3 = hi16(v.y);
            const float ss = sum16(a0 * a0 + a1 * a1 + a2 * a2 + a3 * a3), r = rsqrtf(ss * (1.f / 64.f) + EPS);
            const int d = (4 * c.lane) & 63;
            v.x = pk2(a0 * r * gk[d], a1 * r * gk[d + 1]); v.y = pk2(a2 * r * gk[d + 2], a3 * r * gk[d + 3]);
            *(uint2*)(pr + PC_CKK + 4 * c.lane) = v;
        }
    }
}

DEVI void phase_fin(const Ctx& c, const Params& p, int l) {
    bf16_t* qb = (bf16_t*)(p.ws + WS_Q); bf16_t* kvb = (bf16_t*)(p.ws + WS_KV); const bf16_t* proj = (const bf16_t*)(p.ws + WS_PROJ);
    const float* cs = (const float*)(p.ws + WS_COS); const float* sn = (const float*)(p.ws + WS_SIN);
    const float* gq = p.in[I_QQK] + l * 96; const float* gk = p.in[I_KQK] + l * 96;
    const float qscale = 0.10206207261596577f * 1.4426950408889634f;
#pragma unroll 1
    for (int it = c.bid * 512 + c.tid; it < MTOK * 8; it += c.nblk * 512) {
        const int row = it >> 3, hh = it & 7;
        {
            bf16_t* qp = qb + (size_t)row * QLD + hh * 96;
            float ss = 0.f;
#pragma unroll 1
            for (int i = 0; i < 12; ++i) { float t8[8]; load_bf16_row<8>(qp + 8 * i, t8);
#pragma unroll
                for (int j = 0; j < 8; ++j) ss += t8[j] * t8[j]; }
            const float r = rsqrtf(ss * (1.f / 96.f) + EPS) * qscale;
#pragma unroll 1
            for (int i = 0; i < 8; ++i) { float t8[8]; load_bf16_row<8>(qp + 8 * i, t8);
#pragma unroll
                for (int j = 0; j < 8; ++j) t8[j] *= r * gq[8 * i + j];
                store_bf16_row<8>(qp + 8 * i, t8); }
#pragma unroll 1
            for (int i = 0; i < 2; ++i) { float x1[8], x2[8]; load_bf16_row<8>(qp + 64 + 8 * i, x1); load_bf16_row<8>(qp + 80 + 8 * i, x2);
#pragma unroll
                for (int j = 0; j < 8; ++j) { const float co = cs[row * 16 + 8 * i + j], si = sn[row * 16 + 8 * i + j], a = x1[j], b2 = x2[j];
                    x1[j] = (a * co - b2 * si) * r * gq[64 + 8 * i + j]; x2[j] = (b2 * co + a * si) * r * gq[80 + 8 * i + j]; }
                store_bf16_row<8>(qp + 64 + 8 * i, x1); store_bf16_row<8>(qp + 80 + 8 * i, x2); }
        }
    }
#pragma unroll 1
    for (int it = c.bid * 512 + c.tid; it < MTOK * 8; it += c.nblk * 512) {
        const int row = it >> 3, hh = it & 7;
        {
            bf16_t* kp = kvb + (size_t)row * KVLD + hh * 160;
            float kn[64]; load_bf16_row<64>(kp, kn);
            float kr[32]; load_bf16_row<32>(proj + (size_t)row * PROJ_LD + PC_KPE, kr);
            float ss = 0.f;
#pragma unroll
            for (int i = 0; i < 64; ++i) ss += kn[i] * kn[i];
#pragma unroll
            for (int i = 0; i < 32; ++i) ss += kr[i] * kr[i];
            const float r = rsqrtf(ss * (1.f / 96.f) + EPS);
#pragma unroll
            for (int i = 0; i < 64; ++i) kn[i] *= r * gk[i];
#pragma unroll
            for (int i = 0; i < 32; ++i) kr[i] *= r * gk[64 + i];
            store_bf16_row<64>(kp, kn); store_bf16_row<32>(kp + 64, kr);
        }
    }
}

DEVI void phase_att(const Ctx& c, const Params& p, int l) {
    const bf16_t* proj = (const bf16_t*)(p.ws + WS_PROJ); const bf16_t* qb = (const bf16_t*)(p.ws + WS_Q); const bf16_t* kvb = (const bf16_t*)(p.ws + WS_KV);
    bf16_t* o = (bf16_t*)(p.ws + WS_H);
    const float* relb = p.in[I_RELB] + l * 4 * 257;
    for (int wi = c.bid * 8 + c.wid; wi < 8192; wi += c.nblk * 8) {
        if (wi < 2048) {
            const int tt = 63 - (wi & 63), bh = wi >> 6, b = bh >> 2, hh = bh & 3, t0 = tt * 64, t = t0 + c.lane;
            const size_t rowb = (size_t)b * SEQ;
            float q[64], acc[64];
            load_bf16_row<64>(proj + (rowb + t) * PROJ_LD + PC_SBQ + hh * 64, q);
#pragma unroll
            for (int d = 0; d < 64; ++d) acc[d] = 0.f;
            float tail = 0.f;
            for (int s = t0 + 62; s >= 0; --s) {
                float z = dot_bf16<64>(proj + (rowb + s) * PROJ_LD + PC_SBK + hh * 64, q) * 0.125f;
                if (s < t) {
                    const float sp = fmaxf(z, 0.f) + log1pf(__expf(-fabsf(z)));
                    const float w = __expf(z - sp + tail);
                    tail -= sp;
                    axpy_bf16<64>(acc, 1.f, w, proj + (rowb + s) * PROJ_LD + PC_SBV + hh * 64);
                }
            }
            store_bf16_row<64>(o + (rowb + t) * DM + hh * 64, acc);
        } else if (wi < 6144) {
            const int w2 = wi - 2048, tt = 63 - (w2 & 63), bh = w2 >> 6, b = bh >> 3, hh = bh & 7, t0 = tt * 64, t = t0 + c.lane;
            const size_t rowb = (size_t)b * SEQ;
            unsigned q[48]; float acc[64];
#pragma unroll
            for (int i = 0; i < 12; ++i) { const uint4 v = *(const uint4*)(qb + (rowb + t) * QLD + hh * 96 + 8 * i); q[4 * i] = v.x; q[4 * i + 1] = v.y; q[4 * i + 2] = v.z; q[4 * i + 3] = v.w; }
#pragma unroll
            for (int d = 0; d < 64; ++d) acc[d] = 0.f;
            float mx = -3.0e38f, den = 0.f;
            for (int s = 0; s < t0 + 64; ++s) {
                const bf16_t* kp = kvb + (rowb + s) * KVLD + hh * 160;
                const float z = dot_bf16_pk<96>(kp, q);
                const float mn = fmaxf(mx, z), corr = exp2f(mx - mn), pw = exp2f(z - mn);
                mx = mn; den = den * corr + pw;
                axpy_bf16<64>(acc, corr, pw, kp + 96);
            }
            const float inv = 1.f / den;
#pragma unroll
            for (int d = 0; d < 64; ++d) acc[d] *= inv;
            store_bf16_row<64>(o + (rowb + t) * DM + 256 + hh * 64, acc);
        } else {
            const int w2 = wi - 6144, n = w2 & 63, bh = w2 >> 6, b = bh >> 2, hh = bh & 3, t0 = n * 64, t = t0 + c.lane;
            const size_t rowb = (size_t)b * SEQ;
            float q[64], acc[64];
            load_bf16_row<64>(proj + (rowb + t) * PROJ_LD + PC_CKQ + hh * 64, q);
#pragma unroll
            for (int d = 0; d < 64; ++d) acc[d] = 0.f;
            float mx = -3.0e38f, den = 0.f;
            const int s_lo = (n - 8) * 64 < 0 ? 0 : (n - 8) * 64;
            for (int s = s_lo; s < t0 + 64; ++s) {
                float z = dot_bf16<64>(proj + (rowb + s) * PROJ_LD + PC_CKK + hh * 64, q);
                int rel = t - s; rel = rel < -128 ? -128 : rel > 128 ? 128 : rel;
                z += relb[hh * 257 + rel + 128] * 1.4426950408889634f;
                const float mn = fmaxf(mx, z), corr = exp2f(mx - mn), pw = exp2f(z - mn);
                mx = mn; den = den * corr + pw;
                axpy_bf16<64>(acc, corr, pw, proj + (rowb + s) * PROJ_LD + PC_CKV + hh * 64);
            }
            const float inv = 1.f / den;
#pragma unroll
            for (int d = 0; d < 64; ++d) acc[d] *= inv;
            store_bf16_row<64>(o + (rowb + t) * DM + 768 + hh * 64, acc);
        }
    }
}

DEVI void phase_mergenorm(const Ctx& c, const Params& p) {
    bf16_t* o = (bf16_t*)(p.ws + WS_H);
    for (int row = c.bid * 8 + c.wid; row < MTOK; row += c.nblk * 8) {
        bf16_t* orow = o + (size_t)row * DM + 16 * c.lane;
        float v[16]; load_bf16_row<16>(orow, v);
        float ss = 0.f;
#pragma unroll
        for (int i = 0; i < 16; ++i) ss += v[i] * v[i];
        ss = sum16(ss);
        const float s0 = __shfl(ss, 0, 64), s1 = __shfl(ss, 16, 64), s2 = __shfl(ss, 32, 64), s3 = __shfl(ss, 48, 64);
        const int g = c.lane >> 4;
        const float r = g == 0 ? rsqrtf(s0 * (1.f / 256.f) + EPS) : g == 3 ? rsqrtf(s3 * (1.f / 256.f) + EPS) : rsqrtf((s1 + s2) * (1.f / 512.f) + EPS);
#pragma unroll
        for (int i = 0; i < 16; ++i) v[i] *= r;
        store_bf16_row<16>(orow, v);
    }
}


DEVI void phase_fin2(const Ctx& c, const Params& p, int l) {
    bf16_t* __restrict__ kvb = (bf16_t*)(p.ws + WS_KV); bf16_t* __restrict__ proj = (bf16_t*)(p.ws + WS_PROJ);
    const float* __restrict__ cs = (const float*)(p.ws + WS_COS); const float* __restrict__ sn = (const float*)(p.ws + WS_SIN);
    const float* gq = p.in[I_QQK] + l * 96; const float* gk = p.in[I_KQK] + l * 96;
    const float* gcq = p.in[I_CKQN] + l * 64; const float* gck = p.in[I_CKKN] + l * 64;
    LAS float* wsm = (LAS float*)(c.ring + 131072) + c.wid * 32;
    const int lane = c.lane, hq = lane >> 3, p8 = lane & 7, pos0 = 12 * p8;
    float* __restrict__ alpha_arr = (float*)(p.ws + WS_ALPHA);
    float gkp[12];
#pragma unroll
    for (int j = 0; j < 12; ++j) { const int pos = pos0 + j, og = pos < 64 ? pos : 64 + ((pos - 64) >> 1) + 16 * ((pos - 64) & 1); gkp[j] = gk[og] * gq[og]; }
    const int dck = (4 * lane) & 63;
    float gck4[4];
#pragma unroll
    for (int j = 0; j < 4; ++j) gck4[j] = gck[dck + j] * gcq[dck + j];
#pragma unroll 1
    for (int row = c.bid * 8 + c.wid; row < MTOK; row += c.nblk * 8) {
        bf16_t* pr = proj + (size_t)row * PROJ_LD;
        bf16_t* kp = kvb + (size_t)row * KVLD + 160 * hq + pos0;
        bf16_t* vp = kvb + (size_t)row * KVLD + 160 * hq + 96 + 8 * p8;
        const uint2 cqv = *(const uint2*)(pr + PC_CQ + 4 * lane);
        const unsigned latv = *(const unsigned*)(pr + PC_LAT + 2 * lane);
        float x1 = 0.f, x2 = 0.f, co = 0.f, si = 0.f;
        if (lane < 16) { x1 = bf2f(pr[PC_KPE + lane]); x2 = bf2f(pr[PC_KPE + 16 + lane]); co = cs[row * 16 + lane]; si = sn[row * 16 + lane]; }
        uint2 kv[3];
#pragma unroll
        for (int t = 0; t < 3; ++t) { kv[t] = (pos0 + 4 * t < 64) ? *(const uint2*)(kp + 4 * t) : make_uint2(0u, 0u); }
        const uint4 vv = *(const uint4*)vp;
        const uint2 ckk = *(const uint2*)(pr + PC_CKK + 4 * lane);
        float a0 = lo16(cqv.x), a1 = hi16(cqv.x), a2 = lo16(cqv.y), a3 = hi16(cqv.y);
        const float alpha = rsqrtf(wave_sum(a0 * a0 + a1 * a1 + a2 * a2 + a3 * a3) * (1.f / 256.f) + EPS);
        a0 = lo16(latv); a1 = hi16(latv);
        const float beta = rsqrtf(wave_sum(a0 * a0 + a1 * a1) * (1.f / 128.f) + EPS);
        const float ss_pe = wave_sum(x1 * x1 + x2 * x2);
        if (lane < 16) { wsm[2 * lane] = x1 * co - x2 * si; wsm[2 * lane + 1] = x2 * co + x1 * si; }
        if (lane == 0) alpha_arr[row] = alpha;
        float k[12];
#pragma unroll
        for (int t = 0; t < 3; ++t) { k[4 * t] = lo16(kv[t].x); k[4 * t + 1] = hi16(kv[t].x); k[4 * t + 2] = lo16(kv[t].y); k[4 * t + 3] = hi16(kv[t].y); }
        float ssk = 0.f;
#pragma unroll
        for (int j = 0; j < 12; ++j) ssk += k[j] * k[j];
        ssk += __shfl_xor(ssk, 1, 64); ssk += __shfl_xor(ssk, 2, 64); ssk += __shfl_xor(ssk, 4, 64);
        const float rk = rsqrtf((beta * beta * ssk + ss_pe) * (1.f / 96.f) + EPS), rkb = rk * beta;
#pragma unroll
        for (int j = 0; j < 12; ++j) { const int pos = pos0 + j; k[j] = (pos < 64) ? k[j] * rkb * gkp[j] : wsm[pos >= 64 ? pos - 64 : 0] * rk * gkp[j]; }
#pragma unroll
        for (int t = 0; t < 3; ++t) { uint2 o; o.x = pk2(k[4 * t], k[4 * t + 1]); o.y = pk2(k[4 * t + 2], k[4 * t + 3]); *(uint2*)(kp + 4 * t) = o; }
        { uint4 o; o.x = pk2(lo16(vv.x) * beta, hi16(vv.x) * beta); o.y = pk2(lo16(vv.y) * beta, hi16(vv.y) * beta); o.z = pk2(lo16(vv.z) * beta, hi16(vv.z) * beta); o.w = pk2(lo16(vv.w) * beta, hi16(vv.w) * beta); *(uint4*)vp = o; }
        { float b0 = lo16(ckk.x), b1 = hi16(ckk.x), b2 = lo16(ckk.y), b3 = hi16(ckk.y);
          const float r = rsqrtf(sum16(b0 * b0 + b1 * b1 + b2 * b2 + b3 * b3) * (1.f / 64.f) + EPS);
          uint2 o; o.x = pk2(b0 * r * gck4[0], b1 * r * gck4[1]); o.y = pk2(b2 * r * gck4[2], b3 * r * gck4[3]); *(uint2*)(pr + PC_CKK + 4 * lane) = o; }
    }
}

DEVI void phase_mergenorm2(const Ctx& c, const Params& p) {
    bf16_t* o = (bf16_t*)(p.ws + WS_H);
#pragma unroll 1
    for (int row = (c.bid * 8 + c.wid) * 2; row < MTOK; row += c.nblk * 16) {
        uint4 raw[2][2];
#pragma unroll
        for (int q = 0; q < 2; ++q) { const uint4* rp = (const uint4*)(o + (size_t)(row + q) * DM + 16 * c.lane); raw[q][0] = rp[0]; raw[q][1] = rp[1]; }
#pragma unroll
        for (int q = 0; q < 2; ++q) {
            float v[16];
#pragma unroll
            for (int t = 0; t < 2; ++t) { const uint4 u = raw[q][t]; v[8 * t] = lo16(u.x); v[8 * t + 1] = hi16(u.x); v[8 * t + 2] = lo16(u.y); v[8 * t + 3] = hi16(u.y); v[8 * t + 4] = lo16(u.z); v[8 * t + 5] = hi16(u.z); v[8 * t + 6] = lo16(u.w); v[8 * t + 7] = hi16(u.w); }
            float ss = 0.f;
#pragma unroll
            for (int i = 0; i < 16; ++i) ss += v[i] * v[i];
            ss = sum16(ss);
            const float s0 = __shfl(ss, 0, 64), s1 = __shfl(ss, 16, 64), s2 = __shfl(ss, 32, 64), s3 = __shfl(ss, 48, 64);
            const int g = c.lane >> 4;
            const float r = g == 0 ? rsqrtf(s0 * (1.f / 256.f) + EPS) : g == 3 ? rsqrtf(s3 * (1.f / 256.f) + EPS) : rsqrtf((s1 + s2) * (1.f / 512.f) + EPS);
#pragma unroll
            for (int i = 0; i < 16; ++i) v[i] *= r;
            store_bf16_row<16>(o + (size_t)(row + q) * DM + 16 * c.lane, v);
        }
    }
}

DEVI void phase_route(const Ctx& c, const Params& p) {
    const int* cnt = (const int*)(p.ws + WS_CNT); const int* te = (const int*)(p.ws + WS_TOKE); const float* tw = (const float*)(p.ws + WS_TOKW);
    int* perm = (int*)(p.ws + WS_PERM); float* permw = (float*)(p.ws + WS_PERMW); int* texp = (int*)(p.ws + WS_TEXP);
    int* s_tot = (int*)c.sm; int* s_base = s_tot + 16; int* s_seg = s_tot + 32; int* s_e = s_tot + 64;
    for (int ch = c.bid; ch < MTOK / 128; ch += c.nblk) {
        __syncthreads();
        if (c.tid < 16) { int tot = 0, base = 0; for (int i = 0; i < MTOK / 128; ++i) { const int v = cnt[i * 16 + c.tid]; tot += v; base += (i < ch) ? v : 0; } s_tot[c.tid] = tot; s_base[c.tid] = base; }
        if (c.tid >= 64 && c.tid < 64 + 256) { const int i = c.tid - 64; s_e[i] = te[(ch * 128 + (i & 127)) * 2 + (i >> 7)]; }
        __syncthreads();
        if (c.tid < 2) { int a = 0; for (int e = 0; e < 8; ++e) { s_seg[c.tid * 8 + e] = a; a += (s_tot[c.tid * 8 + e] + 255) & ~255; } s_seg[16 + c.tid] = a; }
        __syncthreads();
        if (c.tid < 256) {
            const int s = c.tid >> 7, i = c.tid & 127, e = s_e[s * 128 + i];
            int rank = 0; for (int j = 0; j < i; ++j) rank += (s_e[s * 128 + j] == e);
            const int pos = s_seg[s * 8 + e] + s_base[s * 8 + e] + rank, tok = ch * 128 + i;
            perm[s * MOE_ROWS + pos] = tok; permw[s * MOE_ROWS + pos] = tw[tok * 2 + s];
        }
        if (ch == 0) {
            for (int s = 0; s < 2; ++s) {
                for (int e = 0; e < 8; ++e) {
                    const int beg = s_seg[s * 8 + e] + s_tot[s * 8 + e], end = s_seg[s * 8 + e] + ((s_tot[s * 8 + e] + 255) & ~255);
                    for (int q = beg + c.tid; q < end; q += 512) { perm[s * MOE_ROWS + q] = -1; permw[s * MOE_ROWS + q] = 0.f; }
                    const int t0 = s_seg[s * 8 + e] >> 8, t1 = end >> 8;
                    for (int t = t0 + c.tid; t < t1; t += 512) texp[s * MOE_TILES + t] = e;
                }
                if (c.tid == 0) texp[2 * MOE_TILES + s] = s_seg[16 + s] >> 8;
            }
        }
    }
}


DEVI void phase_moe_tail(const Ctx& c, const Params& p, const float* gate) {
    const int* texp = (const int*)(p.ws + WS_TEXP);
    const int ntl1 = texp[2 * MOE_TILES + 1];
    int q1 = ntl1 - (256 * 2) / 4; q1 = q1 < 0 ? 0 : q1 > 8 ? 8 : q1; if (c.nblk != 256) q1 = 0;
    const int* perm = (const int*)(p.ws + WS_PERM) + MOE_ROWS; const float* permw = (const float*)(p.ws + WS_PERMW) + MOE_ROWS;
    const bf16_t* xs2 = (const bf16_t*)(p.ws + WS_XS2); const float* part = (const float*)(p.ws + WS_PART);
    for (int row = c.bid * 8 + c.wid; row < q1 * 256; row += c.nblk * 8) {
        const int tok = perm[row]; if (tok < 0) continue;
        const float w = permw[row]; const float* gp = gate + (tok / SEQ) * 6144;
#pragma unroll
        for (int i = 0; i < 4; ++i) {
            const int col = 4 * (c.lane + 64 * i);
            const uint2 xv = *(const uint2*)(xs2 + (size_t)tok * DM + col);
            const size_t po = (size_t)row * DM + col; const size_t ps = (size_t)8 * 256 * DM;
            const f32x4 a = (*(const f32x4*)(part + po) + *(const f32x4*)(part + ps + po)) + (*(const f32x4*)(part + 2 * ps + po) + *(const f32x4*)(part + 3 * ps + po));
            const f32x4 g = *(const f32x4*)(gp + col);
            f32x4 o; o[0] = lo16(xv.x) + g[0] * w * a[0]; o[1] = hi16(xv.x) + g[1] * w * a[1]; o[2] = lo16(xv.y) + g[2] * w * a[2]; o[3] = hi16(xv.y) + g[3] * w * a[3];
            *(f32x4*)(p.out + (size_t)tok * DM + col) = o;
        }
    }
}

constexpr int NPHASE = 23;
constexpr int LDS_SM = 131072, LDS_XB = LDS_SM + 16640, LDS_BYTES = LDS_XB + 256;
template <int PH> DEVI void run_phase(const Ctx& c0, const Params& p, int repi = 0) {
    unsigned z_l = 0u; asm volatile("" : "+v"(z_l));
    int wid_l = c0.wid; asm volatile("" : "+s"(wid_l));
    const int lane_l = (int)__builtin_amdgcn_mbcnt_hi(~0u, __builtin_amdgcn_mbcnt_lo(~0u, z_l));
    Ctx c; c.tid = wid_l * 64 + lane_l; c.lane = lane_l; c.wid = wid_l; c.bid = c0.bid; c.nblk = c0.nblk; c.sm = c0.sm; c.ring = c0.ring;
    constexpr int l = PH >= 10 ? 1 : 0;
    constexpr int r = PH == 0 ? -1 : (l == 0 ? PH - 1 : PH - 10);
    unsigned char* ws = p.ws;
    const float* modl = (const float*)(ws + WS_MOD) + l * 8 * 6144;
    bf16_t* H = (bf16_t*)(ws + WS_H); bf16_t* PROJ = (bf16_t*)(ws + WS_PROJ); bf16_t* Q = (bf16_t*)(ws + WS_Q); bf16_t* KV = (bf16_t*)(ws + WS_KV); bf16_t* HID = (bf16_t*)(ws + WS_HID);
    void* XS = (void*)p.out; void* XS2 = (void*)(ws + WS_XS2);
    if constexpr (PH == 0) phase_prologue(c, p, repi);
    else if constexpr (r == 0) { if constexpr (l == 0) phase_norm<false, false>(c, p, p.in[I_X], p.in[I_NMIX] + l * DM, modl, modl + 1024); else phase_norm<false, true>(c, p, XS, p.in[I_NMIX] + l * DM, modl, modl + 1024); }
    else if constexpr (r == 1) {
        pg8::ProbPlain P{H, (const bf16_t*)(ws + WS_WIN) + (size_t)l * 2048 * 1024, 1024, 1024, 1024, {}}; P.S.init(MTOK / 256, 8, c.nblk, c.bid);
        pg8::gemm_phase(c.ring, P, pg8::EpiStoreT{PROJ, PROJ_LD, nullptr, 0, 1 << 30}, c.tid);
    } else if constexpr (r == 2) {
        pg8::ProbUp P{PROJ + PC_CQ, PROJ + PC_LAT, (const bf16_t*)(ws + WS_WQ) + (size_t)l * 768 * 256, (const bf16_t*)(ws + WS_WKV) + (size_t)l * 1280 * 256, PROJ_LD, 256, 256, {}};
        P.S.init(MTOK / 256, 8, c.nblk, c.bid);
        pg8::gemm_phase(c.ring, P, pg8::EpiStoreT{Q, QLD, KV, KVLD, 3}, c.tid);
    } else if constexpr (r == 3) phase_fin2(c, p, l);
    else if constexpr (r == 4) att::phase(c, p, l + 2 * repi);
    else if constexpr (r == 5) {
        pg8::ProbPlain P{H, (const bf16_t*)(ws + WS_WOUT) + (size_t)l * 1024 * 1024, 1024, 1024, 1024, {}}; P.S.init(MTOK / 256, 4, c.nblk, c.bid);
        {
            const float* ssh = (const float*)(ws + WS_SSH); float* rat = (float*)(ws + WS_RAT);
            pg8::Unit u;
            for (int ui = 0; P.next(ui, u); ++ui) if (c.tid < 256) {
                const size_t row = (size_t)u.pm * 256 + c.tid; const float* sp = ssh + row * 16;
                const f32x4 a = *(const f32x4*)sp, b = *(const f32x4*)(sp + 4), c2 = *(const f32x4*)(sp + 8), d = *(const f32x4*)(sp + 12);
                const float s1 = (a[0] + a[1]) + (a[2] + a[3]), s2 = ((b[0] + b[1]) + (b[2] + b[3])) + ((c2[0] + c2[1]) + (c2[2] + c2[3])), s3 = (d[0] + d[1]) + (d[2] + d[3]);
                const float q1 = rsqrtf(s1 * (1.f / 256.f) + EPS), q2 = rsqrtf(s2 * (1.f / 512.f) + EPS), q3 = rsqrtf(s3 * (1.f / 256.f) + EPS);
                *(f32x4*)(rat + row * 4) = (f32x4){q1 / q2, q2 / q3, q3, 0.f};
            }
            asm volatile("s_waitcnt vmcnt(0)" ::: "memory"); __syncthreads();
        }
        if constexpr (l == 0) pg8::gemm_phase<pg8::EpiResidT<false, true>, pg8::ProbPlain, false, true, pg8::GroupRowScale>(c.ring, P, pg8::EpiResidT<false, true>{p.in[I_X], XS, modl + 2048}, c.tid, pg8::GroupRowScale{(const float*)(ws + WS_RAT)});
        else pg8::gemm_phase<pg8::EpiResidT<true, true>, pg8::ProbPlain, false, true, pg8::GroupRowScale>(c.ring, P, pg8::EpiResidT<true, true>{XS, XS, modl + 2048}, c.tid, pg8::GroupRowScale{(const float*)(ws + WS_RAT)});
    } else if constexpr (r == 6) phase_norm<(l == 1), true>(c, p, XS, p.in[I_NFFN] + l * DM, modl + 3072, modl + 4096);
    else if constexpr (l == 0 && r == 7) {
        pg8::ProbPlain P{H, (const bf16_t*)(ws + WS_FGU), 1024, 1024, 1024, {}}; P.S.init(MTOK / 256, 22, c.nblk, c.bid);
        pg8::gemm_phase(c.ring, P, pg8::EpiSwigluT{HID}, c.tid);
    } else if constexpr (l == 0 && r == 8) {
        pg8::ProbPlain P{HID, (const bf16_t*)(ws + WS_FD), DFF, DFF, DFF, {}}; P.S.init(MTOK / 256, 4, c.nblk, c.bid);
        pg8::gemm_phase(c.ring, P, pg8::EpiResidT<true, true>{XS, XS, modl + 5120}, c.tid);
    } else if constexpr (l == 1 && r == 7) phase_route(c, p);
    else if constexpr (l == 1 && r == 12) phase_moe_tail(c, p, modl + 5120);
    else {
        constexpr int s = (r - 8) >> 1;
        const int* perm = (const int*)(ws + WS_PERM) + s * MOE_ROWS; const float* permw = (const float*)(ws + WS_PERMW) + s * MOE_ROWS;
        const int* texp = (const int*)(ws + WS_TEXP);
        const int ntl0 = texp[2 * MOE_TILES + 0];
        int q0 = ntl0 - (256 * 2) / 4; q0 = q0 < 0 ? 0 : q0 > 8 ? 8 : q0; if (c.nblk != 256) q0 = 0;
        const int ntl1 = texp[2 * MOE_TILES + 1];
        int q1 = ntl1 - (256 * 2) / 4; q1 = q1 < 0 ? 0 : q1 > 8 ? 8 : q1; if (c.nblk != 256) q1 = 0;
        bf16_t* HIDs = HID + (size_t)(s * 8) * 256 * DFF;
        int mx = 0;
        if (c.nblk == 256) { const int nw0 = 22 * ntl0, spare = ((nw0 + 255) / 256) * 256 - nw0; mx = spare / 22; int lim = ntl1 - ntl0 + 8; lim = lim < 0 ? 0 : lim; mx = mx > lim ? lim : mx; mx = mx > ntl1 ? ntl1 : mx; }
        if constexpr (((r - 8) & 1) == 0) {
            const int ntl = (s == 0) ? ntl0 : ntl1 - mx;
            if (s == 1 && c.bid >= c.nblk - 4 * q0) {
                const int k = c.bid - (c.nblk - 4 * q0);
                pg8::ProbMoeT<pg8::OneUnit> P{HID, (const bf16_t*)(ws + WS_MD), DFF, DFF, DFF, {k >> 2, k & 3}, texp, (size_t)1024 * DFF, nullptr, 0};
                pg8::gemm_phase(c.ring, P, pg8::EpiMoeDownT<true>{XS, XS2, modl + 5120, (const int*)(ws + WS_PERM), (const float*)(ws + WS_PERMW)}, c.tid);
                __syncthreads();
            }
            LAS unsigned* tab = (LAS unsigned*)(c.ring + 131072);
            pg8::ProbMoeT<pg8::SkipOrder> P{H, (const bf16_t*)(ws + WS_MGU), 1024, 1024, 1024, {{}, (s == 1) ? 4 * q0 : 0, 3, (s == 0) ? mx : 0, MOE_TILES + ntl1 - mx}, texp + s * MOE_TILES, (size_t)5632 * 1024, tab, 0};
            P.S.base.init(ntl, 22, c.nblk, c.bid);
            { pg8::Unit u; for (int ui = 0; ui < 16 && P.next(ui, u); ++ui) if (c.tid < 256) { const int tok = perm[u.pm * 256 + c.tid]; tab[ui * 256 + c.tid] = (unsigned)(tok < 0 ? 0 : tok) * 2048u; } }
            __syncthreads();
            pg8::gemm_phase<pg8::EpiSwigluT, pg8::ProbMoeT<pg8::SkipOrder>, true>(c.ring, P, pg8::EpiSwigluT{HIDs, MOE_TILES, 8 - MOE_TILES}, c.tid);
        } else {
            const int ntl = texp[2 * MOE_TILES + s], qo = (s == 0) ? q0 : q1;
            pg8::ProbMoeT<pg8::StaticOrder> P{HIDs, (const bf16_t*)(ws + WS_MD), DFF, DFF, DFF, {}, texp + s * MOE_TILES, (size_t)1024 * DFF, nullptr, qo};
            P.S.init(ntl - qo, 4, c.nblk, c.bid);
            if constexpr (s == 0) pg8::gemm_phase(c.ring, P, pg8::EpiMoeDownT<true>{XS, XS2, modl + 5120, perm, permw}, c.tid);
            else {
                pg8::gemm_phase(c.ring, P, pg8::EpiMoeDownT<false>{XS2, (void*)p.out, modl + 5120, perm, permw}, c.tid);
                if (q1 > 0) {
                    __syncthreads();
                    pg8::ProbSplitK4 PS{HIDs, (const bf16_t*)(ws + WS_MD), DFF, DFF, DFF, texp + s * MOE_TILES, (size_t)1024 * DFF, 16 * q1, c.nblk, c.bid};
                    pg8::gemm_phase(c.ring, PS, pg8::EpiPartialT{(float*)(ws + WS_PART), 8 * 256}, c.tid);
                }
            }
        }
    }
}
template <int PH, int HI> DEVI void run_range(const Ctx& c, const Params& p, const XcdBarrier& bar) {
    if constexpr (PH < HI) {
        run_phase<PH>(c, p);
        if constexpr ((REP_MASK >> PH) & 1u) { xcd_barrier(bar); run_phase<PH>(c, p, 1); }
        if constexpr (PROBE_TYPES != 0 && PH == 5) { xcd_barrier(bar); Ctx cc = c; cc.tid = threadIdx.x; cc.lane = threadIdx.x & 63; cc.wid = __builtin_amdgcn_readfirstlane(threadIdx.x >> 6); att::phase_probe(cc, p, 0); }
        if constexpr (PH + 1 < HI) { xcd_barrier(bar); run_range<PH + 1, HI>(c, p, bar); }
    }
}

template <int LO, int HI>
__global__ void __launch_bounds__(512, 2) mega_kernel(Params p) {
    extern __shared__ __attribute__((aligned(16))) unsigned char lds[];
    Ctx c; c.bid = blockIdx.x; c.nblk = gridDim.x; c.tid = threadIdx.x; c.lane = threadIdx.x & 63; c.wid = __builtin_amdgcn_readfirstlane(threadIdx.x >> 6);
    c.ring = (LAS unsigned char*)lds; c.sm = (float*)(lds + LDS_SM);
    volatile LAS unsigned* xbw = (volatile LAS unsigned*)((LAS unsigned char*)lds + LDS_XB);
    if (threadIdx.x < 4) xbw[threadIdx.x] = 0u;
    __syncthreads();
    unsigned* barw = (unsigned*)(p.ws + WS_CTL);
    XcdBarrier bar; bar.bar = barw; bar.x = 0; bar.st = xbw;
    if constexpr (HI - LO > 1) bar = xcd_barrier_post(barw, xbw);
    run_range<LO, HI>(c, p, bar);
}

template <int K> static void launch_each(int grid, hipStream_t stream, const Params& p) {
    if constexpr (K < NPHASE) {
        (void)hipFuncSetAttribute((const void*)mega_kernel<K, K + 1>, hipFuncAttributeMaxDynamicSharedMemorySize, LDS_BYTES);
        hipLaunchKernelGGL((mega_kernel<K, K + 1>), dim3(grid), dim3(512), LDS_BYTES, stream, p);
        launch_each<K + 1>(grid, stream, p);
    }
}

extern "C" void kernel_launch(void* const* d_in, const int* in_sizes, int n_in, void* d_out, int out_size, void* d_ws, size_t ws_size, hipStream_t stream) {
    (void)in_sizes; (void)out_size;
    if (n_in < 26 || ws_size < WS_END) { fprintf(stderr, "kernel_launch: bad sizes n_in=%d ws=%zu\n", n_in, ws_size); return; }
    static int grid = 0;
    if (!grid) {
        int dev = 0, cus = 0;
        (void)hipGetDevice(&dev);
        (void)hipDeviceGetAttribute(&cus, hipDeviceAttributeMultiprocessorCount, dev);
        grid = cus;
        if (grid > 256 || grid < 1) grid = 256;
    }
    (void)hipMemsetAsync((unsigned char*)d_ws + WS_CTL, 0, CTL_BYTES, stream);
    Params p{};
    for (int i = 0; i < 26; ++i) p.in[i] = (const float*)d_in[i];
    p.out = (float*)d_out; p.ws = (unsigned char*)d_ws;
#if ONE_LAUNCH
    (void)hipFuncSetAttribute((const void*)mega_kernel<0, NPHASE>, hipFuncAttributeMaxDynamicSharedMemorySize, LDS_BYTES);
    hipLaunchKernelGGL((mega_kernel<0, NPHASE>), dim3(grid), dim3(512), LDS_BYTES, stream, p);
#else
    launch_each<0>(grid, stream, p);
#endif
}
```

```cpp
#include <hip/hip_runtime.h>
#include <stdint.h>
#include <stdio.h>

#ifndef REP_MASK
#define REP_MASK 0u
#endif
#ifndef ONE_LAUNCH
#define ONE_LAUNCH 1
#endif

#define DEVI __device__ __forceinline__
#define LAS __attribute__((address_space(3)))
typedef unsigned short bf16_t;
typedef short bf16x8 __attribute__((ext_vector_type(8)));
typedef float f32x4 __attribute__((ext_vector_type(4)));

constexpr int NB = 8, SEQ = 4096, DM = 1024, MTOK = NB * SEQ;
constexpr int INC = 1952;
constexpr int PROJ_LD = 2048;
constexpr int DFF = 2816, NEXP = 8;
constexpr int QLD = 768;
constexpr int KVLD = 1280;
constexpr float EPS = 1e-6f;
constexpr int PC_SBQ = 0, PC_SBK = 256, PC_SBV = 512, PC_CQ = 768, PC_CKQ = 1024, PC_CKK = 1280, PC_CKV = 1536, PC_LAT = 1792, PC_KPE = 1920;
constexpr int MOE_TILES = 136;
constexpr int WS_BND_WORD = 12288;
constexpr float att_L2E = 1.4426950408889634f;
constexpr int MOE_ROWS = MOE_TILES * 256;

constexpr size_t MiB = 1u << 20;
constexpr size_t WS_CTL = 0, CTL_BYTES = 64 * 1024;
constexpr size_t WS_MOD = 1 * MiB;
constexpr size_t WS_COS = 2 * MiB, WS_SIN = 4 * MiB;
constexpr size_t WS_TOKE = 6 * MiB;
constexpr size_t WS_TOKW = 6 * MiB + 256 * 1024;
constexpr size_t WS_CNT = 6 * MiB + 512 * 1024;
constexpr size_t WS_PERM = 6 * MiB + 640 * 1024;
constexpr size_t WS_PERMW = 7 * MiB;
constexpr size_t WS_TEXP = 7 * MiB + 512 * 1024;
constexpr size_t WS_WIN = 8 * MiB;
constexpr size_t WS_WQ = 16 * MiB;
constexpr size_t WS_WKV = 17 * MiB;
constexpr size_t WS_WOUT = 19 * MiB;
constexpr size_t WS_FGU = 23 * MiB;
constexpr size_t WS_FD = 34 * MiB;
constexpr size_t WS_MGU = 40 * MiB;
constexpr size_t WS_MD = 128 * MiB;
constexpr size_t WS_H = 172 * MiB;
constexpr size_t WS_PROJ = 236 * MiB;
constexpr size_t WS_Q = 364 * MiB;
constexpr size_t WS_KV = 412 * MiB;
constexpr size_t WS_HID = 236 * MiB;
constexpr size_t WS_SSH = 492 * MiB;
constexpr size_t WS_RAT = 494 * MiB;
constexpr size_t WS_ALPHA = 494 * MiB + 512 * 1024;
constexpr size_t WS_XS2 = 440 * MiB;
constexpr size_t WS_PART = 172 * MiB;
constexpr size_t WS_END = 504 * MiB;
static_assert(WS_HID + (size_t)MOE_ROWS * DFF * 2 <= WS_END, "hid fits");
static_assert(WS_KV + (size_t)MTOK * KVLD * 2 <= WS_END, "kv fits");

DEVI float bf2f(bf16_t v) { return __builtin_bit_cast(float, (unsigned)v << 16); }
DEVI bf16_t f2bf(float f) { unsigned u = __builtin_bit_cast(unsigned, f); return (bf16_t)((u + 0x7fffu + ((u >> 16) & 1u)) >> 16); }
DEVI unsigned pk2(float lo, float hi) { return (unsigned)f2bf(lo) | ((unsigned)f2bf(hi) << 16); }
DEVI float lo16(unsigned u) { return __builtin_bit_cast(float, u << 16); }
DEVI float hi16(unsigned u) { return __builtin_bit_cast(float, u & 0xffff0000u); }
DEVI float wave_sum(float v) {
#pragma unroll
    for (int o = 32; o; o >>= 1) v += __shfl_xor(v, o, 64);
    return v;
}
DEVI float sum16(float v) {
#pragma unroll
    for (int o = 8; o; o >>= 1) v += __shfl_xor(v, o, 64);
    return v;
}
template <int N> DEVI void load_bf16_row(const bf16_t* p, float (&out)[N]) {
#pragma unroll
    for (int i = 0; i < N / 8; ++i) {
        const uint4 v = *(const uint4*)(p + 8 * i);
        out[8 * i + 0] = lo16(v.x); out[8 * i + 1] = hi16(v.x); out[8 * i + 2] = lo16(v.y); out[8 * i + 3] = hi16(v.y);
        out[8 * i + 4] = lo16(v.z); out[8 * i + 5] = hi16(v.z); out[8 * i + 6] = lo16(v.w); out[8 * i + 7] = hi16(v.w);
    }
}
template <int N> DEVI void store_bf16_row(bf16_t* p, const float (&v)[N]) {
#pragma unroll
    for (int i = 0; i < N / 8; ++i) {
        uint4 o; o.x = pk2(v[8 * i], v[8 * i + 1]); o.y = pk2(v[8 * i + 2], v[8 * i + 3]); o.z = pk2(v[8 * i + 4], v[8 * i + 5]); o.w = pk2(v[8 * i + 6], v[8 * i + 7]);
        *(uint4*)(p + 8 * i) = o;
    }
}

template <int N> DEVI float dot_bf16(const bf16_t* p, const float (&q)[N]) {
    float z0 = 0.f, z1 = 0.f;
#pragma unroll
    for (int i = 0; i < N / 8; ++i) {
        const uint4 v = *(const uint4*)(p + 8 * i);
        z0 += q[8 * i + 0] * lo16(v.x); z1 += q[8 * i + 1] * hi16(v.x); z0 += q[8 * i + 2] * lo16(v.y); z1 += q[8 * i + 3] * hi16(v.y);
        z0 += q[8 * i + 4] * lo16(v.z); z1 += q[8 * i + 5] * hi16(v.z); z0 += q[8 * i + 6] * lo16(v.w); z1 += q[8 * i + 7] * hi16(v.w);
    }
    return z0 + z1;
}
template <int N> DEVI void axpy_bf16(float (&acc)[N], float corr, float w, const bf16_t* p) {
#pragma unroll
    for (int i = 0; i < N / 8; ++i) {
        const uint4 v = *(const uint4*)(p + 8 * i);
        acc[8 * i + 0] = acc[8 * i + 0] * corr + w * lo16(v.x); acc[8 * i + 1] = acc[8 * i + 1] * corr + w * hi16(v.x);
        acc[8 * i + 2] = acc[8 * i + 2] * corr + w * lo16(v.y); acc[8 * i + 3] = acc[8 * i + 3] * corr + w * hi16(v.y);
        acc[8 * i + 4] = acc[8 * i + 4] * corr + w * lo16(v.z); acc[8 * i + 5] = acc[8 * i + 5] * corr + w * hi16(v.z);
        acc[8 * i + 6] = acc[8 * i + 6] * corr + w * lo16(v.w); acc[8 * i + 7] = acc[8 * i + 7] * corr + w * hi16(v.w);
    }
}

template <int N> DEVI float dot_bf16_pk(const bf16_t* p, const unsigned (&q)[N / 2]) {
    float z0 = 0.f, z1 = 0.f;
#pragma unroll
    for (int i = 0; i < N / 8; ++i) {
        const uint4 v = *(const uint4*)(p + 8 * i);
        z0 += lo16(q[4 * i + 0]) * lo16(v.x); z1 += hi16(q[4 * i + 0]) * hi16(v.x); z0 += lo16(q[4 * i + 1]) * lo16(v.y); z1 += hi16(q[4 * i + 1]) * hi16(v.y);
        z0 += lo16(q[4 * i + 2]) * lo16(v.z); z1 += hi16(q[4 * i + 2]) * hi16(v.z); z0 += lo16(q[4 * i + 3]) * lo16(v.w); z1 += hi16(q[4 * i + 3]) * hi16(v.w);
    }
    return z0 + z1;
}

#define XB_TMO      128
#define XB_XCNT(j)  (256  + 64 * (j))
#define XB_XSUB(j)  (1280 + 64 * (j))
#define XB_XGEN(j)  (2304 + 64 * (j))
#define XB_TOP      3328
#define XB_TOPGEN   3392
#define XCD_BAR_WORDS 3456
#define XB_SPIN_CAP (1u << 24)
DEVI unsigned xb_ld(unsigned* p)              { return __hip_atomic_load(p, __ATOMIC_RELAXED, __HIP_MEMORY_SCOPE_AGENT); }
DEVI unsigned xb_add(unsigned* p, unsigned v) { return __hip_atomic_fetch_add(p, v, __ATOMIC_RELAXED, __HIP_MEMORY_SCOPE_AGENT); }
DEVI unsigned xb_xcc_id() { return (unsigned)__builtin_amdgcn_s_getreg((3 << 11) | 20) & 0xFu; }
#define XB_SPIN(cond, bar) do { unsigned _sp = 0; while (cond) { __builtin_amdgcn_s_sleep(1); \
    if ((++_sp & 255u) == 0u) { if (xb_ld(&(bar)[XB_TMO])) break; if (_sp > XB_SPIN_CAP) { atomicAdd(&(bar)[XB_TMO], 1u); break; } } } } while (0)
struct XcdBarrier { unsigned* bar; unsigned x; volatile LAS unsigned* st; };
DEVI XcdBarrier xcd_barrier_post(unsigned* bar, volatile LAS unsigned* st) {
    XcdBarrier b; b.bar = bar; b.x = xb_xcc_id(); b.st = st;
    if (threadIdx.x == 0) (void)xb_add(&bar[XB_XCNT(b.x)], 1u);
    return b;
}
DEVI void xcd_barrier_complete(unsigned* bar, unsigned x, unsigned& nloc, unsigned& nx) {
    const unsigned G = gridDim.x * gridDim.y * gridDim.z;
    unsigned sum, cnt, mine, sp = 0u;
    for (;;) {
        sum = 0u; cnt = 0u; mine = 0u;
#pragma unroll
        for (unsigned j = 0; j < 16; ++j) { const unsigned c = xb_ld(&bar[XB_XCNT(j)]); sum += c; cnt += (c > 0u) ? 1u : 0u; mine = (j == x) ? c : mine; }
        if (sum == G) break;
        __builtin_amdgcn_s_sleep(1);
        if ((++sp & 255u) == 0u) { if (xb_ld(&bar[XB_TMO])) break; if (sp > XB_SPIN_CAP) { atomicAdd(&bar[XB_TMO], 1u); break; } }
    }
    nloc = mine > 0u ? mine : 1u; nx = cnt > 0u ? cnt : 1u;
}
DEVI void xcd_barrier(const XcdBarrier& b) {
    asm volatile("s_waitcnt vmcnt(0)" ::: "memory");
    __syncthreads();
    if (threadIdx.x == 0) {
        unsigned* bar = b.bar;
        __builtin_amdgcn_s_waitcnt(0);
        unsigned nloc = b.st[0], nx = b.st[1];
        if (nloc == 0u) { xcd_barrier_complete(bar, b.x, nloc, nx); b.st[0] = nloc; b.st[1] = nx; }
        const unsigned old = xb_add(&bar[XB_XSUB(b.x)], 1u);
        const unsigned gen = old / nloc;
        if (old + 1u == (gen + 1u) * nloc) {
            __builtin_amdgcn_fence(__ATOMIC_RELEASE, "agent");
            asm volatile("s_waitcnt vmcnt(0)" ::: "memory");
            const unsigned og = xb_add(&bar[XB_TOP], 1u);
            const unsigned tg = og / nx;
            if (og + 1u == (tg + 1u) * nx) xb_add(&bar[XB_TOPGEN], 1u);
            else XB_SPIN(xb_ld(&bar[XB_TOPGEN]) == tg, bar);
            __builtin_amdgcn_fence(__ATOMIC_ACQUIRE, "agent");
            xb_add(&bar[XB_XGEN(b.x)], 1u);
            asm volatile("s_waitcnt vmcnt(0)" ::: "memory");
        } else {
            XB_SPIN(xb_ld(&bar[XB_XGEN(b.x)]) == gen, bar);
            __builtin_amdgcn_fence(__ATOMIC_ACQUIRE, "agent");
            asm volatile("s_waitcnt vmcnt(0)" ::: "memory");
        }
    }
    __syncthreads();
}

struct Params {
    const float* in[26];
    float* out;
    unsigned char* ws;
};
enum { I_X = 0, I_C, I_POS, I_ADAW, I_ADAB, I_NMIX, I_NFFN, I_WIN, I_QNORM, I_WQUP, I_KVNORM, I_WKVUP, I_QQK, I_KQK, I_CKQN, I_CKKN, I_RELB, I_GON, I_WOUT,
       I_FG, I_FU, I_FD, I_ROUTER, I_MG, I_MU, I_MD };

struct Ctx {
    int bid, nblk, tid, lane, wid;
    float* sm;
    LAS unsigned char* ring;
};

enum { MAP_ID = 0, MAP_WIN, MAP_KV, MAP_GU };
template <int MAP>
DEVI void conv_job(const Ctx& c, const float* src, const float* src2, int src_ld, int Ksrc, const float* gain, bf16_t* dst, int Kdst, int nrows) {
    const int nrb = nrows / 32, nkb = Kdst / 64, total = nrb * nkb;
    float* tile = c.sm;
    for (int it = c.bid; it < total; it += c.nblk) {
        const int rb = it / nkb, kb = it % nkb, k0 = kb * 64;
        const float* s = src; int col = rb * 32;
        if (MAP == MAP_WIN) { const int r = rb * 32; col = r < 1024 ? r : r < 1792 ? 1184 + (r - 1024) : r < 1920 ? 1024 + (r - 1792) : r < 1952 ? 1152 : -1; }
        if (MAP == MAP_KV) { const int r = rb * 32, h = r / 160, o = r % 160; col = o < 64 ? 128 * h + o : o < 96 ? -1 : 128 * h + 64 + (o - 96); }
        if (MAP == MAP_GU) { const int t = rb >> 3, sb = rb & 7; s = (sb >> 2) ? src2 : src; col = 128 * t + 32 * (sb & 3); }
        for (int e = c.tid; e < 2048; e += 512) {
            const int kk = e >> 5, j = e & 31, k = k0 + kk;
            float v = 0.f;
            if (col >= 0 && k < Ksrc) { v = s[(size_t)k * src_ld + col + j]; if (gain) v *= gain[k]; }
            tile[kk * 33 + j] = v;
        }
        __syncthreads();
        for (int e = c.tid; e < 1024; e += 512) {
            const int j = e >> 5, kp = e & 31;
            *(unsigned*)(dst + (size_t)(rb * 32 + j) * Kdst + k0 + 2 * kp) = pk2(tile[(2 * kp) * 33 + j], tile[(2 * kp + 1) * 33 + j]);
        }
        __syncthreads();
    }
}


enum { MAP_Q = 4 };
template <int MAP>
DEVI void conv_job2(const Ctx& c, const float* __restrict__ src, const float* __restrict__ src2, int src_ld, int Ksrc, const float* __restrict__ gain, bf16_t* __restrict__ dst, int Kdst, int nrows) {
    const int nrb = nrows / 64, nkb = Kdst / 64, total = nrb * nkb;
    for (int it = c.bid * 8 + c.wid; it < total; it += c.nblk * 8) {
        const int kb = it / nrb, rb = it % nrb, n = rb * 64 + c.lane, k0 = kb * 64;
        const float* sp = src; int col = n;
        if (MAP == MAP_WIN) col = n < 1024 ? n : n < 1792 ? 1184 + (n - 1024) : n < 1920 ? 1024 + (n - 1792) : n < 1952 ? 1152 + (n - 1920) : -1;
        if (MAP == MAP_KV) { const int h = n / 160, o = n % 160; col = o < 64 ? 128 * h + o : o < 96 ? -1 : 128 * h + 64 + (o - 96); }
        if (MAP == MAP_GU) { const int t = n >> 8, r = n & 255; sp = (r >> 7) ? src2 : src; col = 128 * t + (r & 127); }
        if (MAP == MAP_Q) { const int h = n / 96, pos = n % 96; col = 96 * h + (pos < 64 ? pos : 64 + ((pos - 64) >> 1) + 16 * ((pos - 64) & 1)); }
        const bool live = (col >= 0);
        sp += live ? col : 0;
        bf16_t* dp = dst + (size_t)n * Kdst + k0;
        float v[64];
        if (live) {
#pragma unroll
            for (int j = 0; j < 64; ++j) v[j] = (k0 + j < Ksrc) ? __builtin_nontemporal_load(sp + (size_t)(k0 + j) * src_ld) : 0.f;
            if (gain) {
#pragma unroll
                for (int j = 0; j < 64; ++j) v[j] *= (k0 + j < Ksrc) ? gain[k0 + j] : 0.f;
            }
        } else {
#pragma unroll
            for (int j = 0; j < 64; ++j) v[j] = 0.f;
        }
#pragma unroll
        for (int k8 = 0; k8 < 8; ++k8) {
            uint4 o; o.x = pk2(v[8 * k8], v[8 * k8 + 1]); o.y = pk2(v[8 * k8 + 2], v[8 * k8 + 3]); o.z = pk2(v[8 * k8 + 4], v[8 * k8 + 5]); o.w = pk2(v[8 * k8 + 6], v[8 * k8 + 7]);
            *(uint4*)(dp + k8 * 8) = o;
        }
    }
}

template <int MAP>
DEVI void conv_job3(const Ctx& c, const float* __restrict__ src, const float* __restrict__ src2, int src_ld, int Ksrc, const float* __restrict__ gain, bf16_t* __restrict__ dst, int Kdst, int nrows) {
    const int nrb = nrows / 256, nkb = Kdst / 16, total = nrb * nkb;
    for (int it = c.bid * 8 + c.wid; it < total; it += c.nblk * 8) {
        const int kb = it % nkb, rb = it / nkb, n = rb * 256 + 4 * c.lane, k0 = kb * 16;
        const float* sp = src; int col = n;
        if (MAP == MAP_WIN) col = n < 1024 ? n : n < 1792 ? 1184 + (n - 1024) : n < 1920 ? 1024 + (n - 1792) : n < 1952 ? 1152 + (n - 1920) : -1;
        if (MAP == MAP_KV) { const int h = n / 160, o = n % 160; col = o < 64 ? 128 * h + o : o < 96 ? -1 : 128 * h + 64 + (o - 96); }
        if (MAP == MAP_GU) { const int t = n >> 8, r = n & 255; sp = (r >> 7) ? src2 : src; col = 128 * t + (r & 127); }
        const bool live = (col >= 0) && (k0 < Ksrc);
        f32x4 v[16];
        if (live) {
            sp += col;
#pragma unroll
            for (int j = 0; j < 16; ++j) v[j] = __builtin_nontemporal_load((const f32x4*)(sp + (size_t)(k0 + j) * src_ld));
            if (gain) {
#pragma unroll
                for (int j = 0; j < 16; ++j) v[j] *= gain[k0 + j];
            }
        } else {
#pragma unroll
            for (int j = 0; j < 16; ++j) v[j] = (f32x4){0.f, 0.f, 0.f, 0.f};
        }
#pragma unroll
        for (int i = 0; i < 4; ++i) {
            uint4 o0, o1;
            o0.x = pk2(v[0][i], v[1][i]); o0.y = pk2(v[2][i], v[3][i]); o0.z = pk2(v[4][i], v[5][i]); o0.w = pk2(v[6][i], v[7][i]);
            o1.x = pk2(v[8][i], v[9][i]); o1.y = pk2(v[10][i], v[11][i]); o1.z = pk2(v[12][i], v[13][i]); o1.w = pk2(v[14][i], v[15][i]);
            bf16_t* dp = dst + (size_t)(n + i) * Kdst + k0;
            *(uint4*)dp = o0; *(uint4*)(dp + 8) = o1;
        }
    }
}

template <int MAP>
DEVI void conv_rowblock(const Ctx& c, const float* __restrict__ src, const float* __restrict__ src2, int src_ld, int Ksrc, const float* __restrict__ gain, bf16_t* __restrict__ dst, int Kdst, int rb) {
    const int nkb = Kdst / 16;
    for (int kb = c.wid; kb < nkb; kb += 8) {
        const int n = rb * 256 + 4 * c.lane, k0 = kb * 16;
        const float* sp = src; int col = n;
        if (MAP == MAP_WIN) col = n < 1024 ? n : n < 1792 ? 1184 + (n - 1024) : n < 1920 ? 1024 + (n - 1792) : n < 1952 ? 1152 + (n - 1920) : -1;
        if (MAP == MAP_KV) { const int h = n / 160, o = n % 160; col = o < 64 ? 128 * h + o : o < 96 ? -1 : 128 * h + 64 + (o - 96); }
        if (MAP == MAP_GU) { const int t = n >> 8, r = n & 255; sp = (r >> 7) ? src2 : src; col = 128 * t + (r & 127); }
        const bool live = (col >= 0) && (k0 < Ksrc);
        f32x4 v[16];
        if (live) {
            sp += col;
#pragma unroll
            for (int j = 0; j < 16; ++j) v[j] = __builtin_nontemporal_load((const f32x4*)(sp + (size_t)(k0 + j) * src_ld));
            if (gain) {
#pragma unroll
                for (int j = 0; j < 16; ++j) v[j] *= gain[k0 + j];
            }
        } else {
#pragma unroll
            for (int j = 0; j < 16; ++j) v[j] = (f32x4){0.f, 0.f, 0.f, 0.f};
        }
#pragma unroll
        for (int i = 0; i < 4; ++i) {
            uint4 o0, o1;
            o0.x = pk2(v[0][i], v[1][i]); o0.y = pk2(v[2][i], v[3][i]); o0.z = pk2(v[4][i], v[5][i]); o0.w = pk2(v[6][i], v[7][i]);
            o1.x = pk2(v[8][i], v[9][i]); o1.y = pk2(v[10][i], v[11][i]); o1.z = pk2(v[12][i], v[13][i]); o1.w = pk2(v[14][i], v[15][i]);
            bf16_t* dp = dst + (size_t)(n + i) * Kdst + k0;
            *(uint4*)dp = o0; *(uint4*)(dp + 8) = o1;
        }
    }
}

#ifndef MOE_CONV_IN_ATT
#define MOE_CONV_IN_ATT 1
#endif
#ifndef PRO_SKIP
#define PRO_SKIP 0
#endif
DEVI void phase_prologue(const Ctx& c, const Params& p, int repi = 0) {
    unsigned char* ws = p.ws;
    const int skip = repi ? PRO_SKIP : 0;
    if (!(skip & 1))
    {
        LAS float* sc = (LAS float*)c.ring;
        float* part = c.sm;
        float* mod = (float*)(ws + WS_MOD);
        for (int e = c.tid; e < 8 * 1024; e += 512) { const float v = p.in[I_C][e]; sc[e] = v / (1.f + __expf(-v)); }
        __syncthreads();
        const int col_l = c.tid % 48, ks = c.tid / 48;
        for (int it = c.bid; it < 256; it += c.nblk) {
            const int gcol = it * 48 + col_l, l = gcol / 6144, col = gcol % 6144;
            if (ks < 8) {
                const float* w = p.in[I_ADAW] + (size_t)l * 1024 * 6144 + (size_t)(ks * 128) * 6144 + col;
                float acc[8];
#pragma unroll
                for (int b = 0; b < 8; ++b) acc[b] = 0.f;
#pragma unroll 1
                for (int k0 = 0; k0 < 128; k0 += 32) {
                    float wv[32];
#pragma unroll
                    for (int j = 0; j < 32; ++j) wv[j] = __builtin_nontemporal_load(w + (size_t)(k0 + j) * 6144);
#pragma unroll
                    for (int j = 0; j < 32; ++j)
#pragma unroll
                        for (int b = 0; b < 8; ++b) acc[b] += sc[b * 1024 + ks * 128 + k0 + j] * wv[j];
                }
#pragma unroll
                for (int b = 0; b < 8; ++b) part[(ks * 8 + b) * 48 + col_l] = acc[b];
            }
            __syncthreads();
            if (c.tid < 384) { const int b = c.tid / 48, cl = c.tid % 48;
              const int gc = it * 48 + cl, l2 = gc / 6144, c2 = gc % 6144;
              float a = 0.f;
#pragma unroll
              for (int k2 = 0; k2 < 8; ++k2) a += part[(k2 * 8 + b) * 48 + cl];
              mod[(l2 * 8 + b) * 6144 + c2] = a + p.in[I_ADAB][l2 * 6144 + c2]; }
            __syncthreads();
        }
        __syncthreads();
    }
    if (!(skip & 2)) {
        float* cs = (float*)(ws + WS_COS); float* sn = (float*)(ws + WS_SIN);
        const int* pos = (const int*)p.in[I_POS];
        for (int e = c.bid * 512 + c.tid; e < MTOK * 16; e += c.nblk * 512) {
            const int m = e >> 4, i = e & 15;
            const float inv_freq = powf(10000.0f, -(float)(2 * i) / 32.0f);
            const float ang = (float)pos[m] * inv_freq;
            cs[e] = cosf(ang); sn[e] = sinf(ang);
        }
    }
    if (c.bid == 0 && c.wid == 0) {
        float* bnd = (float*)(ws + WS_CTL) + WS_BND_WORD;
        for (int l = 0; l < 2; ++l) {
            const float* gq = p.in[I_QQK] + l * 96; const float* gk = p.in[I_KQK] + l * 96;
            float g = fabsf(gq[c.lane] * gk[c.lane]); if (c.lane < 32) g = fmaxf(g, fabsf(gq[64 + c.lane] * gk[64 + c.lane]));
            const float* gcq = p.in[I_CKQN] + l * 64; const float* gck = p.in[I_CKKN] + l * 64;
            float gc = fabsf(gcq[c.lane] * gck[c.lane]);
#pragma unroll
            for (int o = 32; o; o >>= 1) { g = fmaxf(g, __shfl_xor(g, o, 64)); gc = fmaxf(gc, __shfl_xor(gc, o, 64)); }
            if (c.lane == 0) bnd[l * 8] = 9.797958971132712f * att_L2E * g * 1.02f + 0.5f;
            for (int h = 0; h < 4; ++h) {
                const float* rb = p.in[I_RELB] + (l * 4 + h) * 257; float b = 0.f;
                for (int i = c.lane; i < 257; i += 64) b = fmaxf(b, fabsf(rb[i]));
#pragma unroll
                for (int o = 32; o; o >>= 1) b = fmaxf(b, __shfl_xor(b, o, 64));
                if (c.lane == 0) bnd[l * 8 + 1 + h] = att_L2E * (8.f * gc + b) * 1.02f + 0.5f;
            }
        }
    }
    if (!(skip & 8)) for (int l = 0; l < 2; ++l) {
        conv_job3<MAP_WIN>(c, p.in[I_WIN] + (size_t)l * 1024 * INC, nullptr, INC, 1024, nullptr, (bf16_t*)(ws + WS_WIN) + (size_t)l * 2048 * 1024, 1024, 2048);
        conv_job2<MAP_Q>(c, p.in[I_WQUP] + (size_t)l * 256 * 768, nullptr, 768, 256, p.in[I_QNORM] + l * 256, (bf16_t*)(ws + WS_WQ) + (size_t)l * 768 * 256, 256, 768);
        conv_job3<MAP_KV>(c, p.in[I_WKVUP] + (size_t)l * 128 * 1024, nullptr, 1024, 128, p.in[I_KVNORM] + l * 128, (bf16_t*)(ws + WS_WKV) + (size_t)l * 1280 * 256, 256, 1280);
        conv_job3<MAP_ID>(c, p.in[I_WOUT] + (size_t)l * 1024 * 1024, nullptr, 1024, 1024, p.in[I_GON] + l * 1024, (bf16_t*)(ws + WS_WOUT) + (size_t)l * 1024 * 1024, 1024, 1024);
    }
    if (!(skip & 8)) conv_job3<MAP_GU>(c, p.in[I_FG], p.in[I_FU], DFF, 1024, nullptr, (bf16_t*)(ws + WS_FGU), 1024, 5632);
    if (!(skip & 8)) conv_job3<MAP_ID>(c, p.in[I_FD], nullptr, 1024, DFF, nullptr, (bf16_t*)(ws + WS_FD), DFF, 1024);
    if (!(skip & 4) && !MOE_CONV_IN_ATT) for (int e = 0; e < NEXP; ++e) {
        conv_job3<MAP_GU>(c, p.in[I_MG] + (size_t)e * 1024 * DFF, p.in[I_MU] + (size_t)e * 1024 * DFF, DFF, 1024, nullptr, (bf16_t*)(ws + WS_MGU) + (size_t)e * 5632 * 1024, 1024, 5632);
        conv_job3<MAP_ID>(c, p.in[I_MD] + (size_t)e * DFF * 1024, nullptr, 1024, DFF, nullptr, (bf16_t*)(ws + WS_MD) + (size_t)e * 1024 * DFF, DFF, 1024);
    }
}

template <bool BF> DEVI f32x4 pg8_ld4(const void* base, size_t idx) {
    if constexpr (BF) { const uint2 v = *(const uint2*)((const bf16_t*)base + idx); return (f32x4){lo16(v.x), hi16(v.x), lo16(v.y), hi16(v.y)}; }
    else return *(const f32x4*)((const float*)base + idx);
}
DEVI float reduce8(const float (&lg)[8], int lane) {
    float t[4], u[2], v;
    const bool b5 = lane & 32, b4 = lane & 16, b3 = lane & 8;
#pragma unroll
    for (int e = 0; e < 4; ++e) { const float keep = b5 ? lg[e + 4] : lg[e], send = b5 ? lg[e] : lg[e + 4]; t[e] = keep + __shfl_xor(send, 32, 64); }
#pragma unroll
    for (int e = 0; e < 2; ++e) { const float keep = b4 ? t[e + 2] : t[e], send = b4 ? t[e] : t[e + 2]; u[e] = keep + __shfl_xor(send, 16, 64); }
    { const float keep = b3 ? u[1] : u[0], send = b3 ? u[0] : u[1]; v = keep + __shfl_xor(send, 8, 64); }
    v += __shfl_xor(v, 4, 64); v += __shfl_xor(v, 2, 64); v += __shfl_xor(v, 1, 64);
    return v;
}
template <bool ROUTER, bool XBF>
DEVI void phase_norm(const Ctx& c, const Params& p, const void* __restrict__ x, const float* __restrict__ gain, const float* __restrict__ sh, const float* __restrict__ sc  ) {
    bf16_t* __restrict__ h = (bf16_t*)(p.ws + WS_H);
    int* sm_e = (int*)c.sm;
    constexpr int NR = 2;
    LAS f32x4* wl = (LAS f32x4*)c.ring;
    if (ROUTER) {
        for (int e4 = c.tid; e4 < 2048; e4 += 512) {
            const int col = e4 >> 1, half = e4 & 1, ln = (col >> 2) & 63, i = col >> 8, j = col & 3;
            wl[((i * 4 + j) * 2 + half) * 64 + ln] = *(const f32x4*)(p.in[I_ROUTER] + (size_t)col * 8 + 4 * half);
        }
        __syncthreads();
    }
#pragma unroll 1
    for (int ch = c.bid; ch < MTOK / 128; ch += c.nblk) {
#pragma unroll 1
        for (int rr = 0; rr < 16; rr += NR) {
            if (ROUTER) asm volatile("" ::: "memory");
            const int rloc = c.wid * 16 + rr, row = ch * 128 + rloc, b = row / SEQ;
            f32x4 v[NR][4]; float ss[NR];
#pragma unroll
            for (int q = 0; q < NR; ++q)
#pragma unroll
                for (int i = 0; i < 4; ++i) v[q][i] = pg8_ld4<XBF>(x, (size_t)(row + q) * DM + 4 * (c.lane + 64 * i));
#pragma unroll
            for (int q = 0; q < NR; ++q) { float a = 0.f;
#pragma unroll
                for (int i = 0; i < 4; ++i) a += v[q][i][0] * v[q][i][0] + v[q][i][1] * v[q][i][1] + v[q][i][2] * v[q][i][2] + v[q][i][3] * v[q][i][3];
                ss[q] = a; }
            float rstdv[NR];
#pragma unroll
            for (int q = 0; q < NR; ++q) rstdv[q] = rsqrtf(wave_sum(ss[q]) * (1.f / DM) + EPS);
            float lg[NR][8];
#pragma unroll
            for (int q = 0; q < NR; ++q)
#pragma unroll
                for (int e = 0; e < 8; ++e) lg[q][e] = 0.f;
#pragma unroll
            for (int i = 0; i < 4; ++i) {
                const int col = 4 * (c.lane + 64 * i);
                const f32x4 g = *(const f32x4*)(gain + col), s1 = *(const f32x4*)(sc + b * 6144 + col), s0 = *(const f32x4*)(sh + b * 6144 + col);
                f32x4 o[NR];
#pragma unroll
                for (int q = 0; q < NR; ++q) {
#pragma unroll
                    for (int j = 0; j < 4; ++j) o[q][j] = v[q][i][j] * rstdv[q] * g[j] * (1.f + s1[j]) + s0[j];
                    uint2 pk; pk.x = pk2(o[q][0], o[q][1]); pk.y = pk2(o[q][2], o[q][3]);
                    *(uint2*)(h + (size_t)(row + q) * DM + col) = pk;
                }
                if (ROUTER) {
                    asm volatile("" ::: "memory");
#pragma unroll
                    for (int j = 0; j < 4; ++j) {
                        const f32x4 w0 = wl[((i * 4 + j) * 2) * 64 + c.lane], w1 = wl[((i * 4 + j) * 2 + 1) * 64 + c.lane];
#pragma unroll
                        for (int q = 0; q < NR; ++q) {
                            lg[q][0] += o[q][j] * w0[0]; lg[q][1] += o[q][j] * w0[1]; lg[q][2] += o[q][j] * w0[2]; lg[q][3] += o[q][j] * w0[3];
                            lg[q][4] += o[q][j] * w1[0]; lg[q][5] += o[q][j] * w1[1]; lg[q][6] += o[q][j] * w1[2]; lg[q][7] += o[q][j] * w1[3];
                        }
                    }
                }
            }
            if (ROUTER) {
#pragma unroll
                for (int q = 0; q < NR; ++q) {
                    const float mine = reduce8(lg[q], c.lane);
                    float l8[8];
#pragma unroll
                    for (int e = 0; e < 8; ++e) l8[e] = __builtin_bit_cast(float, __builtin_amdgcn_readlane(__builtin_bit_cast(int, mine), 8 * e));
                    int e0 = 0; float v0 = l8[0];
#pragma unroll
                    for (int e = 1; e < 8; ++e) if (l8[e] > v0) { v0 = l8[e]; e0 = e; }
                    int e1 = -1; float v1 = -3.0e38f;
#pragma unroll
                    for (int e = 0; e < 8; ++e) if (e != e0 && l8[e] > v1) { v1 = l8[e]; e1 = e; }
                    const float t = __expf(v1 - v0), w0 = 1.f / (1.f + t), w1 = t / (1.f + t);
                    if (c.lane == 0) {
                        int* te = (int*)(p.ws + WS_TOKE); float* tw = (float*)(p.ws + WS_TOKW);
                        te[(row + q) * 2] = e0; te[(row + q) * 2 + 1] = e1; tw[(row + q) * 2] = w0; tw[(row + q) * 2 + 1] = w1;
                        sm_e[rloc + q] = e0; sm_e[128 + rloc + q] = e1;
                    }
                }
            }
        }
        if (ROUTER) {
            __syncthreads();
            if (c.tid < 16) { const int s = c.tid >> 3, e = c.tid & 7; int n = 0; for (int i = 0; i < 128; ++i) n += (sm_e[s * 128 + i] == e); ((int*)(p.ws + WS_CNT))[ch * 16 + c.tid] = n; }
            __syncthreads();
        }
    }
}

struct GemmDesc {
    const bf16_t* A; int lda; const bf16_t* Bt; int ldb; int M, N, K;
    const int* rowidx;
    const int* tile_expert;
    size_t expert_stride;
    const int* ntiles;
};
template <bool DUAL, class Epi>
DEVI void gemm_simple(const Ctx& c, const GemmDesc& g, const Epi& epi) {
    const int fr = c.lane & 15, fq = c.lane >> 4;
    const int Mrows = g.ntiles ? (*g.ntiles) * 256 : g.M;
    const int ntn = DUAL ? (g.N / 256) * 4 : g.N / 64, ntm = Mrows / 32;
    const long total = (long)ntm * ntn;
    for (long u = (long)c.bid * 8 + c.wid; u < total; u += (long)c.nblk * 8) {
        const int mt = (int)(u / ntn), nt = (int)(u % ntn), row0 = mt * 32;
        const bf16_t* Bt = g.Bt;
        if (g.tile_expert) Bt += (size_t)g.tile_expert[row0 >> 8] * g.expert_stride;
        int colb[4];
        if (DUAL) { const int t = nt >> 2, s = nt & 3; colb[0] = 256 * t + 32 * s; colb[1] = colb[0] + 16; colb[2] = colb[0] + 128; colb[3] = colb[2] + 16; }
        else {
#pragma unroll
            for (int i = 0; i < 4; ++i) colb[i] = nt * 64 + 16 * i;
        }
        int r0 = row0 + fr, r1 = row0 + 16 + fr;
        if (g.rowidx) { r0 = g.rowidx[r0]; r1 = g.rowidx[r1]; r0 = r0 < 0 ? 0 : r0; r1 = r1 < 0 ? 0 : r1; }
        const bf16_t* a0 = g.A + (size_t)r0 * g.lda + fq * 8; const bf16_t* a1 = g.A + (size_t)r1 * g.lda + fq * 8;
        const bf16_t* b0 = Bt + (size_t)(colb[0] + fr) * g.ldb + fq * 8; const bf16_t* b1 = Bt + (size_t)(colb[1] + fr) * g.ldb + fq * 8;
        const bf16_t* b2 = Bt + (size_t)(colb[2] + fr) * g.ldb + fq * 8; const bf16_t* b3 = Bt + (size_t)(colb[3] + fr) * g.ldb + fq * 8;
        f32x4 acc[2][4];
#pragma unroll
        for (int m = 0; m < 2; ++m)
#pragma unroll
            for (int i = 0; i < 4; ++i) acc[m][i] = (f32x4){0.f, 0.f, 0.f, 0.f};
        for (int k = 0; k < g.K; k += 32) {
            const bf16x8 af0 = *(const bf16x8*)(a0 + k), af1 = *(const bf16x8*)(a1 + k);
            const bf16x8 bf0 = *(const bf16x8*)(b0 + k), bf1 = *(const bf16x8*)(b1 + k), bf2 = *(const bf16x8*)(b2 + k), bf3 = *(const bf16x8*)(b3 + k);
            acc[0][0] = __builtin_amdgcn_mfma_f32_16x16x32_bf16(af0, bf0, acc[0][0], 0, 0, 0);
            acc[0][1] = __builtin_amdgcn_mfma_f32_16x16x32_bf16(af0, bf1, acc[0][1], 0, 0, 0);
            acc[0][2] = __builtin_amdgcn_mfma_f32_16x16x32_bf16(af0, bf2, acc[0][2], 0, 0, 0);
            acc[0][3] = __builtin_amdgcn_mfma_f32_16x16x32_bf16(af0, bf3, acc[0][3], 0, 0, 0);
            acc[1][0] = __builtin_amdgcn_mfma_f32_16x16x32_bf16(af1, bf0, acc[1][0], 0, 0, 0);
            acc[1][1] = __builtin_amdgcn_mfma_f32_16x16x32_bf16(af1, bf1, acc[1][1], 0, 0, 0);
            acc[1][2] = __builtin_amdgcn_mfma_f32_16x16x32_bf16(af1, bf2, acc[1][2], 0, 0, 0);
            acc[1][3] = __builtin_amdgcn_mfma_f32_16x16x32_bf16(af1, bf3, acc[1][3], 0, 0, 0);
        }
#pragma unroll
        for (int m = 0; m < 2; ++m)
#pragma unroll
            for (int r = 0; r < 4; ++r) {
                const int row = row0 + 16 * m + 4 * fq + r;
                if (DUAL) {
                    const int t = nt >> 2, s = nt & 3, j0 = 128 * t + 32 * s + fr;
                    epi(row, j0, acc[m][0][r], acc[m][2][r]);
                    epi(row, j0 + 16, acc[m][1][r], acc[m][3][r]);
                } else {
#pragma unroll
                    for (int i = 0; i < 4; ++i) epi(row, colb[i] + fr, acc[m][i][r], 0.f);
                }
            }
    }
}

struct EpiStoreBf16 { bf16_t* O; int ldo; DEVI void operator()(int row, int col, float v, float) const { O[(size_t)row * ldo + col] = f2bf(v); } };
struct EpiResid {
    const float* xin; float* out; const float* gate;
    DEVI void operator()(int row, int col, float v, float) const { const int b = row / SEQ; out[(size_t)row * DM + col] = xin[(size_t)row * DM + col] + gate[b * 6144 + col] * v; }
};
struct EpiSwiglu { bf16_t* H; DEVI void operator()(int row, int j, float g, float u) const { H[(size_t)row * DFF + j] = f2bf(g / (1.f + __expf(-g)) * u); } };
struct EpiMoeDown {
    float* out; const float* gate; const int* perm; const float* permw;
    DEVI void operator()(int pos, int col, float v, float) const {
        const int tok = perm[pos]; if (tok < 0) return;
        const int b = tok / SEQ; out[(size_t)tok * DM + col] += gate[b * 6144 + col] * permw[pos] * v;
    }
};


namespace pg8 {
typedef unsigned u32x4 __attribute__((ext_vector_type(4)));
constexpr int BM = 256, BK = 64, HALF = 128, HTB = HALF * BK * 2, STAGE_BYTES = 8 * HTB, NXCD = 8, WGM = 8;
__host__ __device__ __forceinline__ int lds_byte(int r, int c) { const int st = (r >> 4) * 2 + (c >> 5), rr = r & 15, cc = c & 31, ob = rr * 64 + cc * 2; return st * 1024 + (ob ^ (((ob >> 9) & 1) << 5)); }
__host__ __device__ __forceinline__ void stage_rc(int b, int& R, int& C) { const int st = b / 1024, sb = b % 1024, swz = sb ^ (((sb >> 9) & 1) << 5); R = (st >> 1) * 16 + swz / 64; C = (st & 1) * 32 + (swz % 64) / 2; }
__host__ __device__ __forceinline__ int perm32(int rho) { const int n = rho >> 4, i = rho & 15; return 8 * (i >> 2) + 4 * n + (i & 3); }
struct Unit { int pm, pn, ks; };
struct StaticOrder {
    int nM, nN, nwg, G, c;
    __device__ void init(int nM_, int nN_, int G_, int c_) { nM = nM_; nN = nN_; nwg = nM * nN; G = G_; c = c_; }
    __device__ bool next(int i, Unit& u) const { return unit_of((long)i * G + c, u); }
    __device__ bool unit_of(long L, Unit& u) const {
        if (L >= nwg) return false;
        int wgid = (int)L; { const int q = nwg / NXCD, r = nwg % NXCD, xcd = wgid % NXCD, off = wgid / NXCD; wgid = (xcd < r ? xcd * (q + 1) : r * (q + 1) + (xcd - r) * q) + off; }
        const int nig = WGM * nN, gid = wgid / nig, fm = gid * WGM, gsz = (nM - fm) < WGM ? (nM - fm) : WGM;
        u.pm = fm + ((wgid % nig) % gsz); u.pn = (wgid % nig) / gsz; u.ks = 0; return true;
    }
};
DEVI unsigned cvt_pk_bf16(float lo, float hi) { unsigned r; asm volatile("v_cvt_pk_bf16_f32 %0, %1, %2" : "=v"(r) : "v"(lo), "v"(hi)); return r; }

struct NoRowScale { static constexpr bool ON = false; DEVI void load(int, int, int, int, float (&)[8]) const {} };
struct GroupRowScale {
    static constexpr bool ON = true; const float* rat;
    DEVI void load(int pm, int wr, int fr, int sel, float (&f)[8]) const {
#pragma unroll
        for (int ai = 0; ai < 2; ++ai)
#pragma unroll
            for (int m = 0; m < 4; ++m) f[ai * 4 + m] = rat[(unsigned)((pm * BM + ai * HALF + wr * 64 + m * 16 + fr) * 4 + sel)];
    }
};
template <class Epi, class Prob, bool GATHER = false, bool ALIGN_EPI = true, class RS = NoRowScale>
DEVI void gemm_phase(LAS unsigned char* lds, const Prob& P, const Epi& E, int tid_in, const RS& rs = RS()) {
    const int tid = tid_in, wid = __builtin_amdgcn_readfirstlane(tid >> 6), lane = tid & 63, wr = wid >> 2, wc = wid & 3, fr = lane & 15, fq = lane >> 4;
    int nt = P.nt_of_first();
    int RA[2], CA[2];
    unsigned voffA[2], voffB[2];
#pragma unroll
    for (int i = 0; i < 2; ++i) { int R, C; stage_rc(tid * 16 + i * 8192, R, C); const int Rb = Epi::PERM ? ((R & ~31) + perm32(R & 31)) : R;
        RA[i] = R; CA[i] = C; voffA[i] = (unsigned)(R * P.lda + C) * 2u; voffB[i] = (unsigned)(Rb * P.ldb + C) * 2u; }
    const size_t kstep = (size_t)(BK * 2);
    const size_t hstepA = (size_t)HALF * P.lda * 2, hstepB = (size_t)HALF * P.ldb * 2;
    const unsigned ldsw = (unsigned)wid * 1024u;
    const int aoff = lds_byte(wr * 64 + fr, fq * 8), boff = lds_byte(wc * 32 + fr, fq * 8);
#define PG8_SA(b, h) (((b) * 2 + (h)) * HTB)
#define PG8_SB(b, h) ((4 + (b) * 2 + (h)) * HTB)
#define PG8_STAGE(bufoff, gbase, voff) do { _Pragma("unroll") for (int _i = 0; _i < 2; ++_i) \
        __builtin_amdgcn_global_load_lds((const unsigned*)((const char*)(gbase) + (voff)[_i]), (LAS unsigned*)(lds + (bufoff) + ldsw + _i * 8192), 16, 0, 0); } while (0)
#define PG8_LDA(dst, b, h) do { _Pragma("unroll") for (int m = 0; m < 4; ++m) _Pragma("unroll") for (int k = 0; k < 2; ++k) dst[m][k] = *(const LAS bf16x8*)(lds + PG8_SA(b, h) + aoff + m * 2048 + k * 1024); } while (0)
#define PG8_LDB(dst, b, h) do { _Pragma("unroll") for (int n = 0; n < 2; ++n) _Pragma("unroll") for (int k = 0; k < 2; ++k) dst[n][k] = *(const LAS bf16x8*)(lds + PG8_SB(b, h) + boff + n * 2048 + k * 1024); } while (0)
#define PG8_MMA(ai, bj, At, Bt) do { __builtin_amdgcn_s_setprio(1); _Pragma("unroll") for (int m = 0; m < 4; ++m) _Pragma("unroll") for (int n = 0; n < 2; ++n) _Pragma("unroll") for (int k = 0; k < 2; ++k) \
        acc[ai][bj][m][n] = __builtin_amdgcn_mfma_f32_16x16x32_bf16(Bt[n][k], At[m][k], acc[ai][bj][m][n], 0, 0, 0); __builtin_amdgcn_s_setprio(0); } while (0)
#define PG8_WAIT_V(n) asm volatile("s_waitcnt vmcnt(" #n ")" ::: "memory")
#define PG8_WAIT_L(n) asm volatile("s_waitcnt lgkmcnt(" #n ")" ::: "memory")
#define PG8_BAR __builtin_amdgcn_s_barrier()
#define PG8_SCHED __builtin_amdgcn_sched_barrier(0)
#define PG8_STAGE_A(bufoff, ptr, h, vG) do { if constexpr (GATHER) PG8_STAGE(bufoff, ptr, vG[h]); else PG8_STAGE(bufoff, (ptr) + (h) * hstepA, voffA); } while (0)
    Unit cur, nxt; int ui = 0;
    if (!P.next(0, cur)) return;
    f32x4 acc[2][2][4][2];
#pragma unroll
    for (int a = 0; a < 2; ++a)
#pragma unroll
        for (int b = 0; b < 2; ++b)
#pragma unroll
            for (int m = 0; m < 4; ++m)
#pragma unroll
                for (int n = 0; n < 2; ++n) acc[a][b][m][n] = (f32x4){0.f, 0.f, 0.f, 0.f};
    bf16x8 At[4][2], B0[2][2], B1[2][2];
    unsigned vAc[2][2] = {{0u, 0u}, {0u, 0u}}, vAn[2][2] = {{0u, 0u}, {0u, 0u}};
#define PG8_RSCALE(arr) do { _Pragma("unroll") for (int a_ = 0; a_ < 2; ++a_) _Pragma("unroll") for (int m_ = 0; m_ < 4; ++m_) _Pragma("unroll") for (int b_ = 0; b_ < 2; ++b_) _Pragma("unroll") for (int n_ = 0; n_ < 2; ++n_) acc[a_][b_][m_][n_] *= arr[a_ * 4 + m_]; } while (0)
    const char* cA; const char* cB = P.b_tile(cur);
    if constexpr (GATHER) { cA = P.a_base();
#pragma unroll
        for (int h = 0; h < 2; ++h)
#pragma unroll
            for (int i = 0; i < 2; ++i) vAc[h][i] = P.a_rowoff(0, h * HALF + RA[i]) + (unsigned)CA[i] * 2u;
    } else { cA = P.a_tile(cur); }
    PG8_STAGE(PG8_SB(0, 0), cB, voffB); PG8_STAGE(PG8_SB(0, 1), cB + hstepB, voffB); PG8_STAGE_A(PG8_SA(0, 0), cA, 0, vAc); PG8_STAGE_A(PG8_SA(0, 1), cA, 1, vAc);
    if (wr == 1) PG8_BAR;
    PG8_WAIT_V(2); PG8_BAR;
    PG8_STAGE(PG8_SB(1, 0), cB + kstep, voffB); PG8_STAGE_A(PG8_SA(1, 0), cA + kstep, 0, vAc); PG8_STAGE(PG8_SB(1, 1), cB + hstepB + kstep, voffB);
    PG8_WAIT_V(6); PG8_BAR;
    for (;;) {
        const bool has_next = P.next(ui + 1, nxt);
        nt = P.nt_of(cur);
        const char* nA; const char* nB = has_next ? P.b_tile(nxt) : cB;
        if constexpr (GATHER) { nA = cA;
#pragma unroll
            for (int h = 0; h < 2; ++h)
#pragma unroll
                for (int i = 0; i < 2; ++i) vAn[h][i] = has_next ? P.a_rowoff(ui + 1, h * HALF + RA[i]) + (unsigned)CA[i] * 2u : vAc[h][i];
        } else { nA = has_next ? P.a_tile(nxt) : cA; }
        for (int t = 0; t < nt; t += 2) {
            const bool last = (t == nt - 2);
            if constexpr (RS::ON) { if (t == 4 || t == 12) { float rsf[8]; rs.load(cur.pm, wr, fr, t == 4 ? 0 : 1, rsf); PG8_RSCALE(rsf); } }
            const char* a1 = cA + (size_t)(t + 1) * kstep;
            const char* a2 = last ? nA : cA + (size_t)(t + 2) * kstep; const char* b2 = last ? nB : cB + (size_t)(t + 2) * kstep;
            const char* a3 = a2 + kstep; const char* b3 = b2 + kstep;
            unsigned vA2[2][2];
#pragma unroll
            for (int h = 0; h < 2; ++h)
#pragma unroll
                for (int i = 0; i < 2; ++i) vA2[h][i] = (GATHER && last) ? vAn[h][i] : vAc[h][i];
            PG8_LDB(B0, 0, 0); PG8_LDB(B1, 0, 1); PG8_SCHED; PG8_LDA(At, 0, 0); PG8_STAGE_A(PG8_SA(1, 1), a1, 1, vAc);
            PG8_WAIT_V(8); PG8_WAIT_L(0); PG8_BAR; PG8_MMA(0, 0, At, B0); PG8_MMA(0, 1, At, B1); PG8_BAR; PG8_SCHED;
            PG8_LDA(At, 0, 1); PG8_STAGE(PG8_SB(0, 0), b2, voffB); PG8_STAGE(PG8_SB(0, 1), b2 + hstepB, voffB); PG8_STAGE_A(PG8_SA(0, 0), a2, 0, vA2);
            PG8_WAIT_V(8); PG8_WAIT_L(0); PG8_BAR; PG8_MMA(1, 0, At, B0); PG8_MMA(1, 1, At, B1); PG8_BAR; PG8_SCHED;
            PG8_LDB(B0, 1, 0); PG8_LDB(B1, 1, 1); PG8_SCHED; PG8_LDA(At, 1, 0); PG8_STAGE_A(PG8_SA(0, 1), a2, 1, vA2);
            PG8_WAIT_V(8); PG8_WAIT_L(0); PG8_BAR; PG8_MMA(0, 0, At, B0); PG8_MMA(0, 1, At, B1); PG8_BAR; PG8_SCHED;
            PG8_LDA(At, 1, 1); PG8_STAGE(PG8_SB(1, 0), b3, voffB); PG8_STAGE(PG8_SB(1, 1), b3 + hstepB, voffB); PG8_STAGE_A(PG8_SA(1, 0), a3, 0, vA2);
            PG8_WAIT_V(8); PG8_WAIT_L(0); PG8_BAR; PG8_MMA(1, 0, At, B0); PG8_MMA(1, 1, At, B1); PG8_BAR; PG8_SCHED;
        }
        if constexpr (ALIGN_EPI) { if (wr == 0) PG8_BAR; }
        if constexpr (RS::ON) { float rsf[8]; rs.load(cur.pm, wr, fr, 2, rsf); PG8_RSCALE(rsf); }
        E(acc, cur, wr, wc, fr, fq);
        if (!has_next) break;
#pragma unroll
        for (int a = 0; a < 2; ++a)
#pragma unroll
            for (int b = 0; b < 2; ++b)
#pragma unroll
                for (int m = 0; m < 4; ++m)
#pragma unroll
                    for (int n = 0; n < 2; ++n) acc[a][b][m][n] = (f32x4){0.f, 0.f, 0.f, 0.f};
        cur = nxt; cA = nA; cB = nB; ++ui;
        if constexpr (GATHER) {
#pragma unroll
            for (int h = 0; h < 2; ++h)
#pragma unroll
                for (int i = 0; i < 2; ++i) vAc[h][i] = vAn[h][i];
        }
        if constexpr (ALIGN_EPI) { if (wr == 1) PG8_BAR; }
    }
    PG8_WAIT_V(0);
    if constexpr (!ALIGN_EPI) { if (wr == 0) PG8_BAR; }
    PG8_BAR;
#undef PG8_SA
#undef PG8_RSCALE
#undef PG8_SB
#undef PG8_STAGE
#undef PG8_STAGE_A
#undef PG8_LDA
#undef PG8_LDB
#undef PG8_MMA
#undef PG8_WAIT_V
#undef PG8_WAIT_L
#undef PG8_BAR
#undef PG8_SCHED
}

typedef f32x4 Acc[2][2][4][2];
struct EpiStoreT {
    static constexpr bool PERM = true;
    bf16_t* O; int ldc; bf16_t* O2; int ldc2; int split_pn;
    DEVI void operator()(const Acc& acc, const Unit& u, int wr, int wc, int fr, int fq) const {
        const int row0 = u.pm * BM + wr * 64 + fr;
        bf16_t* base = O; int ld = ldc, pn = u.pn;
        if (pn >= split_pn) { base = O2; ld = ldc2; pn -= split_pn; }
        const int col0 = pn * BM + wc * 32 + 8 * fq;
#pragma unroll
        for (int ai = 0; ai < 2; ++ai)
#pragma unroll
            for (int m = 0; m < 4; ++m) { bf16_t* rowp = base + (size_t)(row0 + ai * HALF + m * 16) * ld + col0;
#pragma unroll
                for (int bj = 0; bj < 2; ++bj) { const f32x4 v0 = acc[ai][bj][m][0], v1 = acc[ai][bj][m][1];
                    u32x4 w; w.x = cvt_pk_bf16(v0[0], v0[1]); w.y = cvt_pk_bf16(v0[2], v0[3]); w.z = cvt_pk_bf16(v1[0], v1[1]); w.w = cvt_pk_bf16(v1[2], v1[3]);
                    *(u32x4*)(rowp + bj * HALF) = w; } }
    }
};
struct F8 { f32x4 lo, hi; };
template <bool BF> DEVI F8 ld8(const void* base, size_t idx) {
    F8 r;
    if constexpr (BF) { const u32x4 v = *(const u32x4*)((const bf16_t*)base + idx); r.lo = (f32x4){lo16(v.x), hi16(v.x), lo16(v.y), hi16(v.y)}; r.hi = (f32x4){lo16(v.z), hi16(v.z), lo16(v.w), hi16(v.w)}; }
    else { r.lo = *(const f32x4*)((const float*)base + idx); r.hi = *(const f32x4*)((const float*)base + idx + 4); }
    return r;
}
template <bool BF> DEVI void st8(void* base, size_t idx, const f32x4& lo, const f32x4& hi) {
    if constexpr (BF) { u32x4 o; o.x = cvt_pk_bf16(lo[0], lo[1]); o.y = cvt_pk_bf16(lo[2], lo[3]); o.z = cvt_pk_bf16(hi[0], hi[1]); o.w = cvt_pk_bf16(hi[2], hi[3]); *(u32x4*)((bf16_t*)base + idx) = o; }
    else { *(f32x4*)((float*)base + idx) = lo; *(f32x4*)((float*)base + idx + 4) = hi; }
}
template <bool XBF, bool OBF>
struct EpiResidT {
    static constexpr bool PERM = true;
    const void* xin; void* out; const float* gate;
    DEVI void operator()(const Acc& acc, const Unit& u, int wr, int wc, int fr, int fq) const {
        const int row0 = u.pm * BM + wr * 64 + fr, col0 = u.pn * BM + wc * 32 + 8 * fq, b = (u.pm * BM) / SEQ;
        const float* gp = gate + b * 6144 + col0;
#pragma unroll
        for (int bj = 0; bj < 2; ++bj) {
            const f32x4 g0 = *(const f32x4*)(gp + bj * HALF), g1 = *(const f32x4*)(gp + bj * HALF + 4);
            constexpr int RB = XBF ? 4 : 2;
#pragma unroll
            for (int ai = 0; ai < 2; ++ai)
#pragma unroll
                for (int m0 = 0; m0 < 4; m0 += RB) {
                    F8 xv[RB];
#pragma unroll
                    for (int m = 0; m < RB; ++m) xv[m] = ld8<XBF>(xin, (size_t)(row0 + ai * HALF + (m0 + m) * 16) * DM + col0 + bj * HALF);
                    asm volatile("" ::: "memory");
#pragma unroll
                    for (int m = 0; m < RB; ++m) st8<OBF>(out, (size_t)(row0 + ai * HALF + (m0 + m) * 16) * DM + col0 + bj * HALF, xv[m].lo + g0 * acc[ai][bj][m0 + m][0], xv[m].hi + g1 * acc[ai][bj][m0 + m][1]);
                    asm volatile("" ::: "memory");
                }
        }
    }
};
struct EpiSwigluT {
    static constexpr bool PERM = true;
    bf16_t* H; int pm_wrap = 1 << 30, pm_shift = 0;
    DEVI void operator()(const Acc& acc, const Unit& u, int wr, int wc, int fr, int fq) const {
        const int row0 = (u.pm >= pm_wrap ? u.pm + pm_shift : u.pm) * BM + wr * 64 + fr, j0 = u.pn * HALF + wc * 32 + 8 * fq;
#pragma unroll
        for (int ai = 0; ai < 2; ++ai)
#pragma unroll
            for (int m = 0; m < 4; ++m) {
                float hv[8];
#pragma unroll
                for (int n = 0; n < 2; ++n)
#pragma unroll
                    for (int i = 0; i < 4; ++i) { const float g = acc[ai][0][m][n][i], up = acc[ai][1][m][n][i]; hv[4 * n + i] = g * __builtin_amdgcn_rcpf(1.f + __expf(-g)) * up; }
                u32x4 w; w.x = cvt_pk_bf16(hv[0], hv[1]); w.y = cvt_pk_bf16(hv[2], hv[3]); w.z = cvt_pk_bf16(hv[4], hv[5]); w.w = cvt_pk_bf16(hv[6], hv[7]);
                *(u32x4*)(H + (size_t)(row0 + ai * HALF + m * 16) * DFF + j0) = w;
            }
    }
};
template <bool OBF>
struct EpiMoeDownT {
    static constexpr bool PERM = true;
    const void* xin; void* out; const float* gate; const int* perm; const float* permw;
    DEVI void operator()(const Acc& acc, const Unit& u, int wr, int wc, int fr, int fq) const {
        const int pos0 = u.pm * BM + wr * 64 + fr, col0 = u.pn * BM + wc * 32 + 8 * fq;
        int tk[8]; float wv[8];
#pragma unroll
        for (int r = 0; r < 8; ++r) { const int pos = pos0 + (r >> 2) * HALF + (r & 3) * 16; tk[r] = perm[pos]; wv[r] = permw[pos]; }
#pragma unroll
        for (int r = 0; r < 8; ++r) {
            const int tok = tk[r];
            if (tok >= 0) { const float w = wv[r]; const float* gp = gate + (tok / SEQ) * 6144 + col0; const size_t ro = (size_t)tok * DM + col0;
                F8 xv[2]; f32x4 gv[2][2];
#pragma unroll
                for (int bj = 0; bj < 2; ++bj) { xv[bj] = ld8<true>(xin, ro + bj * HALF); gv[bj][0] = *(const f32x4*)(gp + bj * HALF); gv[bj][1] = *(const f32x4*)(gp + bj * HALF + 4); }
                asm volatile("" ::: "memory");
#pragma unroll
                for (int bj = 0; bj < 2; ++bj) st8<OBF>(out, ro + bj * HALF, xv[bj].lo + gv[bj][0] * w * acc[r >> 2][bj][r & 3][0], xv[bj].hi + gv[bj][1] * w * acc[r >> 2][bj][r & 3][1]);
            }
        }
    }
};

struct ProbPlain {
    static constexpr bool dummy = false;
    const bf16_t* A; const bf16_t* Bt; int lda, ldb, K; StaticOrder S;
    DEVI int nt_of(const Unit&) const { return K / BK; }
    DEVI int nt_of_first() const { return K / BK; }
    DEVI bool next(int i, Unit& u) const { return S.next(i, u); }
    DEVI const char* a_tile(const Unit& u) const { return (const char*)(A + (size_t)u.pm * BM * lda); }
    DEVI const char* b_tile(const Unit& u) const { return (const char*)(Bt + (size_t)u.pn * BM * ldb); }
    DEVI const char* a_base() const { return (const char*)A; }
    DEVI unsigned a_rowoff(int, int) const { return 0u; }
};
struct ProbUp {
    const bf16_t* A1; const bf16_t* A2; const bf16_t* B1; const bf16_t* B2; int lda, ldb, K; StaticOrder S;
    DEVI int nt_of(const Unit& u) const { return u.pn < 3 ? 4 : 2; }
    DEVI int nt_of_first() const { return 4; }
    DEVI bool next(int i, Unit& u) const { return S.next(i, u); }
    DEVI const char* a_tile(const Unit& u) const { return (const char*)((u.pn < 3 ? A1 : A2) + (size_t)u.pm * BM * lda); }
    DEVI const char* b_tile(const Unit& u) const { return (const char*)(u.pn < 3 ? B1 + (size_t)u.pn * BM * ldb : B2 + (size_t)(u.pn - 3) * BM * ldb); }
    DEVI const char* a_base() const { return (const char*)A1; }
    DEVI unsigned a_rowoff(int, int) const { return 0u; }
};
struct SkipOrder {
    StaticOrder base; int nskip, R, m, pmx0;
    DEVI bool next(int i, Unit& u) const {
        const int c = base.c, G = base.G, Gs = G - nskip; const bool lo = c >= Gs; const int round = i + (lo ? R : 0);
        const long L = (round < R) ? (long)round * Gs + c : (long)R * Gs + (long)(round - R) * G + c;
        if (base.unit_of(L, u)) return true;
        const int rounds = (base.nwg + G - 1) / G, x = c - (base.nwg - (rounds - 1) * G);
        if (i != rounds - 1 || x < 0 || x >= 22 * m) return false;
        u.pm = pmx0 + x % m; u.pn = x / m; u.ks = 0; return true;
    }
};
struct OneUnit { int pm, pn; DEVI bool next(int i, Unit& u) const { if (i != 0) return false; u.pm = pm; u.pn = pn; u.ks = 0; return true; } };
template <class Ord>
struct ProbMoeT {
    const bf16_t* A; const bf16_t* Bt; int lda, ldb, K; Ord S; const int* texp; size_t estride; const LAS unsigned* tab; int pm_off;
    DEVI int nt_of(const Unit&) const { return K / BK; }
    DEVI int nt_of_first() const { return K / BK; }
    DEVI bool next(int i, Unit& u) const { if (!S.next(i, u)) return false; u.pm += pm_off; return true; }
    DEVI const char* a_tile(const Unit& u) const { return (const char*)(A + (size_t)u.pm * BM * lda); }
    DEVI const char* b_tile(const Unit& u) const { return (const char*)(Bt + (size_t)texp[u.pm] * estride + (size_t)u.pn * BM * ldb); }
    DEVI const char* a_base() const { return (const char*)A; }
    DEVI unsigned a_rowoff(int ui, int r) const { return tab[ui * 256 + r]; }
};

struct ProbSplitK4 {
    const bf16_t* A; const bf16_t* Bt; int lda, ldb, K; const int* texp; size_t estride; int nsub, G, c;
    DEVI int nt_of(const Unit& u) const { return u.ks < 2 ? 12 : 10; }
    DEVI int nt_of_first() const { return 12; }
    DEVI static int k0_of(int ks) { return 64 * (ks < 2 ? 12 * ks : 24 + 10 * (ks - 2)); }
    DEVI bool next(int i, Unit& u) const { const long L = (long)i * G + c; if (L >= nsub) return false; const int l = (int)L; u.ks = l & 3; u.pn = (l >> 2) & 3; u.pm = l >> 4; return true; }
    DEVI const char* a_tile(const Unit& u) const { return (const char*)(A + (size_t)u.pm * BM * lda + k0_of(u.ks)); }
    DEVI const char* b_tile(const Unit& u) const { return (const char*)(Bt + (size_t)texp[u.pm] * estride + (size_t)u.pn * BM * ldb + k0_of(u.ks)); }
    DEVI const char* a_base() const { return (const char*)A; }
    DEVI unsigned a_rowoff(int, int) const { return 0u; }
};
struct EpiPartialT {
    static constexpr bool PERM = true;
    float* part; int rows;
    DEVI void operator()(const Acc& acc, const Unit& u, int wr, int wc, int fr, int fq) const {
        const int pos0 = u.pm * BM + wr * 64 + fr, col0 = u.pn * BM + wc * 32 + 8 * fq;
        float* base = part + (size_t)u.ks * rows * DM;
#pragma unroll
        for (int ai = 0; ai < 2; ++ai)
#pragma unroll
            for (int m = 0; m < 4; ++m)
#pragma unroll
                for (int bj = 0; bj < 2; ++bj) st8<false>(base, (size_t)(pos0 + ai * HALF + m * 16) * DM + col0 + bj * HALF, acc[ai][bj][m][0], acc[ai][bj][m][1]);
    }
};
}


namespace att {
#define ATT_WRITE_SS (!(PF & 16))
typedef float f32x16 __attribute__((ext_vector_type(16)));
typedef short s16x4 __attribute__((ext_vector_type(4)));
constexpr int LK0 = 0, LK1 = 13312, LV0 = 26624, LV1 = 34816, LBIAS = 43008, LFLAG = 44544, LUNIT = 44672  ;
constexpr float L2E = 1.4426950408889634f;
enum { T_MLA = 0, T_SB = 1, T_CK = 2 };

template <int DK> struct TileRegs { pg8::u32x4 k0, k1, v; };
template <int DK> DEVI void tile_load(TileRegs<DK>& r, const bf16_t* Kg, int pitchK, const bf16_t* Vg, int pitchV, int key0, int tid) {
    constexpr int CPR = DK / 8;
    { const int row = tid / CPR, cc = tid % CPR; r.k0 = *(const pg8::u32x4*)(Kg + (size_t)(key0 + row) * pitchK + cc * 8); }
    if (DK == 96 && tid < 256) { const int ch = tid + 512, row = ch / CPR, cc = ch % CPR; r.k1 = *(const pg8::u32x4*)(Kg + (size_t)(key0 + row) * pitchK + cc * 8); }
    { const int row = tid >> 3, cc = tid & 7; r.v = *(const pg8::u32x4*)(Vg + (size_t)(key0 + row) * pitchV + cc * 8); }
}
template <int DK> DEVI void tile_store(const TileRegs<DK>& r, LAS unsigned char* kb, LAS unsigned char* vb, int tid) {
    constexpr int CPR = DK / 8, PITCH = DK * 2 + 16;
    { const int row = tid / CPR, cc = tid % CPR; *(LAS pg8::u32x4*)(kb + row * PITCH + cc * 16) = r.k0; }
    if (DK == 96 && tid < 256) { const int ch = tid + 512, row = ch / CPR, cc = ch % CPR; *(LAS pg8::u32x4*)(kb + row * PITCH + cc * 16) = r.k1; }
    { const int row = tid >> 3, cc = tid & 7; *(LAS pg8::u32x4*)(vb + (cc >> 2) * 4096 + row * 64 + (cc & 3) * 16) = r.v; }
}
template <int DK> DEVI void loadK(TileRegs<DK>& r, const bf16_t* Kg, int pitchK, int key0, int tid) {
    constexpr int CPR = DK / 8;
    { const int row = tid / CPR, cc = tid % CPR; r.k0 = *(const pg8::u32x4*)(Kg + (size_t)(key0 + row) * pitchK + cc * 8); }
    if (DK == 96 && tid < 256) { const int ch = tid + 512, row = ch / CPR, cc = ch % CPR; r.k1 = *(const pg8::u32x4*)(Kg + (size_t)(key0 + row) * pitchK + cc * 8); }
}
template <int DK> DEVI void loadV(TileRegs<DK>& r, const bf16_t* Vg, int pitchV, int key0, int tid) {
    const int row = tid >> 3, cc = tid & 7; r.v = *(const pg8::u32x4*)(Vg + (size_t)(key0 + row) * pitchV + cc * 8);
}
template <int DK> DEVI void storeK(const TileRegs<DK>& r, LAS unsigned char* kb, int tid) {
    constexpr int CPR = DK / 8, PITCH = DK * 2 + 16;
    { const int row = tid / CPR, cc = tid % CPR; *(LAS pg8::u32x4*)(kb + row * PITCH + cc * 16) = r.k0; }
    if (DK == 96 && tid < 256) { const int ch = tid + 512, row = ch / CPR, cc = ch % CPR; *(LAS pg8::u32x4*)(kb + row * PITCH + cc * 16) = r.k1; }
}
template <int DK> DEVI void storeV(const TileRegs<DK>& r, LAS unsigned char* vb, int tid) {
    const int row = tid >> 3, cc = tid & 7; *(LAS pg8::u32x4*)(vb + (cc >> 2) * 4096 + row * 64 + (cc & 3) * 16) = r.v;
}
DEVI void xswap32(unsigned& a, unsigned& b) { asm volatile("s_nop 1\n\tv_permlane32_swap_b32 %0, %1" : "+v"(a), "+v"(b)); }
DEVI float xhalf_max(float v) { unsigned a = __builtin_bit_cast(unsigned, v), b = a; xswap32(a, b); return fmaxf(__builtin_bit_cast(float, a), __builtin_bit_cast(float, b)); }
DEVI float xhalf_sum(float v) { unsigned a = __builtin_bit_cast(unsigned, v), b = a; xswap32(a, b); return __builtin_bit_cast(float, a) + __builtin_bit_cast(float, b); }
template <int DK> DEVI void qk_tile(f32x16& s0, f32x16& s1, const LAS unsigned char* kb, const bf16x8 (&qf)[DK / 16], int r32, int h) {
    constexpr int PITCH = DK * 2 + 16, NS = DK / 16;
    const LAS unsigned char* k0 = kb + r32 * PITCH + h * 16;
    bf16x8 a0[NS], a1[NS];
#pragma unroll
    for (int st = 0; st < NS; ++st) { a0[st] = *(const LAS bf16x8*)(k0 + st * 32); a1[st] = *(const LAS bf16x8*)(k0 + 32 * PITCH + st * 32); }
#pragma unroll
    for (int i = 0; i < 16; ++i) { s0[i] = 0.f; s1[i] = 0.f; }
    __builtin_amdgcn_sched_barrier(0);
#pragma unroll
    for (int st = 0; st < NS; ++st) {
        s0 = __builtin_amdgcn_mfma_f32_32x32x16_bf16(a0[st], qf[st], s0, 0, 0, 0);
        s1 = __builtin_amdgcn_mfma_f32_32x32x16_bf16(a1[st], qf[st], s1, 0, 0, 0);
    }
    __builtin_amdgcn_sched_barrier(0);
}
DEVI s16x4 vtr(const LAS unsigned char* p) { return __builtin_bit_cast(s16x4, __builtin_amdgcn_ds_read_tr16_b64_v4i16((LAS s16x4*)p)); }
DEVI void pv_tile(f32x16 (&o)[2], const LAS unsigned char* vlane, const bf16x8 (&pf)[4]) {
#pragma unroll
    for (int db = 0; db < 2; ++db) {
        s16x4 lo[4], hi[4];
#pragma unroll
        for (int ks = 0; ks < 4; ++ks) { lo[ks] = vtr(vlane + db * 4096 + ks * 1024); hi[ks] = vtr(vlane + db * 4096 + ks * 1024 + 512); }
        __builtin_amdgcn_sched_barrier(0);
#pragma unroll
        for (int ks = 0; ks < 4; ++ks) {
            const bf16x8 a = (bf16x8){lo[ks][0], lo[ks][1], lo[ks][2], lo[ks][3], hi[ks][0], hi[ks][1], hi[ks][2], hi[ks][3]};
            o[db] = __builtin_amdgcn_mfma_f32_32x32x16_bf16(a, pf[ks], o[db], 0, 0, 0);
        }
        __builtin_amdgcn_sched_barrier(0);
    }
}

template <int DK> DEVI void seg1_fused(f32x16& s0, f32x16& s1, f32x16 (&o)[2], const LAS unsigned char* kb, const LAS unsigned char* vlane, const bf16x8 (&qf)[DK / 16], const bf16x8 (&pf)[4], int r32, int h) {
    constexpr int PITCH = DK * 2 + 16, NS = DK / 16, NH = NS / 2;
    const LAS unsigned char* k0 = kb + r32 * PITCH + h * 16;
    s16x4 lo0[4], hi0[4], lo1[4], hi1[4];
    bf16x8 ka0[NH], ka1[NH], kb0[NH], kb1[NH];
#pragma unroll
    for (int ks = 0; ks < 4; ++ks) { lo0[ks] = vtr(vlane + ks * 1024); hi0[ks] = vtr(vlane + ks * 1024 + 512); }
#pragma unroll
    for (int st = 0; st < NH; ++st) { ka0[st] = *(const LAS bf16x8*)(k0 + st * 32); ka1[st] = *(const LAS bf16x8*)(k0 + 32 * PITCH + st * 32); }
#pragma unroll
    for (int i = 0; i < 16; ++i) { s0[i] = 0.f; s1[i] = 0.f; }
    __builtin_amdgcn_sched_barrier(0);
#pragma unroll
    for (int ks = 0; ks < 4; ++ks) {
        const bf16x8 a = (bf16x8){lo0[ks][0], lo0[ks][1], lo0[ks][2], lo0[ks][3], hi0[ks][0], hi0[ks][1], hi0[ks][2], hi0[ks][3]};
        o[0] = __builtin_amdgcn_mfma_f32_32x32x16_bf16(a, pf[ks], o[0], 0, 0, 0);
    }
#pragma unroll
    for (int ks = 0; ks < 4; ++ks) { lo1[ks] = vtr(vlane + 4096 + ks * 1024); hi1[ks] = vtr(vlane + 4096 + ks * 1024 + 512); }
    __builtin_amdgcn_sched_barrier(0);
#pragma unroll
    for (int st = 0; st < NH; ++st) {
        s0 = __builtin_amdgcn_mfma_f32_32x32x16_bf16(ka0[st], qf[st], s0, 0, 0, 0);
        s1 = __builtin_amdgcn_mfma_f32_32x32x16_bf16(ka1[st], qf[st], s1, 0, 0, 0);
    }
#pragma unroll
    for (int st = 0; st < NH; ++st) { kb0[st] = *(const LAS bf16x8*)(k0 + (NH + st) * 32); kb1[st] = *(const LAS bf16x8*)(k0 + 32 * PITCH + (NH + st) * 32); }
    __builtin_amdgcn_sched_barrier(0);
#pragma unroll
    for (int ks = 0; ks < 4; ++ks) {
        const bf16x8 a = (bf16x8){lo1[ks][0], lo1[ks][1], lo1[ks][2], lo1[ks][3], hi1[ks][0], hi1[ks][1], hi1[ks][2], hi1[ks][3]};
        o[1] = __builtin_amdgcn_mfma_f32_32x32x16_bf16(a, pf[ks], o[1], 0, 0, 0);
    }
    __builtin_amdgcn_sched_barrier(0);
#pragma unroll
    for (int st = 0; st < NH; ++st) {
        s0 = __builtin_amdgcn_mfma_f32_32x32x16_bf16(kb0[st], qf[NH + st], s0, 0, 0, 0);
        s1 = __builtin_amdgcn_mfma_f32_32x32x16_bf16(kb1[st], qf[NH + st], s1, 0, 0, 0);
    }
    __builtin_amdgcn_sched_barrier(0);
}
DEVI void pack_p(bf16x8 (&pf)[4], const f32x16& s0, const f32x16& s1) {
#pragma unroll
    for (int st = 0; st < 2; ++st) {
        unsigned a[4], b[4];
#pragma unroll
        for (int i = 0; i < 4; ++i) { a[i] = pg8::cvt_pk_bf16(s0[8 * st + 2 * i], s0[8 * st + 2 * i + 1]); b[i] = pg8::cvt_pk_bf16(s1[8 * st + 2 * i], s1[8 * st + 2 * i + 1]); }
        pf[st] = __builtin_bit_cast(bf16x8, (pg8::u32x4){a[0], a[1], a[2], a[3]});
        pf[2 + st] = __builtin_bit_cast(bf16x8, (pg8::u32x4){b[0], b[1], b[2], b[3]});
    }
}
typedef float f32x2 __attribute__((ext_vector_type(2)));
DEVI void softmax_tile(f32x16& s0, f32x16& s1, float& m_run, float& l_run, f32x16 (&o)[2], bf16x8 (&pf)[4]) {
    float mx = fmaxf(s0[0], s1[0]);
#pragma unroll
    for (int i = 1; i < 16; ++i) mx = fmaxf(fmaxf(mx, s0[i]), s1[i]);
    mx = xhalf_max(mx);
    const float mn = fmaxf(m_run, mx);
    const f32x2 mn2 = (f32x2){mn, mn};
    f32x2 sum2 = (f32x2){0.f, 0.f};
#pragma unroll
    for (int i = 0; i < 16; i += 2) {
        f32x2 a = (f32x2){s0[i], s0[i + 1]} - mn2, b = (f32x2){s1[i], s1[i + 1]} - mn2;
        a.x = __builtin_amdgcn_exp2f(a.x); a.y = __builtin_amdgcn_exp2f(a.y); b.x = __builtin_amdgcn_exp2f(b.x); b.y = __builtin_amdgcn_exp2f(b.y);
        s0[i] = a.x; s0[i + 1] = a.y; s1[i] = b.x; s1[i + 1] = b.y;
        sum2 += a + b;
    }
    if (__any(mn != m_run)) {
        const float corr = __builtin_amdgcn_exp2f(m_run - mn);
        const f32x2 c2 = (f32x2){corr, corr};
        l_run *= corr;
#pragma unroll
        for (int i = 0; i < 16; i += 2) {
            f32x2 a = (f32x2){o[0][i], o[0][i + 1]} * c2, b = (f32x2){o[1][i], o[1][i + 1]} * c2;
            o[0][i] = a.x; o[0][i + 1] = a.y; o[1][i] = b.x; o[1][i + 1] = b.y;
        }
        m_run = mn;
    }
    l_run += sum2.x + sum2.y;
    pack_p(pf, s0, s1);
}
template <bool MASKED>
DEVI void sb_tile(f32x16& s0, f32x16& s1, float& carry, bf16x8 (&pf)[4], int h, int t_rel  ) {
    constexpr float ZS = 0.125f * 1.4426950408889634f;
    f32x16 L0, L1;
    float G[2][4], Gp[2][4];
#pragma unroll
    for (int x = 0; x < 2; ++x)
#pragma unroll
        for (int g = 0; g < 4; ++g) {
            float gs = 0.f;
#pragma unroll
            for (int i = 0; i < 4; ++i) {
                const int rr = 4 * g + i;
                const float z = (x ? s1[rr] : s0[rr]) * ZS;
                const float e = __builtin_amdgcn_exp2f(-fabsf(z));
                const float sp = fmaxf(z, 0.f) + __builtin_amdgcn_logf(1.f + e);
                float L = -sp, ls = z - sp;
                if (MASKED) { const bool valid = (32 * x + 8 * g + 4 * h + i) < t_rel; L = valid ? L : 0.f; ls = valid ? ls : -1.0e30f; }
                gs += L;
                if (x) { s1[rr] = ls; L1[rr] = L; } else { s0[rr] = ls; L0[rr] = L; }
            }
            G[x][g] = gs;
        }
#pragma unroll
    for (int x = 0; x < 2; ++x)
#pragma unroll
        for (int g = 0; g < 4; ++g) Gp[x][g] = xhalf_sum(G[x][g]) - G[x][g];
    float T[2][4]; float run = 0.f;
#pragma unroll
    for (int x = 1; x >= 0; --x)
#pragma unroll
        for (int g = 3; g >= 0; --g) { T[x][g] = run; run += G[x][g] + Gp[x][g]; }
#pragma unroll
    for (int x = 0; x < 2; ++x)
#pragma unroll
        for (int g = 0; g < 4; ++g) {
            float tl = carry + T[x][g] + (h == 0 ? Gp[x][g] : 0.f);
#pragma unroll
            for (int i = 3; i >= 0; --i) {
                const int rr = 4 * g + i;
                if (x) { const float w = __builtin_amdgcn_exp2f(s1[rr] + tl); tl += L1[rr]; s1[rr] = w; }
                else   { const float w = __builtin_amdgcn_exp2f(s0[rr] + tl); tl += L0[rr]; s0[rr] = w; }
            }
        }
    carry += run;
    pack_p(pf, s0, s1);
}


DEVI void unpack8(const bf16x8& f, float* q) {
#pragma unroll
    for (int j = 0; j < 8; ++j) q[j] = __builtin_bit_cast(float, (unsigned)(unsigned short)f[j] << 16);
}
DEVI bf16x8 pack8(const float* q, float sc) {
    pg8::u32x4 w; w.x = pg8::cvt_pk_bf16(q[0] * sc, q[1] * sc); w.y = pg8::cvt_pk_bf16(q[2] * sc, q[3] * sc); w.z = pg8::cvt_pk_bf16(q[4] * sc, q[5] * sc); w.w = pg8::cvt_pk_bf16(q[6] * sc, q[7] * sc);
    return __builtin_bit_cast(bf16x8, w);
}
DEVI void qprep_mla(bf16x8 (&qf)[6], const Params& p, size_t grow, int h) {
    float q[48];
#pragma unroll
    for (int st = 0; st < 6; ++st) unpack8(qf[st], q + 8 * st);
    const float* cs = (const float*)(p.ws + WS_COS) + grow * 16; const float* sn = (const float*)(p.ws + WS_SIN) + grow * 16;
    const f32x4 c0 = *(const f32x4*)(cs + 4 * h), c1 = *(const f32x4*)(cs + 8 + 4 * h), s0 = *(const f32x4*)(sn + 4 * h), s1 = *(const f32x4*)(sn + 8 + 4 * h);
    float ss = 0.f;
#pragma unroll
    for (int i = 0; i < 48; ++i) ss += q[i] * q[i];
    ss = xhalf_sum(ss);
#pragma unroll
    for (int m = 0; m < 4; ++m) {
        { const float a = q[32 + 2 * m], b = q[33 + 2 * m]; q[32 + 2 * m] = a * c0[m] - b * s0[m]; q[33 + 2 * m] = b * c0[m] + a * s0[m]; }
        { const float a = q[40 + 2 * m], b = q[41 + 2 * m]; q[40 + 2 * m] = a * c1[m] - b * s1[m]; q[41 + 2 * m] = b * c1[m] + a * s1[m]; }
    }
    const float alpha = ((const float*)(p.ws + WS_ALPHA))[grow];
    const float rq = rsqrtf(alpha * alpha * ss * (1.f / 96.f) + EPS) * alpha * (0.10206207261596577f * L2E);
#pragma unroll
    for (int st = 0; st < 6; ++st) qf[st] = pack8(q + 8 * st, rq);
}
DEVI void qprep_ck(bf16x8 (&qf)[4]) {
    float q[32];
#pragma unroll
    for (int st = 0; st < 4; ++st) unpack8(qf[st], q + 8 * st);
    float ss = 0.f;
#pragma unroll
    for (int i = 0; i < 32; ++i) ss += q[i] * q[i];
    ss = xhalf_sum(ss);
    const float r = rsqrtf(ss * (1.f / 64.f) + EPS) * (0.125f * L2E);
#pragma unroll
    for (int st = 0; st < 4; ++st) qf[st] = pack8(q + 8 * st, r);
}

template <int TYPE, int PF = 0>
DEVI void unit(const Ctx& cin, const Params& p, int l, int b, int hh, int qt) {
    constexpr int DK = (TYPE == T_MLA) ? 96 : 64;
    Ctx c = cin; { int ln = cin.lane; asm volatile("" : "+v"(ln)); c.lane = ln; c.tid = cin.wid * 64 + ln; }
    const bf16_t* proj = (const bf16_t*)(p.ws + WS_PROJ); const bf16_t* qb = (const bf16_t*)(p.ws + WS_Q); const bf16_t* kvb = (const bf16_t*)(p.ws + WS_KV);
    bf16_t* O = (bf16_t*)(p.ws + WS_H);
    const size_t rowb = (size_t)b * SEQ;
    const bf16_t *Qg, *Kg, *Vg; int pitchQ, pitchKV, ocol;
    if (TYPE == T_MLA) { Qg = qb + rowb * QLD + hh * 96; pitchQ = QLD; Kg = kvb + rowb * KVLD + hh * 160; Vg = Kg + 96; pitchKV = KVLD; ocol = 256 + hh * 64; }
    else if (TYPE == T_SB) { Qg = proj + rowb * PROJ_LD + PC_SBQ + hh * 64; pitchQ = PROJ_LD; Kg = proj + rowb * PROJ_LD + PC_SBK + hh * 64; Vg = proj + rowb * PROJ_LD + PC_SBV + hh * 64; pitchKV = PROJ_LD; ocol = hh * 64; }
    else { Qg = proj + rowb * PROJ_LD + PC_CKQ + hh * 64; pitchQ = PROJ_LD; Kg = proj + rowb * PROJ_LD + PC_CKK + hh * 64; Vg = proj + rowb * PROJ_LD + PC_CKV + hh * 64; pitchKV = PROJ_LD; ocol = 768 + hh * 64; }
    LAS unsigned char* ring = c.ring;
    const int w = c.wid, r32 = c.lane & 31, h = c.lane >> 5, q0 = qt * 256, trow = q0 + 32 * w + r32;
    int jlo, jhi;
    if (TYPE == T_MLA) { jlo = 0; jhi = 4 * qt + 3; }
    else if (TYPE == T_SB) { jlo = 0; jhi = 4 * qt + 3; }
    else { jlo = 4 * qt - 8 < 0 ? 0 : 4 * qt - 8; jhi = 4 * qt + 3; }
    const int cw = 4 * qt + (w >> 1);
    bf16x8 qf[DK / 16];
#pragma unroll
    for (int st = 0; st < DK / 16; ++st) qf[st] = *(const bf16x8*)(Qg + (size_t)trow * pitchQ + st * 16 + h * 8);
    if constexpr (TYPE == T_MLA) qprep_mla(qf, p, rowb + trow, h);
    if constexpr (TYPE == T_CK) qprep_ck(qf);
    if (TYPE == T_CK) { LAS float* bt = (LAS float*)(ring + LBIAS); const float* rb = p.in[I_RELB] + (l * 4 + hh) * 257; if (c.tid < 257) bt[c.tid] = rb[c.tid] * L2E; }
    if (TYPE == T_SB) { LAS unsigned* fl = (LAS unsigned*)(ring + LFLAG); if (c.tid < 16) fl[c.tid] = 0u; }
    f32x16 o[2];
#pragma unroll
    for (int i = 0; i < 16; ++i) { o[0][i] = 0.f; o[1][i] = 0.f; }
    float m_run = -1.0e30f, l_run = 0.f, carry = 0.f;
    bool wave_done = false;
    const int vlane = (4 * h + ((c.lane & 15) >> 2)) * 64 + (((c.lane >> 4) & 1) * 16 + 4 * (c.lane & 3)) * 2;
    const int ntile = jhi - jlo + 1;
    TileRegs<DK> tr;
    auto tile_of = [&](int it) { return (TYPE == T_SB) ? (jhi - it) : (jlo + it); };
    tile_load<DK>(tr, Kg, pitchKV, Vg, pitchKV, tile_of(0) * 64, c.tid);
    tile_store<DK>(tr, ring + LK0, ring + LV0, c.tid);
    __syncthreads();
    for (int it = 0; it < ntile; ++it) {
        const int j = tile_of(it), buf = it & 1;
        const bool more = (it + 1 < ntile);
        if (more) tile_load<DK>(tr, Kg, pitchKV, Vg, pitchKV, tile_of(it + 1) * 64, c.tid);
        const LAS unsigned char* kb = ring + (buf ? LK1 : LK0); const LAS unsigned char* vb = ring + (buf ? LV1 : LV0);
        bool active;
        if (TYPE == T_MLA) active = (j <= cw);
        else if (TYPE == T_SB) active = (j <= cw) && !wave_done;
        else active = (j <= cw) && (j >= cw - 8);
        if (active) {
            f32x16 s0, s1; bf16x8 pf[4];
            qk_tile<DK>(s0, s1, kb, qf, r32, h);
            if (TYPE == T_MLA) softmax_tile(s0, s1, m_run, l_run, o, pf);
            else if (TYPE == T_CK) {
                const int dlt = cw - j;
                const LAS float* bt = (const LAS float*)(ring + LBIAS);
                if (dlt >= 3) { const float bc = bt[256];
#pragma unroll
                    for (int i = 0; i < 16; ++i) { s0[i] += bc; s1[i] += bc; } }
                else { const int base = 64 * dlt + (32 * (w & 1) + r32) - 4 * h + 128;
#pragma unroll
                    for (int i = 0; i < 16; ++i) { int i0 = base - (8 * (i >> 2) + (i & 3)), i1 = i0 - 32; i0 = i0 > 256 ? 256 : i0; i1 = i1 > 256 ? 256 : i1; s0[i] += bt[i0]; s1[i] += bt[i1]; } }
                softmax_tile(s0, s1, m_run, l_run, o, pf);
            } else {
                if (j == cw) sb_tile<true>(s0, s1, carry, pf, h, trow - j * 64); else sb_tile<false>(s0, s1, carry, pf, h, 0);
                if (__all(carry <= -144.3f)) wave_done = true;
            }
            pv_tile(o, vb + vlane, pf);
        }
        if (TYPE == T_SB) { LAS unsigned* fl = (LAS unsigned*)(ring + LFLAG); if (c.lane == 0) fl[(it & 1) * 8 + w] = wave_done ? 0u : 1u; }
        if (more) tile_store<DK>(tr, ring + (buf ? LK0 : LK1), ring + (buf ? LV0 : LV1), c.tid);
        __syncthreads();
        if (TYPE == T_SB) {
            const LAS unsigned* fl = (const LAS unsigned*)(ring + LFLAG); unsigned any = 0u;
#pragma unroll
            for (int k = 0; k < 8; ++k) any |= fl[(it & 1) * 8 + k];
            if (any == 0u) break;
        }
    }
    float inv = 1.f;
    if (TYPE != T_SB) { const float lt = l_run + __shfl_xor(l_run, 32, 64); inv = 1.f / lt; }
    bf16_t* orow = O + (rowb + trow) * DM + ocol;
    float sq = 0.f;
#pragma unroll
    for (int db = 0; db < 2; ++db)
#pragma unroll
        for (int g = 0; g < 4; ++g) {
            const float v0 = o[db][4 * g] * inv, v1 = o[db][4 * g + 1] * inv, v2 = o[db][4 * g + 2] * inv, v3 = o[db][4 * g + 3] * inv;
            sq += (v0 * v0 + v1 * v1) + (v2 * v2 + v3 * v3);
            uint2 v; v.x = pg8::cvt_pk_bf16(v0, v1); v.y = pg8::cvt_pk_bf16(v2, v3);
            *(uint2*)(orow + 32 * db + 8 * g + 4 * h) = v;
        }
    sq = xhalf_sum(sq);
    if (h == 0 && ATT_WRITE_SS) ((float*)(p.ws + WS_SSH))[(rowb + trow) * 16 + (ocol >> 6)] = sq;
    __syncthreads();
}


#ifndef ATT_UNIT
#define ATT_UNIT unit2
#endif
#ifndef ATT_FUSED_SEG1
#define ATT_FUSED_SEG1 0
#define MLA64 1
#endif

template <int DK> DEVI void qk_tile_c(f32x16& s0, f32x16& s1, const f32x16& cin, const LAS unsigned char* kb, const bf16x8 (&qf)[DK / 16], int r32, int h) {
    constexpr int PITCH = DK * 2 + 16, NS = DK / 16;
    const LAS unsigned char* k0 = kb + r32 * PITCH + h * 16;
    bf16x8 a0[NS], a1[NS];
#pragma unroll
    for (int st = 0; st < NS; ++st) { a0[st] = *(const LAS bf16x8*)(k0 + st * 32); a1[st] = *(const LAS bf16x8*)(k0 + 32 * PITCH + st * 32); }
    __builtin_amdgcn_sched_barrier(0);
    s0 = __builtin_amdgcn_mfma_f32_32x32x16_bf16(a0[0], qf[0], cin, 0, 0, 0);
    s1 = __builtin_amdgcn_mfma_f32_32x32x16_bf16(a1[0], qf[0], cin, 0, 0, 0);
#pragma unroll
    for (int st = 1; st < NS; ++st) {
        s0 = __builtin_amdgcn_mfma_f32_32x32x16_bf16(a0[st], qf[st], s0, 0, 0, 0);
        s1 = __builtin_amdgcn_mfma_f32_32x32x16_bf16(a1[st], qf[st], s1, 0, 0, 0);
    }
    __builtin_amdgcn_sched_barrier(0);
}
constexpr float DEFER_THR = 6.0f;
DEVI void softmax_tile_defer(f32x16& s0, f32x16& s1, float& m_run, f32x16& negm, float& l_run, f32x16 (&o)[2], bf16x8 (&pf)[4], bool first, bool fixed) {
    if (!fixed) {
    float mx = fmaxf(s0[0], s1[0]);
#pragma unroll
    for (int i = 1; i < 16; ++i) mx = fmaxf(fmaxf(mx, s0[i]), s1[i]);
    mx = xhalf_max(mx);
    if (first || __any(mx > DEFER_THR)) {
        const float d = first ? mx : fmaxf(mx, 0.f);
        const float corr = __builtin_amdgcn_exp2f(-d);
        const f32x2 c2 = (f32x2){corr, corr}, d2 = (f32x2){d, d};
        l_run *= corr; m_run += d;
#pragma unroll
        for (int i = 0; i < 16; i += 2) {
            f32x2 a = (f32x2){o[0][i], o[0][i + 1]} * c2, b = (f32x2){o[1][i], o[1][i + 1]} * c2;
            o[0][i] = a.x; o[0][i + 1] = a.y; o[1][i] = b.x; o[1][i + 1] = b.y;
            f32x2 u = (f32x2){s0[i], s0[i + 1]} - d2, v = (f32x2){s1[i], s1[i + 1]} - d2;
            s0[i] = u.x; s0[i + 1] = u.y; s1[i] = v.x; s1[i + 1] = v.y;
        }
#pragma unroll
        for (int i = 0; i < 16; ++i) negm[i] = -m_run;
    }
    }
    float sum = 0.f;
#pragma unroll
    for (int i = 0; i < 16; ++i) {
        s0[i] = __builtin_amdgcn_exp2f(s0[i]); s1[i] = __builtin_amdgcn_exp2f(s1[i]);
        sum += s0[i]; sum += s1[i];
    }
    l_run += sum;
    pack_p(pf, s0, s1);
}

#define ATT_BAR() do { asm volatile("s_waitcnt lgkmcnt(0)" ::: "memory"); __builtin_amdgcn_s_barrier(); asm volatile("" ::: "memory"); } while (0)
template <int TYPE, int PF = 0>
DEVI void unit2(const Ctx& cin, const Params& p, int l, int b, int hh, int qt) {
    constexpr int DK = (TYPE == T_MLA) ? 96 : 64;
    Ctx c = cin; { int ln = cin.lane; asm volatile("" : "+v"(ln)); c.lane = ln; c.tid = cin.wid * 64 + ln; }
    const bf16_t* proj = (const bf16_t*)(p.ws + WS_PROJ); const bf16_t* qb = (const bf16_t*)(p.ws + WS_Q); const bf16_t* kvb = (const bf16_t*)(p.ws + WS_KV);
    bf16_t* O = (PF & 16) ? (bf16_t*)p.out : (bf16_t*)(p.ws + WS_H);
    const size_t rowb = (size_t)b * SEQ;
    const bf16_t *Qg, *Kg, *Vg; int pitchQ, pitchKV, ocol;
    if (TYPE == T_MLA) { Qg = qb + rowb * QLD + hh * 96; pitchQ = QLD; Kg = kvb + rowb * KVLD + hh * 160; Vg = Kg + 96; pitchKV = KVLD; ocol = 256 + hh * 64; }
    else if (TYPE == T_SB) { Qg = proj + rowb * PROJ_LD + PC_SBQ + hh * 64; pitchQ = PROJ_LD; Kg = proj + rowb * PROJ_LD + PC_SBK + hh * 64; Vg = proj + rowb * PROJ_LD + PC_SBV + hh * 64; pitchKV = PROJ_LD; ocol = hh * 64; }
    else { Qg = proj + rowb * PROJ_LD + PC_CKQ + hh * 64; pitchQ = PROJ_LD; Kg = proj + rowb * PROJ_LD + PC_CKK + hh * 64; Vg = proj + rowb * PROJ_LD + PC_CKV + hh * 64; pitchKV = PROJ_LD; ocol = 768 + hh * 64; }
    LAS unsigned char* ring = c.ring;
    const int w = c.wid, hb = w >> 2, r32 = c.lane & 31, h = c.lane >> 5, q0 = qt * 256, trow = q0 + 32 * w + r32;
    int jlo, jhi;
    if (TYPE == T_CK) { jlo = 4 * qt - 8 < 0 ? 0 : 4 * qt - 8; jhi = 4 * qt + 3; } else { jlo = 0; jhi = 4 * qt + 3; }
    const int cw = 4 * qt + (w >> 1);
    bf16x8 qf[DK / 16];
#pragma unroll
    for (int st = 0; st < DK / 16; ++st) qf[st] = *(const bf16x8*)(Qg + (size_t)trow * pitchQ + st * 16 + h * 8);
    if (TYPE == T_CK) { LAS float* bt = (LAS float*)(ring + LBIAS); const float* rb = p.in[I_RELB] + (l * 4 + hh) * 257; if (c.tid < 257) bt[c.tid] = rb[c.tid] * L2E; }
    if (TYPE == T_SB) { LAS unsigned* fl = (LAS unsigned*)(ring + LFLAG); if (c.tid < 32) fl[c.tid] = 1u; }
    f32x16 o[2];
#pragma unroll
    for (int i = 0; i < 16; ++i) { o[0][i] = 0.f; o[1][i] = 0.f; }
    float m_run = 0.f, l_run = 0.f, carry = 0.f;
    bool wave_done = false, first_tile = true, fixed = false;
    if (TYPE != T_SB) {
        const float b2 = __builtin_bit_cast(float, __builtin_amdgcn_readfirstlane(__builtin_bit_cast(int, ((const float*)(p.ws + WS_CTL))[WS_BND_WORD + l * 8 + (TYPE == T_MLA ? 0 : 1 + hh)])));
        fixed = b2 < 50.f; if (fixed) m_run = b2;
    }
    f32x16 negm;
#pragma unroll
    for (int i = 0; i < 16; ++i) negm[i] = -m_run;
    const int vlane = (4 * h + ((c.lane & 15) >> 2)) * 64 + (((c.lane >> 4) & 1) * 16 + 4 * (c.lane & 3)) * 2;
    const int nt = jhi - jlo + 1;
    TileRegs<DK> tr;
    auto tile_of = [&](int it) { return (TYPE == T_SB) ? (jhi - it) : (jlo + it); };
    {
        TileRegs<DK> tr1;
        loadK<DK>(tr, Kg, pitchKV, tile_of(0) * 64, c.tid); loadV<DK>(tr, Vg, pitchKV, tile_of(0) * 64, c.tid);
        if (nt > 1) loadK<DK>(tr1, Kg, pitchKV, tile_of(1) * 64, c.tid);
        if constexpr (TYPE == T_MLA) qprep_mla(qf, p, rowb + trow, h);
        if constexpr (TYPE == T_CK) qprep_ck(qf);
        storeK<DK>(tr, ring + LK0, c.tid); storeV<DK>(tr, ring + LV0, c.tid);
        if (nt > 1) storeK<DK>(tr1, ring + LK1, c.tid);
    }
    __syncthreads();
    if (hb == 1 && !(PF & 32)) ATT_BAR();
    f32x16 s0, s1; bf16x8 pf[4];
    bool act_prev = false;
    int it = 0;
    for (; it < nt; ++it) {
        const int j = tile_of(it);
        bool act_cur;
        if (TYPE == T_MLA) act_cur = (j <= cw);
        else if (TYPE == T_SB) act_cur = (j <= cw) && !wave_done;
        else act_cur = (j <= cw) && (j >= cw - 8);
        if (ATT_FUSED_SEG1 && act_cur && act_prev && !(PF & 12)) seg1_fused<DK>(s0, s1, o, ring + ((it & 1) ? LK1 : LK0), ring + (((it - 1) & 1) ? LV1 : LV0) + vlane, qf, pf, r32, h);
        else {
        if (act_cur) { if (!(PF & 8)) qk_tile_c<DK>(s0, s1, negm, ring + ((it & 1) ? LK1 : LK0), qf, r32, h); else {
#pragma unroll
            for (int i = 0; i < 16; ++i) { s0[i] = (float)i; s1[i] = (float)(i + it); } } }
        if (act_prev && !(PF & 4)) pv_tile(o, ring + (((it - 1) & 1) ? LV1 : LV0) + vlane, pf);
        }
        if (it >= 1 && !(PF & 2)) { if (it + 1 < nt) storeK<DK>(tr, ring + (((it + 1) & 1) ? LK1 : LK0), c.tid); storeV<DK>(tr, ring + ((it & 1) ? LV1 : LV0), c.tid); }
        if (!(PF & 32)) ATT_BAR();
        if (!(PF & 2)) { if (it + 2 < nt) loadK<DK>(tr, Kg, pitchKV, tile_of(it + 2) * 64, c.tid);
        if (it + 1 < nt) loadV<DK>(tr, Vg, pitchKV, tile_of(it + 1) * 64, c.tid); }
        if (act_cur) {
            if (PF & 1) { l_run += s0[3]; pack_p(pf, s0, s1); }
            else if (TYPE == T_MLA) { softmax_tile_defer(s0, s1, m_run, negm, l_run, o, pf, first_tile, fixed); first_tile = false; }
            else if (TYPE == T_CK) {
                const int dlt = cw - j;
                const LAS float* bt = (const LAS float*)(ring + LBIAS);
                if (dlt >= 3) { const float bc = bt[256];
#pragma unroll
                    for (int i = 0; i < 16; ++i) { s0[i] += bc; s1[i] += bc; } }
                else { const int base = 64 * dlt + (32 * (w & 1) + r32) - 4 * h + 128;
#pragma unroll
                    for (int i = 0; i < 16; ++i) { int i0 = base - (8 * (i >> 2) + (i & 3)), i1 = i0 - 32; i0 = i0 > 256 ? 256 : i0; i1 = i1 > 256 ? 256 : i1; s0[i] += bt[i0]; s1[i] += bt[i1]; } }
                softmax_tile_defer(s0, s1, m_run, negm, l_run, o, pf, first_tile, fixed); first_tile = false;
            } else {
                if (j == cw) sb_tile<true>(s0, s1, carry, pf, h, trow - j * 64); else sb_tile<false>(s0, s1, carry, pf, h, 0);
                if (__all(carry <= -144.3f)) wave_done = true;
            }
        }
        if (TYPE == T_SB) { LAS unsigned* fl = (LAS unsigned*)(ring + LFLAG); if (c.lane == 0) fl[(it & 3) * 8 + w] = wave_done ? 0u : 1u; }
        act_prev = act_cur;
        if (!(PF & 32)) ATT_BAR();
        if (TYPE == T_SB && it >= 1) {
            const LAS unsigned* fl = (const LAS unsigned*)(ring + LFLAG); unsigned any = 0u;
#pragma unroll
            for (int k = 0; k < 8; ++k) any |= fl[((it - 1) & 3) * 8 + k];
            if (any == 0u) { ++it; break; }
        }
    }
    if (act_prev && !(PF & 4)) pv_tile(o, ring + (((it - 1) & 1) ? LV1 : LV0) + vlane, pf);
    if (hb == 0 && !(PF & 32)) ATT_BAR();
    float inv = 1.f;
    if (TYPE != T_SB) { const float lt = xhalf_sum(l_run); inv = 1.f / lt; }
    bf16_t* orow = O + (rowb + trow) * DM + ocol;
    float sq = 0.f;
#pragma unroll
    for (int db = 0; db < 2; ++db)
#pragma unroll
        for (int gp = 0; gp < 2; ++gp) {
            unsigned w[2][2];
#pragma unroll
            for (int e = 0; e < 2; ++e) {
                const int g = 2 * gp + e;
                const float v0 = o[db][4 * g] * inv, v1 = o[db][4 * g + 1] * inv, v2 = o[db][4 * g + 2] * inv, v3 = o[db][4 * g + 3] * inv;
                sq += (v0 * v0 + v1 * v1) + (v2 * v2 + v3 * v3);
                w[e][0] = pg8::cvt_pk_bf16(v0, v1); w[e][1] = pg8::cvt_pk_bf16(v2, v3);
            }
            xswap32(w[0][0], w[1][0]); xswap32(w[0][1], w[1][1]);
            pg8::u32x4 v; v.x = w[0][0]; v.y = w[0][1]; v.z = w[1][0]; v.w = w[1][1];
            *(pg8::u32x4*)(orow + 32 * db + 8 * (2 * gp + h)) = v;
        }
    sq = xhalf_sum(sq);
    if (h == 0 && ATT_WRITE_SS) ((float*)(p.ws + WS_SSH))[(rowb + trow) * 16 + (ocol >> 6)] = sq;
    __syncthreads();
}


DEVI void softmax_rb(f32x16& s0, f32x16& s1, float& m_run, float& l_run, f32x16 (&o)[2], bf16x8 (&pf)[4], bool fixed) {
    if (!fixed) {
        float mx = fmaxf(s0[0], s1[0]);
#pragma unroll
        for (int i = 1; i < 16; ++i) mx = fmaxf(fmaxf(mx, s0[i]), s1[i]);
        mx = xhalf_max(mx);
        const float mn = fmaxf(m_run, mx);
        if (__any(mn != m_run)) {
            const float corr = __builtin_amdgcn_exp2f(m_run - mn);
            l_run *= corr;
#pragma unroll
            for (int i = 0; i < 16; ++i) { o[0][i] *= corr; o[1][i] *= corr; }
            m_run = mn;
        }
#pragma unroll
        for (int i = 0; i < 16; ++i) { s0[i] -= mn; s1[i] -= mn; }
    }
    float sum = 0.f;
#pragma unroll
    for (int i = 0; i < 16; ++i) { s0[i] = __builtin_amdgcn_exp2f(s0[i]); s1[i] = __builtin_amdgcn_exp2f(s1[i]); sum += s0[i]; sum += s1[i]; }
    l_run += sum;
    pack_p(pf, s0, s1);
}
DEVI void unit3(const Ctx& cin, const Params& p, int l, int b, int hh, int qt) {
    constexpr int DK = 96, PITCH = DK * 2 + 16;
    Ctx c = cin; { int ln = cin.lane; asm volatile("" : "+v"(ln)); c.lane = ln; c.tid = cin.wid * 64 + ln; }
    const bf16_t* qb = (const bf16_t*)(p.ws + WS_Q); const bf16_t* kvb = (const bf16_t*)(p.ws + WS_KV);
    bf16_t* O = (bf16_t*)(p.ws + WS_H);
    const size_t rowb = (size_t)b * SEQ;
    const bf16_t* Qg = qb + rowb * QLD + hh * 96; const bf16_t* Kg = kvb + rowb * KVLD + hh * 160; const bf16_t* Vg = Kg + 96; const int ocol = 256 + hh * 64;
    LAS unsigned char* ring = c.ring;
    const int w = c.wid, r32 = c.lane & 31, h = c.lane >> 5, q0 = qt * 512;
    const int cw = 8 * qt + w, nt = 8 * qt + 8;
    const float b2 = __builtin_bit_cast(float, __builtin_amdgcn_readfirstlane(__builtin_bit_cast(int, ((const float*)(p.ws + WS_CTL))[WS_BND_WORD + l * 8])));
    const bool fixed = b2 < 50.f;
    bf16x8 qf[2][6];
#pragma unroll
    for (int rb = 0; rb < 2; ++rb) {
        const int trow = q0 + 64 * w + 32 * rb + r32;
#pragma unroll
        for (int st = 0; st < 6; ++st) qf[rb][st] = *(const bf16x8*)(Qg + (size_t)trow * QLD + st * 16 + h * 8);
    }
    TileRegs<DK> tr;
    tile_load<DK>(tr, Kg, KVLD, Vg, KVLD, 0, c.tid);
#pragma unroll
    for (int rb = 0; rb < 2; ++rb) qprep_mla(qf[rb], p, rowb + q0 + 64 * w + 32 * rb + r32, h);
    f32x16 o[2][2];
#pragma unroll
    for (int i = 0; i < 16; ++i) { o[0][0][i] = 0.f; o[0][1][i] = 0.f; o[1][0][i] = 0.f; o[1][1][i] = 0.f; }
    float m_run[2] = {fixed ? 0.f : -1.0e30f, fixed ? 0.f : -1.0e30f}, l_run[2] = {0.f, 0.f};
    const int vlane = (4 * h + ((c.lane & 15) >> 2)) * 64 + (((c.lane >> 4) & 1) * 16 + 4 * (c.lane & 3)) * 2;
    tile_store<DK>(tr, ring + LK0, ring + LV0, c.tid);
    __syncthreads();
    constexpr int LV2 = 49152;
    const int hb = w >> 2;
    bf16x8 pf[2][4];
    auto vslot = [&](int t) { const int m3 = t % 3; return ring + (m3 == 0 ? LV0 : m3 == 1 ? LV1 : LV2); };
    auto do_qksm = [&](const LAS unsigned char* kb) {
        f32x16 s[2][2];
        const LAS unsigned char* k0 = kb + r32 * PITCH + h * 16;
        f32x16 z;
#pragma unroll
        for (int i = 0; i < 16; ++i) z[i] = 0.f;
#pragma unroll
        for (int hf = 0; hf < 2; ++hf) {
            bf16x8 a0[3], a1[3];
#pragma unroll
            for (int st = 0; st < 3; ++st) { a0[st] = *(const LAS bf16x8*)(k0 + (3 * hf + st) * 32); a1[st] = *(const LAS bf16x8*)(k0 + 32 * PITCH + (3 * hf + st) * 32); }
            __builtin_amdgcn_sched_barrier(0);
#pragma unroll
            for (int st = 0; st < 3; ++st)
#pragma unroll
                for (int rb = 0; rb < 2; ++rb) {
                    s[rb][0] = __builtin_amdgcn_mfma_f32_32x32x16_bf16(a0[st], qf[rb][3 * hf + st], (hf == 0 && st == 0) ? z : s[rb][0], 0, 0, 0);
                    s[rb][1] = __builtin_amdgcn_mfma_f32_32x32x16_bf16(a1[st], qf[rb][3 * hf + st], (hf == 0 && st == 0) ? z : s[rb][1], 0, 0, 0);
                }
            __builtin_amdgcn_sched_barrier(0);
        }
#pragma unroll
        for (int rb = 0; rb < 2; ++rb) softmax_rb(s[rb][0], s[rb][1], m_run[rb], l_run[rb], o[rb], pf[rb], fixed);
    };
    auto do_pv = [&](const LAS unsigned char* vb) {
#pragma unroll
        for (int db = 0; db < 2; ++db) {
            s16x4 lo[4], hi[4];
#pragma unroll
            for (int ks = 0; ks < 4; ++ks) { lo[ks] = vtr(vb + db * 4096 + ks * 1024); hi[ks] = vtr(vb + db * 4096 + ks * 1024 + 512); }
            __builtin_amdgcn_sched_barrier(0);
#pragma unroll
            for (int ks = 0; ks < 4; ++ks) {
                const bf16x8 a = (bf16x8){lo[ks][0], lo[ks][1], lo[ks][2], lo[ks][3], hi[ks][0], hi[ks][1], hi[ks][2], hi[ks][3]};
                o[0][db] = __builtin_amdgcn_mfma_f32_32x32x16_bf16(a, pf[0][ks], o[0][db], 0, 0, 0);
                o[1][db] = __builtin_amdgcn_mfma_f32_32x32x16_bf16(a, pf[1][ks], o[1][db], 0, 0, 0);
            }
            __builtin_amdgcn_sched_barrier(0);
        }
    };
#pragma unroll 1
    for (int it = 0; it < nt; ++it) {
        const bool more = (it + 1 < nt);
        if (more) tile_load<DK>(tr, Kg, KVLD, Vg, KVLD, (it + 1) * 64, c.tid);
        if (hb == 1 && it >= 1 && it - 1 <= cw) do_pv(vslot(it - 1) + vlane);
        if (it <= cw) do_qksm(ring + ((it & 1) ? LK1 : LK0));
        if (hb == 0 && it <= cw) do_pv(vslot(it) + vlane);
        if (more) tile_store<DK>(tr, ring + ((it & 1) ? LK0 : LK1), vslot(it + 1), c.tid);
        __syncthreads();
    }
    if (hb == 1 && nt - 1 <= cw) do_pv(vslot(nt - 1) + vlane);
#pragma unroll
    for (int rb = 0; rb < 2; ++rb) {
        const int trow = q0 + 64 * w + 32 * rb + r32;
        const float inv = 1.f / xhalf_sum(l_run[rb]);
        bf16_t* orow = O + (rowb + trow) * DM + ocol;
        float sq = 0.f;
#pragma unroll
        for (int db = 0; db < 2; ++db)
#pragma unroll
            for (int gp = 0; gp < 2; ++gp) {
                unsigned wv[2][2];
#pragma unroll
                for (int e = 0; e < 2; ++e) {
                    const int g = 2 * gp + e;
                    const float v0 = o[rb][db][4 * g] * inv, v1 = o[rb][db][4 * g + 1] * inv, v2 = o[rb][db][4 * g + 2] * inv, v3 = o[rb][db][4 * g + 3] * inv;
                    sq += (v0 * v0 + v1 * v1) + (v2 * v2 + v3 * v3);
                    wv[e][0] = pg8::cvt_pk_bf16(v0, v1); wv[e][1] = pg8::cvt_pk_bf16(v2, v3);
                }
                xswap32(wv[0][0], wv[1][0]); xswap32(wv[0][1], wv[1][1]);
                pg8::u32x4 v; v.x = wv[0][0]; v.y = wv[0][1]; v.z = wv[1][0]; v.w = wv[1][1];
                *(pg8::u32x4*)(orow + 32 * db + 8 * (2 * gp + h)) = v;
            }
        sq = xhalf_sum(sq);
        if (h == 0) ((float*)(p.ws + WS_SSH))[(rowb + trow) * 16 + (ocol >> 6)] = sq;
    }
    __syncthreads();
}

DEVI void conv_unit(const Ctx& c, const Params& p, int cv) {
    unsigned char* ws = p.ws;
    if (cv < 176) { const int e = cv / 22, rb = cv % 22;
        conv_rowblock<MAP_GU>(c, p.in[I_MG] + (size_t)e * 1024 * DFF, p.in[I_MU] + (size_t)e * 1024 * DFF, DFF, 1024, nullptr, (bf16_t*)(ws + WS_MGU) + (size_t)e * 5632 * 1024, 1024, rb); }
    else { const int d = cv - 176, e = d >> 2, rb = d & 3;
        conv_rowblock<MAP_ID>(c, p.in[I_MD] + (size_t)e * DFF * 1024, nullptr, 1024, DFF, nullptr, (bf16_t*)(ws + WS_MD) + (size_t)e * 1024 * DFF, DFF, rb); }
    __syncthreads();
}
DEVI void run_unit(const Ctx& c, const Params& p, int l, int xq, int u, int ncv) {
    constexpr int NB = MLA64 ? 48 : 96;
    if (u >= NB && u < NB + ncv) { conv_unit(c, p, l == 0 ? xq * 22 + (u - NB) : 176 + xq * 4 + (u - NB)); return; }
    if (u >= NB + ncv) u -= ncv;
    if (u < NB) {
        if (MLA64) { const int g = u / 12, idx = u % 12, qt = 7 - (idx >> 1), bh = 8 * (2 * g + (idx & 1)) + xq; unit3(c, p, l, bh >> 3, bh & 7, qt); }
        else { const int g = u / 24, idx = u % 24, qt = 15 - (idx >> 1), bh = 8 * (2 * g + (idx & 1)) + xq; ATT_UNIT<T_MLA>(c, p, l, bh >> 3, bh & 7, qt); }
    }
    else if (u < NB + 64) { const int v = u - NB, qt = 15 - (v >> 2), bh = 8 * (v & 3) + xq; ATT_UNIT<T_CK>(c, p, l, bh >> 2, bh & 3, qt); }
    else if (u < NB + 128) { const int v = u - NB - 64, qt = 15 - (v >> 2), bh = 8 * (v & 3) + xq; ATT_UNIT<T_SB>(c, p, l, bh >> 2, bh & 3, qt); }
    else if (MLA64) { const int v = u - NB - 128, qt = 1 - (v >> 3), bh = 8 * (v & 7) + xq; unit3(c, p, l, bh >> 3, bh & 7, qt); }
    else { const int v = u - NB - 128, qt = 3 - (v >> 3), bh = 8 * (v & 7) + xq; ATT_UNIT<T_MLA>(c, p, l, bh >> 3, bh & 7, qt); }
}
DEVI void phase(const Ctx& c, const Params& p, int lq) {
    const int l = lq & 1;
    unsigned* qbase = (unsigned*)(p.ws + WS_CTL) + 8192 + 512 * lq;
    LAS int* s_unit = (LAS int*)(c.ring + LUNIT);
    const int x0 = (int)(xb_xcc_id() & 7u);
    const int ncv = !MOE_CONV_IN_ATT ? 0 : lq == 0 ? 22 : lq == 1 ? 4 : 0, nun = (MLA64 ? 192 : 256) + ncv;
    for (int k = 0; k < 8; ++k) {
        const int xq = (x0 + k) & 7;
        if (c.tid == 0) s_unit[0] = (int)__hip_atomic_fetch_add(qbase + 64 * xq, 1u, __ATOMIC_RELAXED, __HIP_MEMORY_SCOPE_AGENT);
        __syncthreads();
        for (int par = 0;; par ^= 1) {
            const int u = s_unit[par];
            if (u >= nun) break;
            int nxt = 0;
            if (c.tid == 0) {
                unsigned long long qa = (unsigned long long)(qbase + 64 * xq);
                asm volatile("" : "+v"(qa));
                nxt = (int)__hip_atomic_fetch_add((__attribute__((address_space(1))) unsigned*)qa, 1u, __ATOMIC_RELAXED, __HIP_MEMORY_SCOPE_AGENT);
            }
            run_unit(c, p, l, xq, u, ncv);
            if (c.tid == 0) s_unit[par ^ 1] = nxt;
            __syncthreads();
        }
        __syncthreads();
    }
}
#ifndef PROBE_PF
#define PROBE_PF 0
#endif
#ifndef PROBE_TYPES
#define PROBE_TYPES 0
#endif
DEVI void phase_probe(const Ctx& c, const Params& p, int l) {
    unsigned* qbase = (unsigned*)(p.ws + WS_CTL) + 8192 + 512 * 3;
    LAS int* s_unit = (LAS int*)(c.ring + LUNIT);
    const int x0 = (int)(xb_xcc_id() & 7u);
    for (int k = 0; k < 8; ++k) {
        const int xq = (x0 + k) & 7;
        for (;;) {
            if (c.tid == 0) *s_unit = (int)__hip_atomic_fetch_add(qbase + 64 * xq, 1u, __ATOMIC_RELAXED, __HIP_MEMORY_SCOPE_AGENT);
            __syncthreads();
            const int u = *s_unit;
            __syncthreads();
            if (u >= 256) break;
            if (u < 128) { if (PROBE_TYPES & 1) { const int g = u >> 5, idx = u & 31, qt = 15 - (idx >> 1), bh = 8 * (2 * g + (idx & 1)) + xq; unit2<T_MLA, (PROBE_PF | 16)>(c, p, l, bh >> 3, bh & 7, qt); } }
            else if (u < 192) { if (PROBE_TYPES & 2) { const int v = u - 128, qt = 15 - (v >> 2), bh = 8 * (v & 3) + xq; unit2<T_SB, (PROBE_PF | 16)>(c, p, l, bh >> 2, bh & 3, qt); } }
            else { if (PROBE_TYPES & 4) { const int v = u - 192, qt = v >> 2, bh = 8 * (v & 3) + xq; unit2<T_CK, (PROBE_PF | 16)>(c, p, l, bh >> 2, bh & 3, qt); } }
        }
    }
}
}

DEVI void phase_prep(const Ctx& c, const Params& p, int l) {
    bf16_t* proj = (bf16_t*)(p.ws + WS_PROJ);
    const float* cs = (const float*)(p.ws + WS_COS); const float* sn = (const float*)(p.ws + WS_SIN);
    const float* gq = p.in[I_CKQN] + l * 64; const float* gk = p.in[I_CKKN] + l * 64;
    for (int row = c.bid * 8 + c.wid; row < MTOK; row += c.nblk * 8) {
        bf16_t* pr = proj + (size_t)row * PROJ_LD;
        {
            uint2 v = *(const uint2*)(pr + PC_CQ + 4 * c.lane);
            float a0 = lo16(v.x), a1 = hi16(v.x), a2 = lo16(v.y), a3 = hi16(v.y);
            const float ss = wave_sum(a0 * a0 + a1 * a1 + a2 * a2 + a3 * a3), r = rsqrtf(ss * (1.f / 256.f) + EPS);
            v.x = pk2(a0 * r, a1 * r); v.y = pk2(a2 * r, a3 * r);
            *(uint2*)(pr + PC_CQ + 4 * c.lane) = v;
        }
        {
            unsigned v = *(const unsigned*)(pr + PC_LAT + 2 * c.lane);
            float a0 = lo16(v), a1 = hi16(v);
            const float ss = wave_sum(a0 * a0 + a1 * a1), r = rsqrtf(ss * (1.f / 128.f) + EPS);
            *(unsigned*)(pr + PC_LAT + 2 * c.lane) = pk2(a0 * r, a1 * r);
        }
        if (c.lane < 16) {
            const float x1 = bf2f(pr[PC_KPE + c.lane]), x2 = bf2f(pr[PC_KPE + 16 + c.lane]);
            const float co = cs[row * 16 + c.lane], si = sn[row * 16 + c.lane];
            pr[PC_KPE + c.lane] = f2bf(x1 * co - x2 * si); pr[PC_KPE + 16 + c.lane] = f2bf(x2 * co + x1 * si);
        }
        {
            uint2 v = *(const uint2*)(pr + PC_CKQ + 4 * c.lane);
            float a0 = lo16(v.x), a1 = hi16(v.x), a2 = lo16(v.y), a3 = hi16(v.y);
            const float ss = sum16(a0 * a0 + a1 * a1 + a2 * a2 + a3 * a3), r = rsqrtf(ss * (1.f / 64.f) + EPS) * (0.125f * 1.4426950408889634f);
            const int d = (4 * c.lane) & 63;
            v.x = pk2(a0 * r * gq[d], a1 * r * gq[d + 1]); v.y = pk2(a2 * r * gq[d + 2], a3 * r * gq[d + 3]);
            *(uint2*)(pr + PC_CKQ + 4 * c.lane) = v;
        }
        {
            uint2 v = *(const uint2*)(pr + PC_CKK + 4 * c.lane);
            float a0 = lo16(v.x), a1 = hi16(v.x), a2 = lo16(v.y), a3 = hi16(v.y);
            const float ss = sum16(a0 * a0 + a1 * a1 + a2 * a2 + a3 * a3), r = rsqrtf(ss * (1.f / 64.f) + EPS);
            const int d = (4 * c.lane) & 63;
            v.x = pk2(a0 * r * gk[d], a1 * r * gk[d + 1]); v.y = pk2(a2 * r * gk[d + 2], a3 * r * gk[d + 3]);
            *(uint2*)(pr + PC_CKK + 4 * c.lane) = v;
        }
    }
}

DEVI void phase_fin(const Ctx& c, const Params& p, int l) {
    bf16_t* qb = (bf16_t*)(p.ws + WS_Q); bf16_t* kvb = (bf16_t*)(p.ws + WS_KV); const bf16_t* proj = (const bf16_t*)(p.ws + WS_PROJ);
    const float* cs = (const float*)(p.ws + WS_COS); const float* sn = (const float*)(p.ws + WS_SIN);
    const float* gq = p.in[I_QQK] + l * 96; const float* gk = p.in[I_KQK] + l * 96;
    const float qscale = 0.10206207261596577f * 1.4426950408889634f;
#pragma unroll 1
    for (int it = c.bid * 512 + c.tid; it < MTOK * 8; it += c.nblk * 512) {
        const int row = it >> 3, hh = it & 7;
        {
            bf16_t* qp = qb + (size_t)row * QLD + hh * 96;
            float ss = 0.f;
#pragma unroll 1
            for (int i = 0; i < 12; ++i) { float t8[8]; load_bf16_row<8>(qp + 8 * i, t8);
#pragma unroll
                for (int j = 0; j < 8; ++j) ss += t8[j] * t8[j]; }
            const float r = rsqrtf(ss * (1.f / 96.f) + EPS) * qscale;
#pragma unroll 1
            for (int i = 0; i < 8; ++i) { float t8[8]; load_bf16_row<8>(qp + 8 * i, t8);
#pragma unroll
                for (int j = 0; j < 8; ++j) t8[j] *= r * gq[8 * i + j];
                store_bf16_row<8>(qp + 8 * i, t8); }
#pragma unroll 1
            for (int i = 0; i < 2; ++i) { float x1[8], x2[8]; load_bf16_row<8>(qp + 64 + 8 * i, x1); load_bf16_row<8>(qp + 80 + 8 * i, x2);
#pragma unroll
                for (int j = 0; j < 8; ++j) { const float co = cs[row * 16 + 8 * i + j], si = sn[row * 16 + 8 * i + j], a = x1[j], b2 = x2[j];
                    x1[j] = (a * co - b2 * si) * r * gq[64 + 8 * i + j]; x2[j] = (b2 * co + a * si) * r * gq[80 + 8 * i + j]; }
                store_bf16_row<8>(qp + 64 + 8 * i, x1); store_bf16_row<8>(qp + 80 + 8 * i, x2); }
        }
    }
#pragma unroll 1
    for (int it = c.bid * 512 + c.tid; it < MTOK * 8; it += c.nblk * 512) {
        const int row = it >> 3, hh = it & 7;
        {
            bf16_t* kp = kvb + (size_t)row * KVLD + hh * 160;
            float kn[64]; load_bf16_row<64>(kp, kn);
            float kr[32]; load_bf16_row<32>(proj + (size_t)row * PROJ_LD + PC_KPE, kr);
            float ss = 0.f;
#pragma unroll
            for (int i = 0; i < 64; ++i) ss += kn[i] * kn[i];
#pragma unroll
            for (int i = 0; i < 32; ++i) ss += kr[i] * kr[i];
            const float r = rsqrtf(ss * (1.f / 96.f) + EPS);
#pragma unroll
            for (int i = 0; i < 64; ++i) kn[i] *= r * gk[i];
#pragma unroll
            for (int i = 0; i < 32; ++i) kr[i] *= r * gk[64 + i];
            store_bf16_row<64>(kp, kn); store_bf16_row<32>(kp + 64, kr);
        }
    }
}

DEVI void phase_att(const Ctx& c, const Params& p, int l) {
    const bf16_t* proj = (const bf16_t*)(p.ws + WS_PROJ); const bf16_t* qb = (const bf16_t*)(p.ws + WS_Q); const bf16_t* kvb = (const bf16_t*)(p.ws + WS_KV);
    bf16_t* o = (bf16_t*)(p.ws + WS_H);
    const float* relb = p.in[I_RELB] + l * 4 * 257;
    for (int wi = c.bid * 8 + c.wid; wi < 8192; wi += c.nblk * 8) {
        if (wi < 2048) {
            const int tt = 63 - (wi & 63), bh = wi >> 6, b = bh >> 2, hh = bh & 3, t0 = tt * 64, t = t0 + c.lane;
            const size_t rowb = (size_t)b * SEQ;
            float q[64], acc[64];
            load_bf16_row<64>(proj + (rowb + t) * PROJ_LD + PC_SBQ + hh * 64, q);
#pragma unroll
            for (int d = 0; d < 64; ++d) acc[d] = 0.f;
            float tail = 0.f;
            for (int s = t0 + 62; s >= 0; --s) {
                float z = dot_bf16<64>(proj + (rowb + s) * PROJ_LD + PC_SBK + hh * 64, q) * 0.125f;
                if (s < t) {
                    const float sp = fmaxf(z, 0.f) + log1pf(__expf(-fabsf(z)));
                    const float w = __expf(z - sp + tail);
                    tail -= sp;
                    axpy_bf16<64>(acc, 1.f, w, proj + (rowb + s) * PROJ_LD + PC_SBV + hh * 64);
                }
            }
            store_bf16_row<64>(o + (rowb + t) * DM + hh * 64, acc);
        } else if (wi < 6144) {
            const int w2 = wi - 2048, tt = 63 - (w2 & 63), bh = w2 >> 6, b = bh >> 3, hh = bh & 7, t0 = tt * 64, t = t0 + c.lane;
            const size_t rowb = (size_t)b * SEQ;
            unsigned q[48]; float acc[64];
#pragma unroll
            for (int i = 0; i < 12; ++i) { const uint4 v = *(const uint4*)(qb + (rowb + t) * QLD + hh * 96 + 8 * i); q[4 * i] = v.x; q[4 * i + 1] = v.y; q[4 * i + 2] = v.z; q[4 * i + 3] = v.w; }
#pragma unroll
            for (int d = 0; d < 64; ++d) acc[d] = 0.f;
            float mx = -3.0e38f, den = 0.f;
            for (int s = 0; s < t0 + 64; ++s) {
                const bf16_t* kp = kvb + (rowb + s) * KVLD + hh * 160;
                const float z = dot_bf16_pk<96>(kp, q);
                const float mn = fmaxf(mx, z), corr = exp2f(mx - mn), pw = exp2f(z - mn);
                mx = mn; den = den * corr + pw;
                axpy_bf16<64>(acc, corr, pw, kp + 96);
            }
            const float inv = 1.f / den;
#pragma unroll
            for (int d = 0; d < 64; ++d) acc[d] *= inv;
            store_bf16_row<64>(o + (rowb + t) * DM + 256 + hh * 64, acc);
        } else {
            const int w2 = wi - 6144, n = w2 & 63, bh = w2 >> 6, b = bh >> 2, hh = bh & 3, t0 = n * 64, t = t0 + c.lane;
            const size_t rowb = (size_t)b * SEQ;
            float q[64], acc[64];
            load_bf16_row<64>(proj + (rowb + t) * PROJ_LD + PC_CKQ + hh * 64, q);
#pragma unroll
            for (int d = 0; d < 64; ++d) acc[d] = 0.f;
            float mx = -3.0e38f, den = 0.f;
            const int s_lo = (n - 8) * 64 < 0 ? 0 : (n - 8) * 64;
            for (int s = s_lo; s < t0 + 64; ++s) {
                float z = dot_bf16<64>(proj + (rowb + s) * PROJ_LD + PC_CKK + hh * 64, q);
                int rel = t - s; rel = rel < -128 ? -128 : rel > 128 ? 128 : rel;
                z += relb[hh * 257 + rel + 128] * 1.4426950408889634f;
                const float mn = fmaxf(mx, z), corr = exp2f(mx - mn), pw = exp2f(z - mn);
                mx = mn; den = den * corr + pw;
                axpy_bf16<64>(acc, corr, pw, proj + (rowb + s) * PROJ_LD + PC_CKV + hh * 64);
            }
            const float inv = 1.f / den;
#pragma unroll
            for (int d = 0; d < 64; ++d) acc[d] *= inv;
            store_bf16_row<64>(o + (rowb + t) * DM + 768 + hh * 64, acc);
        }
    }
}

DEVI void phase_mergenorm(const Ctx& c, const Params& p) {
    bf16_t* o = (bf16_t*)(p.ws + WS_H);
    for (int row = c.bid * 8 + c.wid; row < MTOK; row += c.nblk * 8) {
        bf16_t* orow = o + (size_t)row * DM + 16 * c.lane;
        float v[16]; load_bf16_row<16>(orow, v);
        float ss = 0.f;
#pragma unroll
        for (int i = 0; i < 16; ++i) ss += v[i] * v[i];
        ss = sum16(ss);
        const float s0 = __shfl(ss, 0, 64), s1 = __shfl(ss, 16, 64), s2 = __shfl(ss, 32, 64), s3 = __shfl(ss, 48, 64);
        const int g = c.lane >> 4;
        const float r = g == 0 ? rsqrtf(s0 * (1.f / 256.f) + EPS) : g == 3 ? rsqrtf(s3 * (1.f / 256.f) + EPS) : rsqrtf((s1 + s2) * (1.f / 512.f) + EPS);
#pragma unroll
        for (int i = 0; i < 16; ++i) v[i] *= r;
        store_bf16_row<16>(orow, v);
    }
}


DEVI void phase_fin2(const Ctx& c, const Params& p, int l) {
    bf16_t* __restrict__ kvb = (bf16_t*)(p.ws + WS_KV); bf16_t* __restrict__ proj = (bf16_t*)(p.ws + WS_PROJ);
    const float* __restrict__ cs = (const float*)(p.ws + WS_COS); const float* __restrict__ sn = (const float*)(p.ws + WS_SIN);
    const float* gq = p.in[I_QQK] + l * 96; const float* gk = p.in[I_KQK] + l * 96;
    const float* gcq = p.in[I_CKQN] + l * 64; const float* gck = p.in[I_CKKN] + l * 64;
    LAS float* wsm = (LAS float*)(c.ring + 131072) + c.wid * 32;
    const int lane = c.lane, hq = lane >> 3, p8 = lane & 7, pos0 = 12 * p8;
    float* __restrict__ alpha_arr = (float*)(p.ws + WS_ALPHA);
    float gkp[12];
#pragma unroll
    for (int j = 0; j < 12; ++j) { const int pos = pos0 + j, og = pos < 64 ? pos : 64 + ((pos - 64) >> 1) + 16 * ((pos - 64) & 1); gkp[j] = gk[og] * gq[og]; }
    const int dck = (4 * lane) & 63;
    float gck4[4];
#pragma unroll
    for (int j = 0; j < 4; ++j) gck4[j] = gck[dck + j] * gcq[dck + j];
#pragma unroll 1
    for (int row = c.bid * 8 + c.wid; row < MTOK; row += c.nblk * 8) {
        bf16_t* pr = proj + (size_t)row * PROJ_LD;
        bf16_t* kp = kvb + (size_t)row * KVLD + 160 * hq + pos0;
        bf16_t* vp = kvb + (size_t)row * KVLD + 160 * hq + 96 + 8 * p8;
        const uint2 cqv = *(const uint2*)(pr + PC_CQ + 4 * lane);
        const unsigned latv = *(const unsigned*)(pr + PC_LAT + 2 * lane);
        float x1 = 0.f, x2 = 0.f, co = 0.f, si = 0.f;
        if (lane < 16) { x1 = bf2f(pr[PC_KPE + lane]); x2 = bf2f(pr[PC_KPE + 16 + lane]); co = cs[row * 16 + lane]; si = sn[row * 16 + lane]; }
        uint2 kv[3];
#pragma unroll
        for (int t = 0; t < 3; ++t) { kv[t] = (pos0 + 4 * t < 64) ? *(const uint2*)(kp + 4 * t) : make_uint2(0u, 0u); }
        const uint4 vv = *(const uint4*)vp;
        const uint2 ckk = *(const uint2*)(pr + PC_CKK + 4 * lane);
        float a0 = lo16(cqv.x), a1 = hi16(cqv.x), a2 = lo16(cqv.y), a3 = hi16(cqv.y);
        const float alpha = rsqrtf(wave_sum(a0 * a0 + a1 * a1 + a2 * a2 + a3 * a3) * (1.f / 256.f) + EPS);
        a0 = lo16(latv); a1 = hi16(latv);
        const float beta = rsqrtf(wave_sum(a0 * a0 + a1 * a1) * (1.f / 128.f) + EPS);
        const float ss_pe = wave_sum(x1 * x1 + x2 * x2);
        if (lane < 16) { wsm[2 * lane] = x1 * co - x2 * si; wsm[2 * lane + 1] = x2 * co + x1 * si; }
        if (lane == 0) alpha_arr[row] = alpha;
        float k[12];
#pragma unroll
        for (int t = 0; t < 3; ++t) { k[4 * t] = lo16(kv[t].x); k[4 * t + 1] = hi16(kv[t].x); k[4 * t + 2] = lo16(kv[t].y); k[4 * t + 3] = hi16(kv[t].y); }
        float ssk = 0.f;
#pragma unroll
        for (int j = 0; j < 12; ++j) ssk += k[j] * k[j];
        ssk += __shfl_xor(ssk, 1, 64); ssk += __shfl_xor(ssk, 2, 64); ssk += __shfl_xor(ssk, 4, 64);
        const float rk = rsqrtf((beta * beta * ssk + ss_pe) * (1.f / 96.f) + EPS), rkb = rk * beta;
#pragma unroll
        for (int j = 0; j < 12; ++j) { const int pos = pos0 + j; k[j] = (pos < 64) ? k[j] * rkb * gkp[j] : wsm[pos >= 64 ? pos - 64 : 0] * rk * gkp[j]; }
#pragma unroll
        for (int t = 0; t < 3; ++t) { uint2 o; o.x = pk2(k[4 * t], k[4 * t + 1]); o.y = pk2(k[4 * t + 2], k[4 * t + 3]); *(uint2*)(kp + 4 * t) = o; }
        { uint4 o; o.x = pk2(lo16(vv.x) * beta, hi16(vv.x) * beta); o.y = pk2(lo16(vv.y) * beta, hi16(vv.y) * beta); o.z = pk2(lo16(vv.z) * beta, hi16(vv.z) * beta); o.w = pk2(lo16(vv.w) * beta, hi16(vv.w) * beta); *(uint4*)vp = o; }
        { float b0 = lo16(ckk.x), b1 = hi16(ckk.x), b2 = lo16(ckk.y), b3 = hi16(ckk.y);
          const float r = rsqrtf(sum16(b0 * b0 + b1 * b1 + b2 * b2 + b3 * b3) * (1.f / 64.f) + EPS);
          uint2 o; o.x = pk2(b0 * r * gck4[0], b1 * r * gck4[1]); o.y = pk2(b2 * r * gck4[2], b3 * r * gck4[3]); *(uint2*)(pr + PC_CKK + 4 * lane) = o; }
    }
}

DEVI void phase_mergenorm2(const Ctx& c, const Params& p) {
    bf16_t* o = (bf16_t*)(p.ws + WS_H);
#pragma unroll 1
    for (int row = (c.bid * 8 + c.wid) * 2; row < MTOK; row += c.nblk * 16) {
        uint4 raw[2][2];
#pragma unroll
        for (int q = 0; q < 2; ++q) { const uint4* rp = (const uint4*)(o + (size_t)(row + q) * DM + 16 * c.lane); raw[q][0] = rp[0]; raw[q][1] = rp[1]; }
#pragma unroll
        for (int q = 0; q < 2; ++q) {
            float v[16];
#pragma unroll
            for (int t = 0; t < 2; ++t) { const uint4 u = raw[q][t]; v[8 * t] = lo16(u.x); v[8 * t + 1] = hi16(u.x); v[8 * t + 2] = lo16(u.y); v[8 * t + 3] = hi16(u.y); v[8 * t + 4] = lo16(u.z); v[8 * t + 5] = hi16(u.z); v[8 * t + 6] = lo16(u.w); v[8 * t + 7] = hi16(u.w); }
            float ss = 0.f;
#pragma unroll
            for (int i = 0; i < 16; ++i) ss += v[i] * v[i];
            ss = sum16(ss);
            const float s0 = __shfl(ss, 0, 64), s1 = __shfl(ss, 16, 64), s2 = __shfl(ss, 32, 64), s3 = __shfl(ss, 48, 64);
            const int g = c.lane >> 4;
            const float r = g == 0 ? rsqrtf(s0 * (1.f / 256.f) + EPS) : g == 3 ? rsqrtf(s3 * (1.f / 256.f) + EPS) : rsqrtf((s1 + s2) * (1.f / 512.f) + EPS);
#pragma unroll
            for (int i = 0; i < 16; ++i) v[i] *= r;
            store_bf16_row<16>(o + (size_t)(row + q) * DM + 16 * c.lane, v);
        }
    }
}

DEVI void phase_route(const Ctx& c, const Params& p) {
    const int* cnt = (const int*)(p.ws + WS_CNT); const int* te = (const int*)(p.ws + WS_TOKE); const float* tw = (const float*)(p.ws + WS_TOKW);
    int* perm = (int*)(p.ws + WS_PERM); float* permw = (float*)(p.ws + WS_PERMW); int* texp = (int*)(p.ws + WS_TEXP);
    int* s_tot = (int*)c.sm; int* s_base = s_tot + 16; int* s_seg = s_tot + 32; int* s_e = s_tot + 64;
    for (int ch = c.bid; ch < MTOK / 128; ch += c.nblk) {
        __syncthreads();
        if (c.tid < 16) { int tot = 0, base = 0; for (int i = 0; i < MTOK / 128; ++i) { const int v = cnt[i * 16 + c.tid]; tot += v; base += (i < ch) ? v : 0; } s_tot[c.tid] = tot; s_base[c.tid] = base; }
        if (c.tid >= 64 && c.tid < 64 + 256) { const int i = c.tid - 64; s_e[i] = te[(ch * 128 + (i & 127)) * 2 + (i >> 7)]; }
        __syncthreads();
        if (c.tid < 2) { int a = 0; for (int e = 0; e < 8; ++e) { s_seg[c.tid * 8 + e] = a; a += (s_tot[c.tid * 8 + e] + 255) & ~255; } s_seg[16 + c.tid] = a; }
        __syncthreads();
        if (c.tid < 256) {
            const int s = c.tid >> 7, i = c.tid & 127, e = s_e[s * 128 + i];
            int rank = 0; for (int j = 0; j < i; ++j) rank += (s_e[s * 128 + j] == e);
            const int pos = s_seg[s * 8 + e] + s_base[s * 8 + e] + rank, tok = ch * 128 + i;
            perm[s * MOE_ROWS + pos] = tok; permw[s * MOE_ROWS + pos] = tw[tok * 2 + s];
        }
        if (ch == 0) {
            for (int s = 0; s < 2; ++s) {
                for (int e = 0; e < 8; ++e) {
                    const int beg = s_seg[s * 8 + e] + s_tot[s * 8 + e], end = s_seg[s * 8 + e] + ((s_tot[s * 8 + e] + 255) & ~255);
                    for (int q = beg + c.tid; q < end; q += 512) { perm[s * MOE_ROWS + q] = -1; permw[s * MOE_ROWS + q] = 0.f; }
                    const int t0 = s_seg[s * 8 + e] >> 8, t1 = end >> 8;
                    for (int t = t0 + c.tid; t < t1; t += 512) texp[s * MOE_TILES + t] = e;
                }
                if (c.tid == 0) texp[2 * MOE_TILES + s] = s_seg[16 + s] >> 8;
            }
        }
    }
}


DEVI void phase_moe_tail(const Ctx& c, const Params& p, const float* gate) {
    const int* texp = (const int*)(p.ws + WS_TEXP);
    const int ntl1 = texp[2 * MOE_TILES + 1];
    int q1 = ntl1 - (256 * 2) / 4; q1 = q1 < 0 ? 0 : q1 > 8 ? 8 : q1; if (c.nblk != 256) q1 = 0;
    const int* perm = (const int*)(p.ws + WS_PERM) + MOE_ROWS; const float* permw = (const float*)(p.ws + WS_PERMW) + MOE_ROWS;
    const bf16_t* xs2 = (const bf16_t*)(p.ws + WS_XS2); const float* part = (const float*)(p.ws + WS_PART);
    for (int row = c.bid * 8 + c.wid; row < q1 * 256; row += c.nblk * 8) {
        const int tok = perm[row]; if (tok < 0) continue;
        const float w = permw[row]; const float* gp = gate + (tok / SEQ) * 6144;
#pragma unroll
        for (int i = 0; i < 4; ++i) {
            const int col = 4 * (c.lane + 64 * i);
            const uint2 xv = *(const uint2*)(xs2 + (size_t)tok * DM + col);
            const size_t po = (size_t)row * DM + col; const size_t ps = (size_t)8 * 256 * DM;
            const f32x4 a = (*(const f32x4*)(part + po) + *(const f32x4*)(part + ps + po)) + (*(const f32x4*)(part + 2 * ps + po) + *(const f32x4*)(part + 3 * ps + po));
            const f32x4 g = *(const f32x4*)(gp + col);
            f32x4 o; o[0] = lo16(xv.x) + g[0] * w * a[0]; o[1] = hi16(xv.x) + g[1] * w * a[1]; o[2] = lo16(xv.y) + g[2] * w * a[2]; o[3] = hi16(xv.y) + g[3] * w * a[3];
            *(f32x4*)(p.out + (size_t)tok * DM + col) = o;
        }
    }
}

constexpr int NPHASE = 23;
constexpr int LDS_SM = 131072, LDS_XB = LDS_SM + 16640, LDS_BYTES = LDS_XB + 256;
template <int PH> DEVI void run_phase(const Ctx& c0, const Params& p, int repi = 0) {
    unsigned z_l = 0u; asm volatile("" : "+v"(z_l));
    int wid_l = c0.wid; asm volatile("" : "+s"(wid_l));
    const int lane_l = (int)__builtin_amdgcn_mbcnt_hi(~0u, __builtin_amdgcn_mbcnt_lo(~0u, z_l));
    Ctx c; c.tid = wid_l * 64 + lane_l; c.lane = lane_l; c.wid = wid_l; c.bid = c0.bid; c.nblk = c0.nblk; c.sm = c0.sm; c.ring = c0.ring;
    constexpr int l = PH >= 10 ? 1 : 0;
    constexpr int r = PH == 0 ? -1 : (l == 0 ? PH - 1 : PH - 10);
    unsigned char* ws = p.ws;
    const float* modl = (const float*)(ws + WS_MOD) + l * 8 * 6144;
    bf16_t* H = (bf16_t*)(ws + WS_H); bf16_t* PROJ = (bf16_t*)(ws + WS_PROJ); bf16_t* Q = (bf16_t*)(ws + WS_Q); bf16_t* KV = (bf16_t*)(ws + WS_KV); bf16_t* HID = (bf16_t*)(ws + WS_HID);
    void* XS = (void*)p.out; void* XS2 = (void*)(ws + WS_XS2);
    if constexpr (PH == 0) phase_prologue(c, p, repi);
    else if constexpr (r == 0) { if constexpr (l == 0) phase_norm<false, false>(c, p, p.in[I_X], p.in[I_NMIX] + l * DM, modl, modl + 1024); else phase_norm<false, true>(c, p, XS, p.in[I_NMIX] + l * DM, modl, modl + 1024); }
    else if constexpr (r == 1) {
        pg8::ProbPlain P{H, (const bf16_t*)(ws + WS_WIN) + (size_t)l * 2048 * 1024, 1024, 1024, 1024, {}}; P.S.init(MTOK / 256, 8, c.nblk, c.bid);
        pg8::gemm_phase(c.ring, P, pg8::EpiStoreT{PROJ, PROJ_LD, nullptr, 0, 1 << 30}, c.tid);
    } else if constexpr (r == 2) {
        pg8::ProbUp P{PROJ + PC_CQ, PROJ + PC_LAT, (const bf16_t*)(ws + WS_WQ) + (size_t)l * 768 * 256, (const bf16_t*)(ws + WS_WKV) + (size_t)l * 1280 * 256, PROJ_LD, 256, 256, {}};
        P.S.init(MTOK / 256, 8, c.nblk, c.bid);
        pg8::gemm_phase(c.ring, P, pg8::EpiStoreT{Q, QLD, KV, KVLD, 3}, c.tid);
    } else if constexpr (r == 3) phase_fin2(c, p, l);
    else if constexpr (r == 4) att::phase(c, p, l + 2 * repi);
    else if constexpr (r == 5) {
        pg8::ProbPlain P{H, (const bf16_t*)(ws + WS_WOUT) + (size_t)l * 1024 * 1024, 1024, 1024, 1024, {}}; P.S.init(MTOK / 256, 4, c.nblk, c.bid);
        {
            const float* ssh = (const float*)(ws + WS_SSH); float* rat = (float*)(ws + WS_RAT);
            pg8::Unit u;
            for (int ui = 0; P.next(ui, u); ++ui) if (c.tid < 256) {
                const size_t row = (size_t)u.pm * 256 + c.tid; const float* sp = ssh + row * 16;
                const f32x4 a = *(const f32x4*)sp, b = *(const f32x4*)(sp + 4), c2 = *(const f32x4*)(sp + 8), d = *(const f32x4*)(sp + 12);
                const float s1 = (a[0] + a[1]) + (a[2] + a[3]), s2 = ((b[0] + b[1]) + (b[2] + b[3])) + ((c2[0] + c2[1]) + (c2[2] + c2[3])), s3 = (d[0] + d[1]) + (d[2] + d[3]);
                const float q1 = rsqrtf(s1 * (1.f / 256.f) + EPS), q2 = rsqrtf(s2 * (1.f / 512.f) + EPS), q3 = rsqrtf(s3 * (1.f / 256.f) + EPS);
                *(f32x4*)(rat + row * 4) = (f32x4){q1 / q2, q2 / q3, q3, 0.f};
            }
            asm volatile("s_waitcnt vmcnt(0)" ::: "memory"); __syncthreads();
        }
        if constexpr (l == 0) pg8::gemm_phase<pg8::EpiResidT<false, true>, pg8::ProbPlain, false, true, pg8::GroupRowScale>(c.ring, P, pg8::EpiResidT<false, true>{p.in[I_X], XS, modl + 2048}, c.tid, pg8::GroupRowScale{(const float*)(ws + WS_RAT)});
        else pg8::gemm_phase<pg8::EpiResidT<true, true>, pg8::ProbPlain, false, true, pg8::GroupRowScale>(c.ring, P, pg8::EpiResidT<true, true>{XS, XS, modl + 2048}, c.tid, pg8::GroupRowScale{(const float*)(ws + WS_RAT)});
    } else if constexpr (r == 6) phase_norm<(l == 1), true>(c, p, XS, p.in[I_NFFN] + l * DM, modl + 3072, modl + 4096);
    else if constexpr (l == 0 && r == 7) {
        pg8::ProbPlain P{H, (const bf16_t*)(ws + WS_FGU), 1024, 1024, 1024, {}}; P.S.init(MTOK / 256, 22, c.nblk, c.bid);
        pg8::gemm_phase(c.ring, P, pg8::EpiSwigluT{HID}, c.tid);
    } else if constexpr (l == 0 && r == 8) {
        pg8::ProbPlain P{HID, (const bf16_t*)(ws + WS_FD), DFF, DFF, DFF, {}}; P.S.init(MTOK / 256, 4, c.nblk, c.bid);
        pg8::gemm_phase(c.ring, P, pg8::EpiResidT<true, true>{XS, XS, modl + 5120}, c.tid);
    } else if constexpr (l == 1 && r == 7) phase_route(c, p);
    else if constexpr (l == 1 && r == 12) phase_moe_tail(c, p, modl + 5120);
    else {
        constexpr int s = (r - 8) >> 1;
        const int* perm = (const int*)(ws + WS_PERM) + s * MOE_ROWS; const float* permw = (const float*)(ws + WS_PERMW) + s * MOE_ROWS;
        const int* texp = (const int*)(ws + WS_TEXP);
        const int ntl0 = texp[2 * MOE_TILES + 0];
        int q0 = ntl0 - (256 * 2) / 4; q0 = q0 < 0 ? 0 : q0 > 8 ? 8 : q0; if (c.nblk != 256) q0 = 0;
        const int ntl1 = texp[2 * MOE_TILES + 1];
        int q1 = ntl1 - (256 * 2) / 4; q1 = q1 < 0 ? 0 : q1 > 8 ? 8 : q1; if (c.nblk != 256) q1 = 0;
        bf16_t* HIDs = HID + (size_t)(s * 8) * 256 * DFF;
        int mx = 0;
        if (c.nblk == 256) { const int nw0 = 22 * ntl0, spare = ((nw0 + 255) / 256) * 256 - nw0; mx = spare / 22; int lim = ntl1 - ntl0 + 8; lim = lim < 0 ? 0 : lim; mx = mx > lim ? lim : mx; mx = mx > ntl1 ? ntl1 : mx; }
        if constexpr (((r - 8) & 1) == 0) {
            const int ntl = (s == 0) ? ntl0 : ntl1 - mx;
            if (s == 1 && c.bid >= c.nblk - 4 * q0) {
                const int k = c.bid - (c.nblk - 4 * q0);
                pg8::ProbMoeT<pg8::OneUnit> P{HID, (const bf16_t*)(ws + WS_MD), DFF, DFF, DFF, {k >> 2, k & 3}, texp, (size_t)1024 * DFF, nullptr, 0};
                pg8::gemm_phase(c.ring, P, pg8::EpiMoeDownT<true>{XS, XS2, modl + 5120, (const int*)(ws + WS_PERM), (const float*)(ws + WS_PERMW)}, c.tid);
                __syncthreads();
            }
            LAS unsigned* tab = (LAS unsigned*)(c.ring + 131072);
            pg8::ProbMoeT<pg8::SkipOrder> P{H, (const bf16_t*)(ws + WS_MGU), 1024, 1024, 1024, {{}, (s == 1) ? 4 * q0 : 0, 3, (s == 0) ? mx : 0, MOE_TILES + ntl1 - mx}, texp + s * MOE_TILES, (size_t)5632 * 1024, tab, 0};
            P.S.base.init(ntl, 22, c.nblk, c.bid);
            { pg8::Unit u; for (int ui = 0; ui < 16 && P.next(ui, u); ++ui) if (c.tid < 256) { const int tok = perm[u.pm * 256 + c.tid]; tab[ui * 256 + c.tid] = (unsigned)(tok < 0 ? 0 : tok) * 2048u; } }
            __syncthreads();
            pg8::gemm_phase<pg8::EpiSwigluT, pg8::ProbMoeT<pg8::SkipOrder>, true>(c.ring, P, pg8::EpiSwigluT{HIDs, MOE_TILES, 8 - MOE_TILES}, c.tid);
        } else {
            const int ntl = texp[2 * MOE_TILES + s], qo = (s == 0) ? q0 : q1;
            pg8::ProbMoeT<pg8::StaticOrder> P{HIDs, (const bf16_t*)(ws + WS_MD), DFF, DFF, DFF, {}, texp + s * MOE_TILES, (size_t)1024 * DFF, nullptr, qo};
            P.S.init(ntl - qo, 4, c.nblk, c.bid);
            if constexpr (s == 0) pg8::gemm_phase(c.ring, P, pg8::EpiMoeDownT<true>{XS, XS2, modl + 5120, perm, permw}, c.tid);
            else {
                pg8::gemm_phase(c.ring, P, pg8::EpiMoeDownT<false>{XS2, (void*)p.out, modl + 5120, perm, permw}, c.tid);
                if (q1 > 0) {
                    __syncthreads();
                    pg8::ProbSplitK4 PS{HIDs, (const bf16_t*)(ws + WS_MD), DFF, DFF, DFF, texp + s * MOE_TILES, (size_t)1024 * DFF, 16 * q1, c.nblk, c.bid};
                    pg8::gemm_phase(c.ring, PS, pg8::EpiPartialT{(float*)(ws + WS_PART), 8 * 256}, c.tid);
                }
            }
        }
    }
}
template <int PH, int HI> DEVI void run_range(const Ctx& c, const Params& p, const XcdBarrier& bar) {
    if constexpr (PH < HI) {
        run_phase<PH>(c, p);
        if constexpr ((REP_MASK >> PH) & 1u) { xcd_barrier(bar); run_phase<PH>(c, p, 1); }
        if constexpr (PROBE_TYPES != 0 && PH == 5) { xcd_barrier(bar); Ctx cc = c; cc.tid = threadIdx.x; cc.lane = threadIdx.x & 63; cc.wid = __builtin_amdgcn_readfirstlane(threadIdx.x >> 6); att::phase_probe(cc, p, 0); }
        if constexpr (PH + 1 < HI) { xcd_barrier(bar); run_range<PH + 1, HI>(c, p, bar); }
    }
}

template <int LO, int HI>
__global__ void __launch_bounds__(512, 2) mega_kernel(Params p) {
    extern __shared__ __attribute__((aligned(16))) unsigned char lds[];
    Ctx c; c.bid = blockIdx.x; c.nblk = gridDim.x; c.tid = threadIdx.x; c.lane = threadIdx.x & 63; c.wid = __builtin_amdgcn_readfirstlane(threadIdx.x >> 6);
    c.ring = (LAS unsigned char*)lds; c.sm = (float*)(lds + LDS_SM);
    volatile LAS unsigned* xbw = (volatile LAS unsigned*)((LAS unsigned char*)lds + LDS_XB);
    if (threadIdx.x < 4) xbw[threadIdx.x] = 0u;
    __syncthreads();
    unsigned* barw = (unsigned*)(p.ws + WS_CTL);
    XcdBarrier bar; bar.bar = barw; bar.x = 0; bar.st = xbw;
    if constexpr (HI - LO > 1) bar = xcd_barrier_post(barw, xbw);
    run_range<LO, HI>(c, p, bar);
}

template <int K> static void launch_each(int grid, hipStream_t stream, const Params& p) {
    if constexpr (K < NPHASE) {
        (void)hipFuncSetAttribute((const void*)mega_kernel<K, K + 1>, hipFuncAttributeMaxDynamicSharedMemorySize, LDS_BYTES);
        hipLaunchKernelGGL((mega_kernel<K, K + 1>), dim3(grid), dim3(512), LDS_BYTES, stream, p);
        launch_each<K + 1>(grid, stream, p);
    }
}

extern "C" void kernel_launch(void* const* d_in, const int* in_sizes, int n_in, void* d_out, int out_size, void* d_ws, size_t ws_size, hipStream_t stream) {
    (void)in_sizes; (void)out_size;
    if (n_in < 26 || ws_size < WS_END) { fprintf(stderr, "kernel_launch: bad sizes n_in=%d ws=%zu\n", n_in, ws_size); return; }
    static int grid = 0;
    if (!grid) {
        int dev = 0, cus = 0;
        (void)hipGetDevice(&dev);
        (void)hipDeviceGetAttribute(&cus, hipDeviceAttributeMultiprocessorCount, dev);
        grid = cus;
        if (grid > 256 || grid < 1) grid = 256;
    }
    (void)hipMemsetAsync((unsigned char*)d_ws + WS_CTL, 0, CTL_BYTES, stream);
    Params p{};
    for (int i = 0; i < 26; ++i) p.in[i] = (const float*)d_in[i];
    p.out = (float*)d_out; p.ws = (unsigned char*)d_ws;
#if ONE_LAUNCH
    (void)hipFuncSetAttribute((const void*)mega_kernel<0, NPHASE>, hipFuncAttributeMaxDynamicSharedMemorySize, LDS_BYTES);
    hipLaunchKernelGGL((mega_kernel<0, NPHASE>), dim3(grid), dim3(512), LDS_BYTES, stream, p);
#else
    launch_each<0>(grid, stream, p);
#endif
}
```
